# Optimizing an MI355X kernel written in HIP

```python
import jax, jax.numpy as jnp
from jax import lax
import numpy as np

D_MODEL = 1024
BATCH = 2
SEQ = 16384
DEPTH = 1
DEC_BATCH = 8
DEC_SEQ = 32
PAST_LEN = 2048

CHUNK = 64
MIX_WIDTH = D_MODEL
CONV_CH = MIX_WIDTH // 2
CONV_WIDTH = 31
HEAD_DIM = 64
N_HEADS = (MIX_WIDTH - CONV_CH) // HEAD_DIM
N_KV_HEADS = 2
GROUP = N_HEADS // N_KV_HEADS
WINDOW = 128
WIN_CHUNKS = WINDOW // CHUNK
ROPE_THETA = 10000.0
D_FF = 4 * D_MODEL
D_PLE = 256
EPS = 1e-6
NEG = -1e30
Q_COLS = N_HEADS * HEAD_DIM
KV_COLS = N_KV_HEADS * HEAD_DIM
IN_COLS = 2 * CONV_CH + Q_COLS + 2 * KV_COLS
SPLITS = [CONV_CH, 2 * CONV_CH, 2 * CONV_CH + Q_COLS, 2 * CONV_CH + Q_COLS + KV_COLS]

kernel_name = 'hybrid_conformer_conv_swa_sink_stream'


def rmsnorm(x, g):
    xf = x.astype(jnp.float32)
    y = xf * lax.rsqrt(jnp.mean(xf * xf, axis=-1, keepdims=True) + EPS)
    return (y * g.astype(jnp.float32)).astype(x.dtype)


def layernorm(x, g, b):
    xf = x.astype(jnp.float32)
    mu = jnp.mean(xf, axis=-1, keepdims=True)
    xc = xf - mu
    y = xc * lax.rsqrt(jnp.mean(xc * xc, axis=-1, keepdims=True) + EPS)
    return (y * g.astype(jnp.float32) + b.astype(jnp.float32)).astype(x.dtype)


def rope(x, pos):
    half = HEAD_DIM // 2
    inv = 1.0 / (ROPE_THETA ** (jnp.arange(half, dtype=jnp.float32) / half))
    ang = pos[:, None] * inv[None, :]
    cos = jnp.cos(ang)[:, None, :]
    sin = jnp.sin(ang)[:, None, :]
    xf = x.astype(jnp.float32)
    x1, x2 = xf[..., :half], xf[..., half:]
    return jnp.concatenate([x1 * cos - x2 * sin, x2 * cos + x1 * sin], axis=-1).astype(x.dtype)


def sink_softmax(s, sink):
    m = jnp.maximum(jnp.max(s, axis=-1, keepdims=True), sink)
    e = jnp.exp(s - m)
    return e / (jnp.sum(e, axis=-1, keepdims=True) + jnp.exp(sink - m))


def window_attn_prompt(q, k, v, sink):
    B, S = q.shape[0], q.shape[1]
    n_c = S // CHUNK
    qb = q.reshape(B, n_c, CHUNK, N_KV_HEADS, GROUP, HEAD_DIM)
    pad = ((0, 0), (WIN_CHUNKS * CHUNK, 0), (0, 0), (0, 0))
    kp = jnp.pad(k, pad).reshape(B, n_c + WIN_CHUNKS, CHUNK, N_KV_HEADS, HEAD_DIM)
    vp = jnp.pad(v, pad).reshape(B, n_c + WIN_CHUNKS, CHUNK, N_KV_HEADS, HEAD_DIM)
    kw = jnp.concatenate([kp[:, j:j + n_c] for j in range(WIN_CHUNKS + 1)], axis=2)
    vw = jnp.concatenate([vp[:, j:j + n_c] for j in range(WIN_CHUNKS + 1)], axis=2)
    s = jnp.einsum('bnckgd,bnskd->bnkgcs', qb, kw, preferred_element_type=jnp.float32) * (HEAD_DIM ** -0.5)
    key_chunk = (jnp.arange(n_c)[:, None] - WIN_CHUNKS
                 + (jnp.arange((WIN_CHUNKS + 1) * CHUNK) // CHUNK)[None, :])
    valid = key_chunk >= 0
    s = jnp.where(valid[None, :, None, None, None, :], s, NEG)
    sk = sink.astype(jnp.float32).reshape(1, 1, N_KV_HEADS, GROUP, 1, 1)
    pr = sink_softmax(s, sk).astype(v.dtype)
    o = jnp.einsum('bnkgcs,bnskd->bnckgd', pr, vw)
    return o.reshape(B, S, N_HEADS * HEAD_DIM)


def window_attn_sample(q, k_hist, v_hist, k, v, sink):
    B, T = q.shape[0], q.shape[1]
    kall = jnp.concatenate([k_hist.astype(k.dtype), k], axis=1)
    vall = jnp.concatenate([v_hist.astype(v.dtype), v], axis=1)
    qb = q.reshape(B, T, N_KV_HEADS, GROUP, HEAD_DIM)
    s = jnp.einsum('btkgd,bskd->bkgts', qb, kall, preferred_element_type=jnp.float32) * (HEAD_DIM ** -0.5)
    sk = sink.astype(jnp.float32).reshape(1, N_KV_HEADS, GROUP, 1, 1)
    pr = sink_softmax(s, sk).astype(v.dtype)
    o = jnp.einsum('bkgts,bskd->btkgd', pr, vall)
    return o.reshape(B, T, N_HEADS * HEAD_DIM)


def trunk_layer(h, p_l, conv_hist, pos, attend, ln_mix_g, w_in, conv_w, conv_b, conv_norm_g,
                conv_norm_b, w_out, ln_ffn_g, w_ff1, w_ff2, ple_norm_g, w_ple_gate, w_ple_proj):
    B, T = h.shape[0], h.shape[1]
    a = rmsnorm(h, ln_mix_g)
    z = a @ w_in
    c_val, c_gate, q, k, v = jnp.split(z, SPLITS, axis=-1)
    u = c_val * jax.nn.sigmoid(c_gate)
    u_ext = jnp.concatenate([conv_hist.astype(u.dtype), u], axis=1)
    dc = lax.conv_general_dilated(u_ext, conv_w[:, None, :].astype(u.dtype), (1,), 'VALID',
                                  dimension_numbers=('NWC', 'WIO', 'NWC'),
                                  feature_group_count=CONV_CH) + conv_b
    c_out = jax.nn.silu(layernorm(dc, conv_norm_g, conv_norm_b))
    q = rope(q.reshape(B, T, N_HEADS, HEAD_DIM), pos)
    k = rope(k.reshape(B, T, N_KV_HEADS, HEAD_DIM), pos)
    v = v.reshape(B, T, N_KV_HEADS, HEAD_DIM)
    att = attend(q, k, v)
    h = h + jnp.concatenate([c_out, att], axis=-1) @ w_out
    f = rmsnorm(h, ln_ffn_g)
    h = h + jnp.square(jax.nn.relu(f @ w_ff1)) @ w_ff2
    gate = jax.nn.sigmoid(rmsnorm(h, ple_norm_g) @ w_ple_gate)
    h = h + gate * (p_l @ w_ple_proj)
    new_conv = u_ext[:, -(CONV_WIDTH - 1):]
    return h, new_conv, k, v


def setup_inputs(seed: int = 0) -> dict:
    key = jax.random.key(seed)
    ks = jax.random.split(key, 24)
    f32 = jnp.float32
    nrm = lambda k, shape, scale: jax.random.normal(k, shape, f32) * scale
    return {
        'x_prompt': nrm(ks[0], (BATCH, SEQ, D_MODEL), 1.0),
        'x_sample': nrm(ks[1], (DEC_BATCH, DEC_SEQ, D_MODEL), 1.0),
        'p_prompt': nrm(ks[2], (DEPTH, BATCH, SEQ, D_PLE), 1.0),
        'p_sample': nrm(ks[3], (DEPTH, DEC_BATCH, DEC_SEQ, D_PLE), 1.0),
        'cache_k': nrm(ks[4], (DEPTH, DEC_BATCH, WINDOW, N_KV_HEADS, HEAD_DIM), 1.0),
        'cache_v': nrm(ks[5], (DEPTH, DEC_BATCH, WINDOW, N_KV_HEADS, HEAD_DIM), 1.0),
        'state_conv': nrm(ks[6], (DEPTH, DEC_BATCH, CONV_WIDTH - 1, CONV_CH), 0.5),
        'ln_mix_g': 1.0 + nrm(ks[7], (DEPTH, D_MODEL), 0.02),
        'w_in': nrm(ks[8], (DEPTH, D_MODEL, IN_COLS), D_MODEL ** -0.5),
        'conv_w': nrm(ks[9], (DEPTH, CONV_WIDTH, CONV_CH), CONV_WIDTH ** -0.5),
        'conv_b': nrm(ks[10], (DEPTH, CONV_CH), 0.02),
        'conv_norm_g': 1.0 + nrm(ks[11], (DEPTH, CONV_CH), 0.02),
        'conv_norm_b': nrm(ks[12], (DEPTH, CONV_CH), 0.02),
        'attn_sink': nrm(ks[13], (DEPTH, N_HEADS), 1.0),
        'w_out': nrm(ks[14], (DEPTH, MIX_WIDTH, D_MODEL), MIX_WIDTH ** -0.5),
        'ln_ffn_g': 1.0 + nrm(ks[15], (DEPTH, D_MODEL), 0.02),
        'w_ff1': nrm(ks[16], (DEPTH, D_MODEL, D_FF), D_MODEL ** -0.5),
        'w_ff2': nrm(ks[17], (DEPTH, D_FF, D_MODEL), 0.5 * D_FF ** -0.5),
        'ple_norm_g': 1.0 + nrm(ks[18], (DEPTH, D_MODEL), 0.02),
        'w_ple_gate': nrm(ks[19], (DEPTH, D_MODEL, D_MODEL), D_MODEL ** -0.5),
        'w_ple_proj': nrm(ks[20], (DEPTH, D_PLE, D_MODEL), D_PLE ** -0.5),
        'final_norm_g': 1.0 + nrm(ks[21], (D_MODEL,), 0.02),
    }


def reference(x_prompt, x_sample, p_prompt, p_sample, cache_k, cache_v, state_conv,
              ln_mix_g, w_in, conv_w, conv_b, conv_norm_g, conv_norm_b, attn_sink, w_out,
              ln_ffn_g, w_ff1, w_ff2, ple_norm_g, w_ple_gate, w_ple_proj, final_norm_g):
    b_p, s_p = x_prompt.shape[0], x_prompt.shape[1]
    t_s = x_sample.shape[1]
    pos_p = jnp.arange(s_p, dtype=jnp.float32)
    pos_s = PAST_LEN + jnp.arange(t_s, dtype=jnp.float32)
    hp, hs = x_prompt, x_sample
    nk_p, nv_p, nc_p, nk_s, nv_s, nc_s = [], [], [], [], [], []
    for l in range(DEPTH):
        w = (ln_mix_g[l], w_in[l], conv_w[l], conv_b[l], conv_norm_g[l], conv_norm_b[l], w_out[l],
             ln_ffn_g[l], w_ff1[l], w_ff2[l], ple_norm_g[l], w_ple_gate[l], w_ple_proj[l])
        sink = attn_sink[l]
        zero_hist = jnp.zeros((b_p, CONV_WIDTH - 1, CONV_CH), x_prompt.dtype)
        hp, c_p, k_p, v_p = trunk_layer(
            hp, p_prompt[l], zero_hist, pos_p,
            lambda q, k, v: window_attn_prompt(q, k, v, sink), *w)
        ck, cv = cache_k[l], cache_v[l]
        hs, c_s, k_s, v_s = trunk_layer(
            hs, p_sample[l], state_conv[l], pos_s,
            lambda q, k, v: window_attn_sample(q, ck, cv, k, v, sink), *w)
        nk_p.append(k_p[:, -WINDOW:])
        nv_p.append(v_p[:, -WINDOW:])
        nc_p.append(c_p)
        nk_s.append(k_s)
        nv_s.append(v_s)
        nc_s.append(c_s)
    y_prompt = rmsnorm(hp, final_norm_g)
    y_sample = rmsnorm(hs, final_norm_g)
    return (y_prompt, y_sample, jnp.stack(nk_p), jnp.stack(nv_p), jnp.stack(nc_p),
            jnp.stack(nk_s), jnp.stack(nv_s), jnp.stack(nc_s))
```

```cpp
#include <hip/hip_runtime.h>
#include <hip/hip_cooperative_groups.h>
#include <cstdio>
#include <cstdint>
namespace cg = cooperative_groups;

namespace pg8 {
#define PG8_LAS __attribute__((address_space(3)))
typedef unsigned short bf16_t;
typedef short bf16x8 __attribute__((ext_vector_type(8)));
typedef float f32x4 __attribute__((ext_vector_type(4)));
typedef unsigned u32x4 __attribute__((ext_vector_type(4)));
constexpr int BM = 256, BK = 64, HALF = 128, HTB = HALF * BK * 2  , STAGE_BYTES = 8 * HTB, NXCD = 8, WGM = 8;

__host__ __device__ __forceinline__ int lds_byte(int r, int c) { const int st = (r >> 4) * 2 + (c >> 5), rr = r & 15, cc = c & 31, ob = rr * 64 + cc * 2; return st * 1024 + (ob ^ (((ob >> 9) & 1) << 5)); }
__host__ __device__ __forceinline__ void stage_rc(int b, int& R, int& C) { const int st = b / 1024, sb = b % 1024, swz = sb ^ (((sb >> 9) & 1) << 5); R = (st >> 1) * 16 + swz / 64; C = (st & 1) * 32 + (swz % 64) / 2; }
__host__ __device__ __forceinline__ int perm32(int rho) { const int n = rho >> 4, i = rho & 15; return 8 * (i >> 2) + 4 * n + (i & 3); }

struct Unit { int pm, pn, k0, nt, split; };
struct Gemm { const bf16_t* A; const bf16_t* Bt; int M, N, K; };

struct StaticOrder {
    int nM, nN, nwg, G, c, ntfull;
    __host__ __device__ void init(int M, int N, int K, int G_, int c_) { nM = M / BM; nN = N / BM; nwg = nM * nN; G = G_; c = c_; ntfull = K / BK; }
    __host__ __device__ bool next(int i, Unit& u) const {
        const long L = (long)i * G + c; if (L >= nwg) return false;
        int wgid = (int)L; { const int q = nwg / NXCD, r = nwg % NXCD, xcd = wgid % NXCD, off = wgid / NXCD; wgid = (xcd < r ? xcd * (q + 1) : r * (q + 1) + (xcd - r) * q) + off; }
        const int nig = WGM * nN, gid = wgid / nig, fm = gid * WGM, gsz = (nM - fm) < WGM ? (nM - fm) : WGM;
        u.pm = fm + ((wgid % nig) % gsz); u.pn = (wgid % nig) / gsz; u.k0 = 0; u.nt = ntfull; u.split = 0; return true;
    }
    __device__ __forceinline__ void a_ready(const Unit&) const {}
    __device__ __forceinline__ void done(const Unit&) const {}
};

struct SplitOrder {
    StaticOrder so; int nmain, nsplit, ntsub, nsub; unsigned* ready; unsigned need;
    __device__ void init(int Mmain, int N, int K, int klen, int G_, int c_, unsigned* ready_, unsigned need_) { so.init(Mmain, N, K, G_, c_); nmain = so.nwg; nsplit = K / klen; ntsub = klen / BK; nsub = (N / BM) * nsplit; ready = ready_; need = need_; }
    __device__ bool next(int i, Unit& u) const {
        if (so.next(i, u)) return true;
        const int nmine = (nmain - so.c + so.G - 1) / so.G;
        const int j = (i - nmine) * so.G + so.c;
        if (j < 0 || j >= nsub) return false;
        u.pm = so.nM; u.pn = j / nsplit; u.k0 = (j % nsplit) * ntsub * BK; u.nt = ntsub; u.split = 1; return true;
    }
    __device__ __forceinline__ void a_ready(const Unit& u) const {
        if (!u.split || need == 0u) return;
        if (threadIdx.x < 64) {
            unsigned polls = 0;
            while ((unsigned)__builtin_amdgcn_readfirstlane((int)__hip_atomic_load(ready, __ATOMIC_RELAXED, __HIP_MEMORY_SCOPE_AGENT)) < need) { __builtin_amdgcn_s_sleep(2); if (++polls > (1u << 22)) break; }
            __builtin_amdgcn_fence(__ATOMIC_ACQUIRE, "agent");
            asm volatile("s_waitcnt vmcnt(0)" ::: "memory");
        }
        asm volatile("" ::: "memory"); __builtin_amdgcn_s_barrier(); asm volatile("" ::: "memory");
    }
    __device__ __forceinline__ void done(const Unit&) const {}
};
struct SplitCtx { float* sum; int ldn; };
typedef float f32x2 __attribute__((ext_vector_type(2)));
typedef __bf16 bf16x2v __attribute__((ext_vector_type(2)));
__device__ __forceinline__ unsigned pk2(float lo, float hi) { f32x2 v = {lo, hi}; return __builtin_bit_cast(unsigned, __builtin_convertvector(v, bf16x2v)); }
__device__ __forceinline__ u32x4 pk8(const f32x4& a, const f32x4& b) { u32x4 w; w.x = pk2(a[0], a[1]); w.y = pk2(a[2], a[3]); w.z = pk2(b[0], b[1]); w.w = pk2(b[2], b[3]); return w; }
__device__ __forceinline__ float bflo(unsigned w) { return __builtin_bit_cast(float, w << 16); }
__device__ __forceinline__ float bfhi(unsigned w) { return __builtin_bit_cast(float, w & 0xffff0000u); }
__device__ __forceinline__ float sigmoidf_(float x) { return __builtin_amdgcn_rcpf(1.0f + __expf(-x)); }
template <class Epi, class Sched, bool ALIGN_EPI = false, bool SP2 = false>
__device__ __forceinline__ void gemm_phase(PG8_LAS unsigned char* lds, const Gemm g, const Sched& S, const Epi& E, const SplitCtx X = SplitCtx{nullptr, 0}) {
    int tid_ = threadIdx.x; asm volatile("" : "+v"(tid_));
    const int tid = tid_, wid = __builtin_amdgcn_readfirstlane(tid >> 6), lane = tid & 63, wr = wid >> 2, wc = wid & 3, fr = lane & 15, fq = lane >> 4;
    const int K = g.K;
    unsigned voffA[2], voffB[2];
#pragma unroll
    for (int i = 0; i < 2; ++i) { int R, C; stage_rc(tid * 16 + i * 8192, R, C); const int Rb = Epi::PERM ? ((R & ~31) + perm32(R & 31)) : R;
        voffA[i] = (unsigned)(R * K + C) * 2u; voffB[i] = (unsigned)(Rb * K + C) * 2u; }
    const size_t kstep = (size_t)(BK * 2);
    const size_t hstep = (size_t)HALF * K * 2;
    const size_t tstep = 2 * hstep;
    const unsigned ldsw = (unsigned)wid * 1024u;
    const int aoff = lds_byte(wr * 64 + fr, fq * 8), boff = lds_byte(wc * 32 + fr, fq * 8);
#define PG8_SA(b, h) (((b) * 2 + (h)) * HTB)
#define PG8_SB(b, h) ((4 + (b) * 2 + (h)) * HTB)
#define PG8_STAGE(bufoff, gbase, voff) do { _Pragma("unroll") for (int _i = 0; _i < 2; ++_i) \
        __builtin_amdgcn_global_load_lds((const unsigned*)((const char*)(gbase) + (voff)[_i]), (PG8_LAS unsigned*)(lds + (bufoff) + ldsw + _i * 8192), 16, 0, 0); } while (0)
#define PG8_LDA(dst, b, h) do { _Pragma("unroll") for (int m = 0; m < 4; ++m) _Pragma("unroll") for (int k = 0; k < 2; ++k) dst[m][k] = *(const PG8_LAS bf16x8*)(lds + PG8_SA(b, h) + aoff + m * 2048 + k * 1024); } while (0)
#define PG8_LDB(dst, b, h) do { _Pragma("unroll") for (int n = 0; n < 2; ++n) _Pragma("unroll") for (int k = 0; k < 2; ++k) dst[n][k] = *(const PG8_LAS bf16x8*)(lds + PG8_SB(b, h) + boff + n * 2048 + k * 1024); } while (0)
#define PG8_MMA(ai, bj, At, Bt) do { __builtin_amdgcn_s_setprio(1); _Pragma("unroll") for (int m = 0; m < 4; ++m) _Pragma("unroll") for (int n = 0; n < 2; ++n) _Pragma("unroll") for (int k = 0; k < 2; ++k) \
        acc[ai][bj][m][n] = __builtin_amdgcn_mfma_f32_16x16x32_bf16(Bt[n][k], At[m][k], acc[ai][bj][m][n], 0, 0, 0); __builtin_amdgcn_s_setprio(0); } while (0)
#define PG8_WAIT_V(n) asm volatile("s_waitcnt vmcnt(" #n ")" ::: "memory")
#define PG8_WAIT_L(n) asm volatile("s_waitcnt lgkmcnt(" #n ")" ::: "memory")
#define PG8_BAR __builtin_amdgcn_s_barrier()
#define PG8_SCHED __builtin_amdgcn_sched_barrier(0)
    Unit cur, nxt; int ui = 0;
    if (!S.next(0, cur)) return;
    f32x4 acc[2][2][4][2];
#pragma unroll
    for (int a = 0; a < 2; ++a)
#pragma unroll
        for (int b = 0; b < 2; ++b)
#pragma unroll
            for (int m = 0; m < 4; ++m)
#pragma unroll
                for (int n = 0; n < 2; ++n) acc[a][b][m][n] = (f32x4){0.f, 0.f, 0.f, 0.f};
    bf16x8 At[4][2], B0[2][2], B1[2][2];
    const char* cA = (const char*)g.A + (size_t)cur.pm * tstep + (size_t)cur.k0 * 2; const char* cB = (const char*)g.Bt + (size_t)cur.pn * tstep + (size_t)cur.k0 * 2;
    S.a_ready(cur);
    if constexpr (SP2) {
        PG8_STAGE(PG8_SB(0, 0), cB, voffB); PG8_STAGE(PG8_SB(0, 1), cB + hstep, voffB); PG8_STAGE(PG8_SA(0, 0), cA, voffA); PG8_STAGE(PG8_SA(0, 1), cA + hstep, voffA);
        if (wr == 1) PG8_BAR;
        PG8_WAIT_V(2); PG8_BAR;
        PG8_STAGE(PG8_SB(1, 0), cB + kstep, voffB); PG8_STAGE(PG8_SA(1, 0), cA + kstep, voffA); PG8_STAGE(PG8_SB(1, 1), cB + hstep + kstep, voffB);
        PG8_WAIT_V(6); PG8_BAR;
    } else {
        PG8_STAGE(PG8_SB(0, 0), cB, voffB); PG8_STAGE(PG8_SA(0, 0), cA, voffA); PG8_STAGE(PG8_SB(0, 1), cB + hstep, voffB); PG8_STAGE(PG8_SA(0, 1), cA + hstep, voffA);
        if (wr == 1) PG8_BAR;
        PG8_WAIT_V(4); PG8_BAR;
        PG8_STAGE(PG8_SB(1, 0), cB + kstep, voffB); PG8_STAGE(PG8_SA(1, 0), cA + kstep, voffA); PG8_STAGE(PG8_SB(1, 1), cB + hstep + kstep, voffB);
        PG8_WAIT_V(6); PG8_BAR;
    }
    for (;;) {
        const bool has_next = S.next(ui + 1, nxt);
        const char* nA = has_next ? (const char*)g.A + (size_t)nxt.pm * tstep + (size_t)nxt.k0 * 2 : cA; const char* nB = has_next ? (const char*)g.Bt + (size_t)nxt.pn * tstep + (size_t)nxt.k0 * 2 : cB;
        const int nt = cur.nt;
#pragma unroll 1
        for (int t = 0; t < nt; t += 2) {
            const bool last = (t == nt - 2);
            const char* a1 = cA + (size_t)(t + 1) * kstep;
            const char* a2 = last ? nA : cA + (size_t)(t + 2) * kstep; const char* b2 = last ? nB : cB + (size_t)(t + 2) * kstep;
            const char* a3 = a2 + kstep; const char* b3 = b2 + kstep;
            if (last && has_next) S.a_ready(nxt);
            if constexpr (SP2) {
            PG8_LDB(B0, 0, 0); PG8_LDB(B1, 0, 1); PG8_SCHED; PG8_LDA(At, 0, 0); PG8_STAGE(PG8_SA(1, 1), a1 + hstep, voffA);
            PG8_WAIT_V(8); PG8_WAIT_L(0); PG8_BAR; PG8_MMA(0, 0, At, B0); PG8_MMA(0, 1, At, B1); PG8_BAR; PG8_SCHED;
            PG8_LDA(At, 0, 1); PG8_STAGE(PG8_SB(0, 0), b2, voffB); PG8_STAGE(PG8_SB(0, 1), b2 + hstep, voffB); PG8_STAGE(PG8_SA(0, 0), a2, voffA);
            PG8_WAIT_V(8); PG8_WAIT_L(0); PG8_BAR; PG8_MMA(1, 0, At, B0); PG8_MMA(1, 1, At, B1); PG8_BAR; PG8_SCHED;
            PG8_LDB(B0, 1, 0); PG8_LDB(B1, 1, 1); PG8_SCHED; PG8_LDA(At, 1, 0); PG8_STAGE(PG8_SA(0, 1), a2 + hstep, voffA);
            PG8_WAIT_V(8); PG8_WAIT_L(0); PG8_BAR; PG8_MMA(0, 0, At, B0); PG8_MMA(0, 1, At, B1); PG8_BAR; PG8_SCHED;
            PG8_LDA(At, 1, 1); PG8_STAGE(PG8_SB(1, 0), b3, voffB); PG8_STAGE(PG8_SB(1, 1), b3 + hstep, voffB); PG8_STAGE(PG8_SA(1, 0), a3, voffA);
            PG8_WAIT_V(8); PG8_WAIT_L(0); PG8_BAR; PG8_MMA(1, 0, At, B0); PG8_MMA(1, 1, At, B1); PG8_BAR; PG8_SCHED;
            } else {
            PG8_LDB(B0, 0, 0); PG8_SCHED; PG8_LDA(At, 0, 0); PG8_STAGE(PG8_SA(1, 1), a1 + hstep, voffA);
            PG8_WAIT_L(8); PG8_BAR; PG8_WAIT_L(0); PG8_MMA(0, 0, At, B0); PG8_BAR; PG8_SCHED;
            PG8_LDB(B1, 0, 1); PG8_STAGE(PG8_SB(0, 0), b2, voffB);
            PG8_BAR; PG8_WAIT_L(0); PG8_MMA(0, 1, At, B1); PG8_BAR;
            PG8_LDA(At, 0, 1); PG8_STAGE(PG8_SA(0, 0), a2, voffA);
            PG8_BAR; PG8_WAIT_L(0); PG8_MMA(1, 0, At, B0); PG8_BAR; PG8_SCHED;
            PG8_STAGE(PG8_SB(0, 1), b2 + hstep, voffB);
            PG8_WAIT_V(6); PG8_BAR; PG8_MMA(1, 1, At, B1); PG8_BAR;
            PG8_LDB(B0, 1, 0); PG8_SCHED; PG8_LDA(At, 1, 0); PG8_STAGE(PG8_SA(0, 1), a2 + hstep, voffA);
            PG8_WAIT_L(8); PG8_BAR; PG8_WAIT_L(0); PG8_MMA(0, 0, At, B0); PG8_BAR; PG8_SCHED;
            PG8_LDB(B1, 1, 1); PG8_STAGE(PG8_SB(1, 0), b3, voffB);
            PG8_BAR; PG8_WAIT_L(0); PG8_MMA(0, 1, At, B1); PG8_BAR;
            PG8_LDA(At, 1, 1); PG8_STAGE(PG8_SA(1, 0), a3, voffA);
            PG8_BAR; PG8_WAIT_L(0); PG8_MMA(1, 0, At, B0); PG8_BAR; PG8_SCHED;
            PG8_STAGE(PG8_SB(1, 1), b3 + hstep, voffB);
            PG8_WAIT_V(6); PG8_BAR; PG8_MMA(1, 1, At, B1); PG8_BAR;
            }
        }
        if constexpr (ALIGN_EPI) { if (wr == 0) PG8_BAR; }
        bool do_epi = true;
        if (cur.split) {
            const size_t slice = (size_t)BM * X.ldn, rstep = (size_t)16 * X.ldn;
            float* rp = X.sum + (size_t)(cur.k0 / (cur.nt * BK)) * slice + (size_t)(wr * 64 + fr) * X.ldn + cur.pn * BM + wc * 32 + 8 * fq;
#pragma unroll
            for (int a = 0; a < 2; ++a) {
#pragma unroll
                for (int m = 0; m < 4; ++m) {
#pragma unroll
                    for (int b = 0; b < 2; ++b) { *(f32x4*)(rp + b * HALF) = acc[a][b][m][0]; *(f32x4*)(rp + b * HALF + 4) = acc[a][b][m][1]; }
                    rp += rstep;
                }
                rp += 4 * rstep;
            }
            do_epi = false;
        }
        if (do_epi) E(acc, cur, wr, wc, fr, fq);
        if (!has_next) break;
#pragma unroll
        for (int a = 0; a < 2; ++a)
#pragma unroll
            for (int b = 0; b < 2; ++b)
#pragma unroll
                for (int m = 0; m < 4; ++m)
#pragma unroll
                    for (int n = 0; n < 2; ++n) acc[a][b][m][n] = (f32x4){0.f, 0.f, 0.f, 0.f};
        cur = nxt; cA = nA; cB = nB; ++ui;
        if constexpr (ALIGN_EPI) { if (wr == 1) PG8_BAR; }
    }
    PG8_WAIT_V(0);
    if constexpr (!ALIGN_EPI) { if (wr == 0) PG8_BAR; }
    PG8_BAR;
    if constexpr (Epi::AFTER_DRAIN) { E.fused(acc, cur, wr, wc, fr, fq, lds, wid, lane); S.done(cur); }
#undef PG8_SA
#undef PG8_SB
#undef PG8_STAGE
#undef PG8_LDA
#undef PG8_LDB
#undef PG8_MMA
#undef PG8_WAIT_V
#undef PG8_WAIT_L
#undef PG8_BAR
#undef PG8_SCHED
}
}
constexpr int D = 1024, SEQ = 16384, MP = 2 * SEQ, MS = 256, MT = MP + MS, NIN = 1792, FF = 4096, DPLE = 256, CC = 512, QC = 512, KVC = 128;
constexpr float EPS = 1e-6f;
constexpr int NTHREADS = 512, NWAVES = 8;
constexpr int LDS_BYTES = 135168 + 256;
constexpr int MISC_OFF = 135168;
constexpr size_t WS_CTL = 0, CTL_ZERO_BYTES = 32768; constexpr int CW_SPLIT = 4096;
constexpr size_t OFF_Y = 0, OFF_NKP = (size_t)MT * D, OFF_NVP = OFF_NKP + 32768, OFF_NCP = OFF_NVP + 32768, OFF_NKS = OFF_NCP + 30720, OFF_NVS = OFF_NKS + 32768, OFF_NCS = OFF_NVS + 32768;
constexpr size_t MiB = 1u << 20;
constexpr size_t WS_WIN = 1 * MiB, WS_WOUT = 5 * MiB, WS_W1 = 7 * MiB, WS_W2 = 15 * MiB, WS_WG = 23 * MiB, WS_WP = 25 * MiB, WS_ROPE = 26 * MiB;
constexpr size_t WS_RSS1 = 30 * MiB, WS_RSS2 = 33 * MiB, WS_RSS3 = 36 * MiB;
constexpr size_t WS_HB = 40 * MiB, WS_PB = 105 * MiB, WS_PP = 122 * MiB, WS_HID = 188 * MiB;
constexpr size_t WS_A1 = 188 * MiB, WS_MIX = 253 * MiB, WS_U = 318 * MiB, WS_Q = 351 * MiB, WS_KB = 384 * MiB, WS_VB = 393 * MiB;
constexpr size_t WS_PART = 446 * MiB, WS_PARTB = 462 * MiB;
constexpr size_t WS_END = 478 * MiB;
static_assert(WS_HID + (size_t)MT * FF * 2 <= WS_PART && WS_VB + (size_t)MT * KVC * 2 <= WS_END && WS_PP + (size_t)MT * D * 2 <= WS_HID && WS_HB + (size_t)MT * D * 2 <= WS_PB && WS_PB + (size_t)MT * DPLE * 2 <= WS_PP, "ws map");

#define LAS __attribute__((address_space(3)))
typedef unsigned short bf16;
using pg8::f32x4; using pg8::u32x4; using pg8::bf16x8; using pg8::Unit;
typedef float f32x16 __attribute__((ext_vector_type(16)));
typedef unsigned u32x2 __attribute__((ext_vector_type(2)));
using pg8::pk2; using pg8::pk8; using pg8::bflo; using pg8::bfhi; using pg8::sigmoidf_;

struct Params { const float* in[22]; float* out; unsigned char* ws; };

__host__ __device__ __forceinline__ int win_dest(int c) {
    if (c < 512) return 256 * (c >> 7) + (c & 127);
    if (c < 1024) { c -= 512; return 256 * (c >> 7) + 128 + (c & 127); }
    if (c < 1536) { c -= 1024; const int hq = c >> 6, r = c & 63; return 256 * (4 + (hq >> 2)) + (r >> 5) * 128 + (hq & 3) * 32 + (r & 31); }
    if (c < 1664) { c -= 1536; const int hd = c >> 6, r = c & 63; return 1536 + (r >> 5) * 128 + hd * 32 + (r & 31); }
    c -= 1664; return 1536 + (c >> 6) * 128 + 64 + (c & 63);
}
__device__ __forceinline__ float wave_sum(float v) {
#pragma unroll
    for (int o = 1; o < 64; o <<= 1) v += __shfl_xor(v, o);
    return v;
}
#define LDS_WAIT() asm volatile("s_waitcnt lgkmcnt(0)" ::: "memory")

struct EpiIn {
    static constexpr bool PERM = true, AFTER_DRAIN = false;
    bf16 *U, *Q, *KB, *VB; const float* rope; float* out;
    __device__ __forceinline__ void operator()(const f32x4 (&acc)[2][2][4][2], const Unit& u, int wr, int wc, int fr, int fq) const {
        const int rowb = u.pm * 256 + wr * 64 + fr;
        if (u.pn < 4) {
            const int ch = 128 * u.pn + 32 * wc + 8 * fq;
#pragma unroll
            for (int ai = 0; ai < 2; ++ai)
#pragma unroll
                for (int m = 0; m < 4; ++m) {
                    const int row = rowb + ai * 128 + m * 16;
                    const bool isp = row < MP; const int srow = row - MP;
                    const int t = isp ? (row & (SEQ - 1)) : (srow & 31), bb = isp ? (row >> 14) : (srow >> 5);
                    f32x4 o0, o1;
#pragma unroll
                    for (int i = 0; i < 4; ++i) { o0[i] = acc[ai][0][m][0][i] * sigmoidf_(acc[ai][1][m][0][i]); o1[i] = acc[ai][0][m][1][i] * sigmoidf_(acc[ai][1][m][1][i]); }
                    *(u32x4*)(U + (size_t)row * CC + ch) = pk8(o0, o1);
                    float* dst = nullptr;
                    if (isp) { if (t >= SEQ - 30) dst = out + OFF_NCP + ((size_t)(bb * 30 + (t - (SEQ - 30)))) * CC + ch; }
                    else { if (t >= 2) dst = out + OFF_NCS + ((size_t)(bb * 30 + (t - 2))) * CC + ch; }
                    if (dst) { *(f32x4*)dst = o0; *(f32x4*)(dst + 4) = o1; }
                }
        } else if (u.pn < 6 || wc < 2) {
            const bool isq = u.pn < 6;
#pragma unroll
            for (int ai = 0; ai < 2; ++ai)
#pragma unroll
            for (int mh = 0; mh < 4; mh += 2) {
                f32x4 rp4[4][4];
#pragma unroll
                for (int m = mh; m < mh + 2; ++m) {
                    const int row = rowb + ai * 128 + m * 16;
                    const int pos = (row < MP) ? (row & (SEQ - 1)) : 2048 + ((row - MP) & 31);
                    const f32x4* rp = (const f32x4*)(rope + ((size_t)pos * 32 + 8 * fq) * 2);
                    rp4[m][0] = rp[0]; rp4[m][1] = rp[1]; rp4[m][2] = rp[2]; rp4[m][3] = rp[3];
                }
                asm volatile("" ::: "memory");
#pragma unroll
                for (int m = mh; m < mh + 2; ++m) {
                    const int row = rowb + ai * 128 + m * 16;
                    const bool isp = row < MP; const int srow = row - MP;
                    const int t = isp ? (row & (SEQ - 1)) : (srow & 31), bb = isp ? (row >> 14) : (srow >> 5);
                    bf16* op = isq ? Q + (size_t)row * QC + (4 * (u.pn - 4) + wc) * 64 + 8 * fq : KB + (size_t)row * KVC + wc * 64 + 8 * fq;
                    float* dst = nullptr;
                    if (!isq) {
                        if (isp) { if (t >= SEQ - 128) dst = out + OFF_NKP + ((size_t)((bb * 128 + (t - (SEQ - 128))) * 2 + wc)) * 64 + 8 * fq; }
                        else dst = out + OFF_NKS + ((size_t)(srow * 2 + wc)) * 64 + 8 * fq;
                    }
                    f32x4 a[2], b[2];
#pragma unroll
                    for (int n = 0; n < 2; ++n) {
                        const f32x4 r0 = rp4[m][2 * n], r1 = rp4[m][2 * n + 1];
                        const float cs[4] = {r0[0], r0[2], r1[0], r1[2]}, sn[4] = {r0[1], r0[3], r1[1], r1[3]};
#pragma unroll
                        for (int i = 0; i < 4; ++i) { const float x1 = acc[ai][0][m][n][i], x2 = acc[ai][1][m][n][i]; a[n][i] = x1 * cs[i] - x2 * sn[i]; b[n][i] = x2 * cs[i] + x1 * sn[i]; }
                    }
                    *(u32x4*)op = pk8(a[0], a[1]); *(u32x4*)(op + 32) = pk8(b[0], b[1]);
                    if (dst) { *(f32x4*)dst = a[0]; *(f32x4*)(dst + 4) = a[1]; *(f32x4*)(dst + 32) = b[0]; *(f32x4*)(dst + 36) = b[1]; }
                }
                asm volatile("" ::: "memory");
            }
        } else {
            const int dd = 32 * (wc - 2) + 8 * fq;
#pragma unroll
            for (int ai = 0; ai < 2; ++ai)
#pragma unroll
                for (int m = 0; m < 4; ++m) {
                    const int row = rowb + ai * 128 + m * 16;
                    const bool isp = row < MP; const int srow = row - MP;
                    const int t = isp ? (row & (SEQ - 1)) : (srow & 31), bb = isp ? (row >> 14) : (srow >> 5);
#pragma unroll
                    for (int bj = 0; bj < 2; ++bj) {
                        *(u32x4*)(VB + (size_t)row * KVC + 64 * bj + dd) = pk8(acc[ai][bj][m][0], acc[ai][bj][m][1]);
                        float* dst = nullptr;
                        if (isp) { if (t >= SEQ - 128) dst = out + OFF_NVP + ((size_t)((bb * 128 + (t - (SEQ - 128))) * 2 + bj)) * 64 + dd; }
                        else dst = out + OFF_NVS + ((size_t)(srow * 2 + bj)) * 64 + dd;
                        if (dst) { *(f32x4*)dst = acc[ai][bj][m][0]; *(f32x4*)(dst + 4) = acc[ai][bj][m][1]; }
                    }
                }
        }
    }
};
struct EpiPlain {
    static constexpr bool PERM = true, AFTER_DRAIN = false;
    bf16* O; int ldc;
    __device__ __forceinline__ void operator()(const f32x4 (&acc)[2][2][4][2], const Unit& u, int wr, int wc, int fr, int fq) const {
        const int rowb = u.pm * 256 + wr * 64 + fr, colb = u.pn * 256 + wc * 32 + 8 * fq;
#pragma unroll
        for (int ai = 0; ai < 2; ++ai)
#pragma unroll
            for (int m = 0; m < 4; ++m)
#pragma unroll
                for (int bj = 0; bj < 2; ++bj)
                    *(u32x4*)(O + (size_t)(rowb + ai * 128 + m * 16) * ldc + colb + bj * 128) = pk8(acc[ai][bj][m][0], acc[ai][bj][m][1]);
    }
};
__device__ __forceinline__ void wave_row_rs(const float* RSS, int base, int lane, int fr, float (&rs)[2][4]) {
    float r2[2];
#pragma unroll
    for (int a = 0; a < 2; ++a) {
        const f32x4* q = (const f32x4*)(RSS + (size_t)(base + 128 * a + lane) * 16);
        const f32x4 x0 = q[0], x1 = q[1], x2 = q[2], x3 = q[3];
        const float sm = (((x0[0] + x0[1]) + (x0[2] + x0[3])) + ((x1[0] + x1[1]) + (x1[2] + x1[3]))) + (((x2[0] + x2[1]) + (x2[2] + x2[3])) + ((x3[0] + x3[1]) + (x3[2] + x3[3])));
        r2[a] = __builtin_amdgcn_rsqf(sm * (1.0f / D) + EPS);
    }
#pragma unroll
    for (int a = 0; a < 2; ++a)
#pragma unroll
        for (int m = 0; m < 4; ++m) rs[a][m] = __shfl(r2[a], 16 * m + fr);
}
__device__ __forceinline__ float row_rs(const float* RSS, int row) {
    const f32x4* p = (const f32x4*)(RSS + (size_t)row * 16);
    const f32x4 a = p[0], b = p[1], c = p[2], d = p[3];
    const float s = ((a[0] + a[1]) + (a[2] + a[3])) + ((b[0] + b[1]) + (b[2] + b[3])) + ((c[0] + c[1]) + (c[2] + c[3])) + ((d[0] + d[1]) + (d[2] + d[3]));
    return __builtin_amdgcn_rsqf(s * (1.0f / D) + EPS);
}
template <bool FIRST>
struct EpiRes {
    static constexpr bool PERM = true, AFTER_DRAIN = false;
    const float* bp; const float* bs; bf16* HB; float* RSS; const float* RSSs = nullptr;
    bool seam = false; int ai0 = 0, ai1 = 2, m0 = 0, m1 = 4;
    __device__ __forceinline__ void operator()(const f32x4 (&acc)[2][2][4][2], const Unit& u, int wr, int wc, int fr, int fq) const {
        const int rowb = u.pm * 256 + wr * 64 + fr, colb = u.pn * 256 + wc * 32 + 8 * fq;
        float rs[2][4];
        if (!FIRST) wave_row_rs(RSSs, u.pm * 256 + wr * 64, fr + 16 * fq, fr, rs);
#pragma unroll
        for (int ai = 0; ai < 2; ++ai) if (ai >= ai0 && ai < ai1) {
            f32x4 bf[4][2][2]; u32x4 bw[4][2];
#pragma unroll
            for (int m = 0; m < 4; ++m) if (m >= m0 && m < m1) {
                const int row = rowb + ai * 128 + m * 16;
                if (FIRST) { const float* brow = (row < MP) ? bp + (size_t)row * D : bs + (size_t)(row - MP) * D;
#pragma unroll
                    for (int bj = 0; bj < 2; ++bj) { bf[m][bj][0] = *(const f32x4*)(brow + colb + bj * 128); bf[m][bj][1] = *(const f32x4*)(brow + colb + bj * 128 + 4); } }
                else {
#pragma unroll
                    for (int bj = 0; bj < 2; ++bj) bw[m][bj] = *(const u32x4*)(HB + (size_t)row * D + colb + bj * 128); }
            }
            asm volatile("" ::: "memory");
#pragma unroll
            for (int m = 0; m < 4; ++m) if (m >= m0 && m < m1) {
                const int row = rowb + ai * 128 + m * 16;
                float sc = 1.f; if (!FIRST) sc = rs[ai][m] * rs[ai][m];
                float ss = 0.f;
#pragma unroll
                for (int bj = 0; bj < 2; ++bj) {
                    const int col = colb + bj * 128;
                    f32x4 b0, b1;
                    if (FIRST) { b0 = bf[m][bj][0]; b1 = bf[m][bj][1]; }
                    else { const u32x4 w = bw[m][bj]; b0 = (f32x4){bflo(w.x), bfhi(w.x), bflo(w.y), bfhi(w.y)}; b1 = (f32x4){bflo(w.z), bfhi(w.z), bflo(w.w), bfhi(w.w)}; }
                    const f32x4 v0 = acc[ai][bj][m][0] * sc + b0, v1 = acc[ai][bj][m][1] * sc + b1;
                    *(u32x4*)(HB + (size_t)row * D + col) = pk8(v0, v1);
                    ss += (v0[0] * v0[0] + v0[1] * v0[1]) + (v0[2] * v0[2] + v0[3] * v0[3]) + (v1[0] * v1[0] + v1[1] * v1[1]) + (v1[2] * v1[2] + v1[3] * v1[3]);
                }
                ss += __shfl_xor(ss, 16); ss += __shfl_xor(ss, 32);
                if (fq == 0) RSS[(size_t)row * 16 + u.pn * 4 + wc] = ss;
            }
            asm volatile("" ::: "memory");
        }
    }
};
struct EpiFF1 {
    static constexpr bool PERM = true, AFTER_DRAIN = false;
    bf16* O; const float* RSS; bool seam = false; int ai0 = 0, ai1 = 2, m0 = 0, m1 = 4;
    __device__ __forceinline__ void operator()(const f32x4 (&acc)[2][2][4][2], const Unit& u, int wr, int wc, int fr, int fq) const {
        const int rowb = u.pm * 256 + wr * 64 + fr, colb = u.pn * 256 + wc * 32 + 8 * fq;
#pragma unroll
        for (int ai = 0; ai < 2; ++ai) if (ai >= ai0 && ai < ai1)
#pragma unroll
            for (int m = 0; m < 4; ++m) if (m >= m0 && m < m1) {
                const int row = rowb + ai * 128 + m * 16;
#pragma unroll
                for (int bj = 0; bj < 2; ++bj) {
                    f32x4 v0 = acc[ai][bj][m][0], v1 = acc[ai][bj][m][1];
#pragma unroll
                    for (int i = 0; i < 4; ++i) { const float a = fmaxf(v0[i], 0.f), b = fmaxf(v1[i], 0.f); v0[i] = a * a; v1[i] = b * b; }
                    *(u32x4*)(O + (size_t)row * FF + colb + bj * 128) = pk8(v0, v1);
                }
                if (seam) asm volatile("" ::: "memory");
            }
    }
};
struct EpiGate {
    static constexpr bool PERM = true, AFTER_DRAIN = false;
    const bf16* HB; bf16* H3B; const bf16* PP; const float* RSSin; float* RSSout; bool seam = false; int ai0 = 0, ai1 = 2, m0 = 0, m1 = 4;
    __device__ __forceinline__ void operator()(const f32x4 (&acc)[2][2][4][2], const Unit& u, int wr, int wc, int fr, int fq) const {
        const int rowb = u.pm * 256 + wr * 64 + fr, colb = u.pn * 256 + wc * 32 + 8 * fq;
        float rs[2][4];
        wave_row_rs(RSSin, u.pm * 256 + wr * 64, fr + 16 * fq, fr, rs);
#pragma unroll
        for (int ai = 0; ai < 2; ++ai) if (ai >= ai0 && ai < ai1) {
            u32x4 pwv[4][2], hwv[4][2];
#pragma unroll
            for (int m = 0; m < 4; ++m) if (m >= m0 && m < m1) {
                const int row = rowb + ai * 128 + m * 16;
#pragma unroll
                for (int bj = 0; bj < 2; ++bj) { pwv[m][bj] = *(const u32x4*)(PP + (size_t)row * D + colb + bj * 128); hwv[m][bj] = *(const u32x4*)(HB + (size_t)row * D + colb + bj * 128); }
            }
            asm volatile("" ::: "memory");
#pragma unroll
            for (int m = 0; m < 4; ++m) if (m >= m0 && m < m1) {
                const int row = rowb + ai * 128 + m * 16; const float r1 = rs[ai][m];
                float ss = 0.f;
#pragma unroll
                for (int bj = 0; bj < 2; ++bj) {
                    const int col = colb + bj * 128;
                    const u32x4 pw = pwv[m][bj], hw = hwv[m][bj];
                    const f32x4 p0 = {bflo(pw.x), bfhi(pw.x), bflo(pw.y), bfhi(pw.y)}, p1 = {bflo(pw.z), bfhi(pw.z), bflo(pw.w), bfhi(pw.w)};
                    f32x4 v0 = {bflo(hw.x), bfhi(hw.x), bflo(hw.y), bfhi(hw.y)}, v1 = {bflo(hw.z), bfhi(hw.z), bflo(hw.w), bfhi(hw.w)};
#pragma unroll
                    for (int i = 0; i < 4; ++i) { v0[i] += sigmoidf_(acc[ai][bj][m][0][i] * r1) * p0[i]; v1[i] += sigmoidf_(acc[ai][bj][m][1][i] * r1) * p1[i]; }
                    *(u32x4*)(H3B + (size_t)row * D + col) = pk8(v0, v1);
                    ss += (v0[0] * v0[0] + v0[1] * v0[1]) + (v0[2] * v0[2] + v0[3] * v0[3]) + (v1[0] * v1[0] + v1[1] * v1[1]) + (v1[2] * v1[2] + v1[3] * v1[3]);
                }
                ss += __shfl_xor(ss, 16); ss += __shfl_xor(ss, 32);
                if (fq == 0) RSSout[(size_t)row * 16 + u.pn * 4 + wc] = ss;
            }
            asm volatile("" ::: "memory");
        }
    }
};
template <bool MAP>
__device__ __forceinline__ void p0_transpose_item(const float* W, int K, int N, const float* gk, bf16* WT, LAS float* scr, int item, int lane) {
    const int nblk = N / 32, kb = item / nblk, nb = item % nblk, k0 = 64 * kb, n0 = 32 * nb;
#pragma unroll
    for (int i = 0; i < 32; ++i) { const int kk = 2 * i + (lane >> 5); float v = W[(size_t)(k0 + kk) * N + n0 + (lane & 31)]; if (gk) v *= gk[k0 + kk]; scr[kk * 33 + (lane & 31)] = v; }
    LDS_WAIT(); asm volatile("" ::: "memory");
    const int c = lane & 7, nd0 = MAP ? win_dest(n0) : n0;
#pragma unroll
    for (int j = 0; j < 4; ++j) { const int n = (lane >> 3) + 8 * j; const LAS float* s = scr + (8 * c) * 33 + n;
        u32x4 o; o.x = pk2(s[0 * 33], s[1 * 33]); o.y = pk2(s[2 * 33], s[3 * 33]); o.z = pk2(s[4 * 33], s[5 * 33]); o.w = pk2(s[6 * 33], s[7 * 33]);
        *(u32x4*)(WT + (size_t)(nd0 + n) * K + k0 + 8 * c) = o; }
    LDS_WAIT(); asm volatile("" ::: "memory");
}
__device__ __forceinline__ void p0_prologue(const Params& p, LAS unsigned char* lds, int G, int tid, int wid, int lane) {
    unsigned char* ws = p.ws;
    LAS float* scr = (LAS float*)(lds + wid * 16384);
    const int gw = blockIdx.x * NWAVES + wid, NGW = G * NWAVES;
    constexpr int I_IN = (D / 64) * (NIN / 32), I_O = (D / 64) * (D / 32), I_1 = (D / 64) * (FF / 32), I_2 = (FF / 64) * (D / 32), I_G = I_O, I_P = (DPLE / 64) * (D / 32);
    constexpr int NITEMS = I_IN + I_O + I_1 + I_2 + I_G + I_P;
    for (int it = gw; it < NITEMS; it += NGW) {
        int r = it;
        if (r < I_1) { p0_transpose_item<false>(p.in[16], D, FF, p.in[15], (bf16*)(ws + WS_W1), scr, r, lane); continue; } r -= I_1;
        if (r < I_2) { p0_transpose_item<false>(p.in[17], FF, D, nullptr, (bf16*)(ws + WS_W2), scr, r, lane); continue; } r -= I_2;
        if (r < I_IN) { p0_transpose_item<true>(p.in[8], D, NIN, nullptr, (bf16*)(ws + WS_WIN), scr, r, lane); continue; } r -= I_IN;
        if (r < I_O) { p0_transpose_item<false>(p.in[14], D, D, nullptr, (bf16*)(ws + WS_WOUT), scr, r, lane); continue; } r -= I_O;
        if (r < I_G) { p0_transpose_item<false>(p.in[19], D, D, p.in[18], (bf16*)(ws + WS_WG), scr, r, lane); continue; } r -= I_G;
        p0_transpose_item<false>(p.in[20], DPLE, D, nullptr, (bf16*)(ws + WS_WP), scr, r, lane);
    }
    const f32x4* g4 = (const f32x4*)p.in[7] + lane;
    bf16* A1 = (bf16*)(ws + WS_A1); bf16* PB = (bf16*)(ws + WS_PB);
    for (int row = gw * 2; row < MT; row += NGW * 2) {
        f32x4 v[2][4]; f32x4 pv[2]; float s[2];
#pragma unroll
        for (int k = 0; k < 2; ++k) {
            const int rr = row + k;
            const float* xr = (rr < MP) ? p.in[0] + (size_t)rr * D : p.in[1] + (size_t)(rr - MP) * D;
            const f32x4* x4 = (const f32x4*)xr + lane;
#pragma unroll
            for (int j = 0; j < 4; ++j) v[k][j] = x4[64 * j];
            const float* pr = (rr < MP) ? p.in[2] + (size_t)rr * DPLE : p.in[3] + (size_t)(rr - MP) * DPLE;
            pv[k] = ((const f32x4*)pr)[lane];
        }
#pragma unroll
        for (int k = 0; k < 2; ++k) {
            s[k] = 0.f;
#pragma unroll
            for (int j = 0; j < 4; ++j) s[k] += (v[k][j][0] * v[k][j][0] + v[k][j][1] * v[k][j][1]) + (v[k][j][2] * v[k][j][2] + v[k][j][3] * v[k][j][3]);
            const float rs = __builtin_amdgcn_rsqf(wave_sum(s[k]) * (1.0f / D) + EPS);
            u32x2* o = (u32x2*)(A1 + (size_t)(row + k) * D) + lane;
#pragma unroll
            for (int j = 0; j < 4; ++j) { const f32x4 g = g4[64 * j]; u32x2 w; w.x = pk2(v[k][j][0] * rs * g[0], v[k][j][1] * rs * g[1]); w.y = pk2(v[k][j][2] * rs * g[2], v[k][j][3] * rs * g[3]); o[64 * j] = w; }
            u32x2 w; w.x = pk2(pv[k][0], pv[k][1]); w.y = pk2(pv[k][2], pv[k][3]); ((u32x2*)(PB + (size_t)(row + k) * DPLE))[lane] = w;
        }
    }
    float* rope = (float*)(ws + WS_ROPE);
    for (int idx = blockIdx.x * NTHREADS + tid; idx < SEQ * 32; idx += G * NTHREADS) {
        const int pos = idx >> 5, d = idx & 31;
        const float inv = (float)(1.0 / exp2((double)d * (13.287712379549449 / 32.0)));
        const float ang = (float)pos * inv;
        const double a = (double)ang, k = rint(a * 0.15915494309189535);
        const double r = fma(-k, 1.2246467991473532e-16 * 2.0, fma(-k, 6.283185307179586, a));
        const float rf = (float)r;
        ((pg8::f32x2*)rope)[idx] = (pg8::f32x2){cosf(rf), sinf(rf)};
    }
}

constexpr int N_ATT_P = 2 * 256 * 2, N_ATT = N_ATT_P + 16, N_CONV_P = MP / 64, N_CONV = N_CONV_P + 4;
constexpr int DCP = 516;
static_assert(64 * DCP * 4 <= MISC_OFF, "conv tile fits under the barrier words");
__device__ __forceinline__ void conv_item(const Params& p, LAS unsigned char* lds, int item, int tid, int wid, int lane) {
    typedef pg8::f32x2 f2;
    const bf16* U = (const bf16*)(p.ws + WS_U); bf16* MIX = (bf16*)(p.ws + WS_MIX);
    LAS float* DC = (LAS float*)lds;
    const int half = wid >> 2, c2 = 2 * (tid & 255);
    const bool sample = item >= N_CONV_P;
    const int row0 = item * 64, rowh = row0 + 32 * half;
    f2 win[62];
    if (!sample) {
        const int t0 = rowh & (SEQ - 1);
#pragma unroll
        for (int k = 0; k < 62; ++k) {
            const int tk = t0 - 30 + k;
            unsigned w = *(const unsigned*)(U + (size_t)(rowh - 30 + k - (tk < 0 ? tk : 0)) * CC + c2);
            if (tk < 0) w = 0u;
            win[k] = (f2){bflo(w), bfhi(w)};
        }
    } else {
        const float* sc = p.in[6] + (size_t)((item - N_CONV_P) * 2 + half) * 30 * CC + c2;
#pragma unroll
        for (int k = 0; k < 30; ++k) win[k] = *(const f2*)(sc + (size_t)k * CC);
#pragma unroll
        for (int k = 30; k < 62; ++k) { const unsigned w = *(const unsigned*)(U + (size_t)(rowh - 30 + k) * CC + c2); win[k] = (f2){bflo(w), bfhi(w)}; }
    }
    f2 w[31];
#pragma unroll
    for (int j = 0; j < 31; ++j) w[j] = *(const f2*)(p.in[9] + j * CC + c2);
    const f2 bias = *(const f2*)(p.in[10] + c2);
#pragma unroll
    for (int r = 0; r < 32; ++r) {
        f2 a = bias;
#pragma unroll
        for (int j = 0; j < 31; ++j) a = w[j] * win[r + j] + a;
        *(LAS f2*)(DC + (32 * half + r) * DCP + c2) = a;
    }
    __syncthreads();
    const int c8 = lane * 8;
    const f32x4 g0 = *(const f32x4*)(p.in[11] + c8), g1 = *(const f32x4*)(p.in[11] + c8 + 4), b0 = *(const f32x4*)(p.in[12] + c8), b1 = *(const f32x4*)(p.in[12] + c8 + 4);
#pragma unroll
    for (int rr = 0; rr < 8; ++rr) {
        const int r = 8 * wid + rr;
        f32x4 x0 = *(const LAS f32x4*)(DC + r * DCP + c8), x1 = *(const LAS f32x4*)(DC + r * DCP + c8 + 4);
        const float mean = wave_sum((x0[0] + x0[1]) + (x0[2] + x0[3]) + (x1[0] + x1[1]) + (x1[2] + x1[3])) * (1.0f / CC);
        x0 = x0 - mean; x1 = x1 - mean;
        const float var = wave_sum((x0[0] * x0[0] + x0[1] * x0[1]) + (x0[2] * x0[2] + x0[3] * x0[3]) + (x1[0] * x1[0] + x1[1] * x1[1]) + (x1[2] * x1[2] + x1[3] * x1[3])) * (1.0f / CC);
        const float rstd = __builtin_amdgcn_rsqf(var + EPS);
        f32x4 y0 = x0 * rstd * g0 + b0, y1 = x1 * rstd * g1 + b1;
#pragma unroll
        for (int i = 0; i < 4; ++i) { y0[i] *= sigmoidf_(y0[i]); y1[i] *= sigmoidf_(y1[i]); }
        *(u32x4*)(MIX + (size_t)(row0 + r) * D + c8) = pk8(y0, y1);
    }
    __syncthreads();
}

constexpr int KSP = 144, VTP = 408, VT_OFF = 192 * KSP;
#define MFMA32(a, b, c) __builtin_amdgcn_mfma_f32_32x32x16_bf16((a), (b), (c), 0, 0, 0)
__device__ __forceinline__ void attn_item(const Params& p, LAS unsigned char* lds, int item, int tid, int wid, int lane) {
    const bf16* Q = (const bf16*)(p.ws + WS_Q); const bf16* KB = (const bf16*)(p.ws + WS_KB); const bf16* VB = (const bf16*)(p.ws + WS_VB); bf16* MIX = (bf16*)(p.ws + WS_MIX);
    const bool sample = item >= N_ATT_P;
    int b, n, kvh, kt0, kt1;
    if (!sample) { b = item >> 9; n = (item >> 1) & 255; kvh = item & 1; kt0 = (n >= 2) ? 0 : (n == 1 ? 2 : 4); kt1 = 6; }
    else { const int s = item - N_ATT_P; b = s >> 1; n = 0; kvh = s & 1; kt0 = 0; kt1 = 5; }
    const int keyrow0 = b * SEQ + (n - 2) * 64;
    if (!sample) {
        u32x4 kv[3], vv[3];
#pragma unroll
        for (int i = 0; i < 3; ++i) {
            const int id = tid + NTHREADS * i, j = id >> 3, c = id & 7, jc = j < 32 * kt0 ? 32 * kt0 : j;
            const size_t grow = (size_t)(keyrow0 + jc);
            kv[i] = *(const u32x4*)(KB + grow * KVC + kvh * 64 + c * 8); vv[i] = *(const u32x4*)(VB + grow * KVC + kvh * 64 + c * 8);
        }
#pragma unroll
        for (int i = 0; i < 3; ++i) {
            const int id = tid + NTHREADS * i, j = id >> 3, c = id & 7;
            if (j >= 32 * kt0) {
                *(LAS u32x4*)(lds + j * KSP + c * 16) = kv[i];
                LAS unsigned short* vt = (LAS unsigned short*)(lds + VT_OFF + (8 * c) * VTP) + j;
                vt[0 * (VTP / 2)] = (unsigned short)(vv[i].x & 0xffffu); vt[1 * (VTP / 2)] = (unsigned short)(vv[i].x >> 16);
                vt[2 * (VTP / 2)] = (unsigned short)(vv[i].y & 0xffffu); vt[3 * (VTP / 2)] = (unsigned short)(vv[i].y >> 16);
                vt[4 * (VTP / 2)] = (unsigned short)(vv[i].z & 0xffffu); vt[5 * (VTP / 2)] = (unsigned short)(vv[i].z >> 16);
                vt[6 * (VTP / 2)] = (unsigned short)(vv[i].w & 0xffffu); vt[7 * (VTP / 2)] = (unsigned short)(vv[i].w >> 16);
            }
        }
    } else {
#pragma unroll
    for (int i = 0; i < 3; ++i) {
        const int id = tid + NTHREADS * i, j = id >> 3, c = id & 7;
        if (j >= 32 * kt0 && j < 32 * kt1) {
            u32x4 kv, vv;
            if (!sample || j >= 128) {
                const size_t grow = sample ? (size_t)(MP + b * 32 + (j - 128)) : (size_t)(keyrow0 + j);
                kv = *(const u32x4*)(KB + grow * KVC + kvh * 64 + c * 8); vv = *(const u32x4*)(VB + grow * KVC + kvh * 64 + c * 8);
            } else {
                const size_t off = ((size_t)(b * 128 + j) * 2 + kvh) * 64 + c * 8;
                const f32x4 k0 = *(const f32x4*)(p.in[4] + off), k1 = *(const f32x4*)(p.in[4] + off + 4), v0 = *(const f32x4*)(p.in[5] + off), v1 = *(const f32x4*)(p.in[5] + off + 4);
                kv = pk8(k0, k1); vv = pk8(v0, v1);
            }
            *(LAS u32x4*)(lds + j * KSP + c * 16) = kv;
            LAS unsigned short* vt = (LAS unsigned short*)(lds + VT_OFF + (8 * c) * VTP) + j;
            vt[0 * (VTP / 2)] = (unsigned short)(vv.x & 0xffffu); vt[1 * (VTP / 2)] = (unsigned short)(vv.x >> 16);
            vt[2 * (VTP / 2)] = (unsigned short)(vv.y & 0xffffu); vt[3 * (VTP / 2)] = (unsigned short)(vv.y >> 16);
            vt[4 * (VTP / 2)] = (unsigned short)(vv.z & 0xffffu); vt[5 * (VTP / 2)] = (unsigned short)(vv.z >> 16);
            vt[6 * (VTP / 2)] = (unsigned short)(vv.w & 0xffffu); vt[7 * (VTP / 2)] = (unsigned short)(vv.w >> 16);
        }
    }
    }
    __syncthreads();
    const int g = wid >> 1, qh = wid & 1, head = kvh * 4 + g, q = lane & 31, h = lane >> 5;
    if (!sample || qh == 0) {
        const size_t qrow = sample ? (size_t)(MP + b * 32 + q) : (size_t)(b * SEQ + n * 64 + qh * 32 + q);
        bf16x8 bq[4];
#pragma unroll
        for (int ks = 0; ks < 4; ++ks) bq[ks] = *(const bf16x8*)(Q + qrow * QC + head * 64 + ks * 16 + 8 * h);
        f32x16 st[6];
#pragma unroll
        for (int kt = 0; kt < 6; ++kt) {
#pragma unroll
            for (int r = 0; r < 16; ++r) st[kt][r] = 0.f;
            if (kt >= kt0 && kt < kt1) {
#pragma unroll
                for (int ks = 0; ks < 4; ++ks) { const bf16x8 a = *(const LAS bf16x8*)(lds + (32 * kt + q) * KSP + (16 * ks + 8 * h) * 2); st[kt] = MFMA32(a, bq[ks], st[kt]); }
            }
        }
        const float sk = p.in[13][head];
        float mx = sk;
#pragma unroll
        for (int kt = 0; kt < 6; ++kt) if (kt >= kt0 && kt < kt1) {
#pragma unroll
            for (int r = 0; r < 16; ++r) mx = fmaxf(mx, st[kt][r] * 0.125f);
        }
        mx = fmaxf(mx, __shfl_xor(mx, 32));
        float sum = 0.f;
#pragma unroll
        for (int kt = 0; kt < 6; ++kt) if (kt >= kt0 && kt < kt1) {
#pragma unroll
            for (int r = 0; r < 16; ++r) { const float e = __expf(st[kt][r] * 0.125f - mx); st[kt][r] = e; sum += e; }
        }
        sum += __shfl_xor(sum, 32); sum += __expf(sk - mx);
        f32x16 o[2];
#pragma unroll
        for (int r = 0; r < 16; ++r) { o[0][r] = 0.f; o[1][r] = 0.f; }
#pragma unroll
        for (int kt = 0; kt < 6; ++kt) if (kt >= kt0 && kt < kt1) {
#pragma unroll
            for (int s = 0; s < 2; ++s) {
                u32x4 pw; pw.x = pk2(st[kt][8 * s + 0], st[kt][8 * s + 1]); pw.y = pk2(st[kt][8 * s + 2], st[kt][8 * s + 3]); pw.z = pk2(st[kt][8 * s + 4], st[kt][8 * s + 5]); pw.w = pk2(st[kt][8 * s + 6], st[kt][8 * s + 7]);
                const bf16x8 pb = __builtin_bit_cast(bf16x8, pw);
#pragma unroll
                for (int dt = 0; dt < 2; ++dt) {
                    const LAS unsigned char* vp = lds + VT_OFF + (32 * dt + q) * VTP + (32 * kt + 16 * s + 4 * h) * 2;
                    const u32x2 lo = *(const LAS u32x2*)vp, hi = *(const LAS u32x2*)(vp + 16);
                    const u32x4 aw = {lo.x, lo.y, hi.x, hi.y};
                    o[dt] = MFMA32(__builtin_bit_cast(bf16x8, aw), pb, o[dt]);
                }
            }
        }
        const float inv = 1.0f / sum;
        bf16* op = MIX + qrow * D + CC + head * 64 + 4 * h;
#pragma unroll
        for (int dt = 0; dt < 2; ++dt)
#pragma unroll
            for (int gq = 0; gq < 4; ++gq) { u32x2 w; w.x = pk2(o[dt][4 * gq + 0] * inv, o[dt][4 * gq + 1] * inv); w.y = pk2(o[dt][4 * gq + 2] * inv, o[dt][4 * gq + 3] * inv); *(u32x2*)(op + 32 * dt + 8 * gq) = w; }
    }
    __syncthreads();
}

#define XB_TMO      128
#define XB_XCNT(j)  (256  + 64 * (j))
#define XB_XSUB(j)  (1280 + 64 * (j))
#define XB_XGEN(j)  (2304 + 64 * (j))
#define XB_TOP      3328
#define XB_TOPGEN   3392
#define XCD_BAR_WORDS 3456
#define XB_SPIN_CAP (1u << 18)

__device__ __forceinline__ unsigned xb_ld(unsigned* p)              { return __hip_atomic_load(p, __ATOMIC_RELAXED, __HIP_MEMORY_SCOPE_AGENT); }
__device__ __forceinline__ unsigned xb_add(unsigned* p, unsigned v) { return __hip_atomic_fetch_add(p, v, __ATOMIC_RELAXED, __HIP_MEMORY_SCOPE_AGENT); }
__device__ __forceinline__ unsigned xb_xcc_id() { return (unsigned)__builtin_amdgcn_s_getreg((3 << 11) | 20) & 0xFu; }
#define XB_SPIN(cond, bar) do { unsigned _sp = 0; while (cond) { __builtin_amdgcn_s_sleep(1); \
    if ((++_sp & 255u) == 0u) { if (xb_ld(&(bar)[XB_TMO])) break; if (_sp > XB_SPIN_CAP) { atomicAdd(&(bar)[XB_TMO], 1u); break; } } } } while (0)

struct XcdBarrier {
    unsigned* bar; unsigned x;
    volatile LAS unsigned* st;
};

__device__ __forceinline__ XcdBarrier xcd_barrier_post(unsigned* bar, volatile LAS unsigned* st) {
    XcdBarrier b; b.bar = bar; b.x = xb_xcc_id(); b.st = st;
    if (threadIdx.x == 0) (void)xb_add(&bar[XB_XCNT(b.x)], 1u);
    return b;
}
__device__ __forceinline__ void xcd_barrier_complete(unsigned* bar, unsigned x, unsigned& nloc, unsigned& nx) {
    const unsigned G = gridDim.x * gridDim.y * gridDim.z;
    unsigned sum, cnt, mine, sp = 0u;
    for (;;) {
        sum = 0u; cnt = 0u; mine = 0u;
#pragma unroll
        for (unsigned j = 0; j < 16; ++j) { const unsigned c = xb_ld(&bar[XB_XCNT(j)]); sum += c; cnt += (c > 0u) ? 1u : 0u; mine = (j == x) ? c : mine; }
        if (sum == G) break;
        __builtin_amdgcn_s_sleep(1);
        if ((++sp & 255u) == 0u) { if (xb_ld(&bar[XB_TMO])) break; if (sp > XB_SPIN_CAP) { atomicAdd(&bar[XB_TMO], 1u); break; } }
    }
    nloc = mine > 0u ? mine : 1u; nx = cnt > 0u ? cnt : 1u;
}

__device__ __forceinline__ void xcd_barrier(const XcdBarrier& b) {
    asm volatile("s_waitcnt vmcnt(0)" ::: "memory");
    __syncthreads();
    if (threadIdx.x == 0) {
        unsigned* bar = b.bar;
        __builtin_amdgcn_s_waitcnt(0);
        unsigned nloc = b.st[0], nx = b.st[1];
        if (nloc == 0u) { xcd_barrier_complete(bar, b.x, nloc, nx); b.st[0] = nloc; b.st[1] = nx; }
        const unsigned old = xb_add(&bar[XB_XSUB(b.x)], 1u);
        const unsigned gen = old / nloc;
        if (old + 1u == (gen + 1u) * nloc) {
            __builtin_amdgcn_fence(__ATOMIC_RELEASE, "agent");
            asm volatile("s_waitcnt vmcnt(0)" ::: "memory");
            const unsigned og = xb_add(&bar[XB_TOP], 1u);
            const unsigned tg = og / nx;
            if (og + 1u == (tg + 1u) * nx) xb_add(&bar[XB_TOPGEN], 1u);
            else XB_SPIN(xb_ld(&bar[XB_TOPGEN]) == tg, bar);
            __builtin_amdgcn_fence(__ATOMIC_ACQUIRE, "agent");
            xb_add(&bar[XB_XGEN(b.x)], 1u);
            asm volatile("s_waitcnt vmcnt(0)" ::: "memory");
        } else {
            XB_SPIN(xb_ld(&bar[XB_XGEN(b.x)]) == gen, bar);
            __builtin_amdgcn_fence(__ATOMIC_ACQUIRE, "agent");
            asm volatile("s_waitcnt vmcnt(0)" ::: "memory");
        }
    }
    __syncthreads();
}


template <int NS, class Epi>
__device__ __forceinline__ void sample_fixup(const float* part, int ldn, int item, const Epi& E, unsigned* cnt) {
    int tid_ = threadIdx.x; asm volatile("" : "+v"(tid_));
    const int lane = tid_ & 63, wid = __builtin_amdgcn_readfirstlane(tid_ >> 6), wr = wid >> 2, wc = wid & 3, fr = lane & 15, fq = lane >> 4;
    const int pn = item >> 3, ah = (item >> 2) & 1, mh = item & 3;
    const size_t slice = (size_t)256 * ldn;
    const float* q = part + (size_t)(ah * 128 + wr * 64 + mh * 16 + fr) * ldn + pn * 256 + wc * 32 + 8 * fq;
    f32x4 s0 = {0.f, 0.f, 0.f, 0.f}, s1 = s0, s2 = s0, s3 = s0;
#pragma unroll
    for (int k4 = 0; k4 < NS; k4 += 4) {
        f32x4 l[4][4];
#pragma unroll
        for (int ks = 0; ks < 4; ++ks) { l[ks][0] = *(const f32x4*)(q); l[ks][1] = *(const f32x4*)(q + 4); l[ks][2] = *(const f32x4*)(q + 128); l[ks][3] = *(const f32x4*)(q + 132); q += slice; }
        s0 += (l[0][0] + l[1][0]) + (l[2][0] + l[3][0]); s1 += (l[0][1] + l[1][1]) + (l[2][1] + l[3][1]); s2 += (l[0][2] + l[1][2]) + (l[2][2] + l[3][2]); s3 += (l[0][3] + l[1][3]) + (l[2][3] + l[3][3]);
    }
    Unit u; u.pm = MP / 256; u.pn = pn; u.k0 = 0; u.nt = 0; u.split = 0;
#pragma unroll
    for (int a = 0; a < 2; ++a)
#pragma unroll
        for (int m = 0; m < 4; ++m)
            if (a == ah && m == mh) {
                f32x4 acc[2][2][4][2];
#pragma unroll
                for (int x = 0; x < 2; ++x)
#pragma unroll
                    for (int b = 0; b < 2; ++b)
#pragma unroll
                        for (int y = 0; y < 4; ++y) { acc[x][b][y][0] = (f32x4){0.f, 0.f, 0.f, 0.f}; acc[x][b][y][1] = (f32x4){0.f, 0.f, 0.f, 0.f}; }
                acc[a][0][m][0] = s0; acc[a][0][m][1] = s1; acc[a][1][m][0] = s2; acc[a][1][m][1] = s3;
                Epi Eh = E; Eh.ai0 = a; Eh.ai1 = a + 1; Eh.m0 = m; Eh.m1 = m + 1;
                Eh(acc, u, wr, wc, fr, fq);
            }
    if (cnt) {
        asm volatile("s_waitcnt vmcnt(0)" ::: "memory");
        __syncthreads();
        if (wid == 0) {
            __builtin_amdgcn_fence(__ATOMIC_RELEASE, "agent");
            asm volatile("s_waitcnt vmcnt(0)" ::: "memory");
            if (lane == 0) (void)__hip_atomic_fetch_add(cnt, 1u, __ATOMIC_RELAXED, __HIP_MEMORY_SCOPE_AGENT);
        }
    }
}

__device__ __forceinline__ void p7_rows(float* out, const bf16* H3B, const float* RSS3, const float* gfin, int row0, int row_end, int step) {
    int t7 = threadIdx.x; asm volatile("" : "+v"(t7));
    const int lane = t7 & 63, wid = __builtin_amdgcn_readfirstlane(t7 >> 6);
    const f32x4* g4 = (const f32x4*)gfin + 2 * lane;
    const f32x4 ga = g4[0], gb = g4[1], gc = g4[128], gd = g4[129];
    for (int row = row0 + wid * 2; row < row_end; row += step) {
        float part[2]; u32x4 w[2][2];
#pragma unroll
        for (int k = 0; k < 2; ++k) {
            part[k] = RSS3[(size_t)(row + k) * 16 + (lane & 15)]; if (lane >= 16) part[k] = 0.f;
            const u32x4* hp = (const u32x4*)(H3B + (size_t)(row + k) * D) + lane;
            w[k][0] = hp[0]; w[k][1] = hp[64];
        }
#pragma unroll
        for (int k = 0; k < 2; ++k) {
            const float rs = __builtin_amdgcn_rsqf(wave_sum(part[k]) * (1.0f / D) + EPS);
            f32x4* o = (f32x4*)(out + (size_t)(row + k) * D) + 2 * lane;
            const u32x4 a = w[k][0], b = w[k][1];
            o[0] = (f32x4){bflo(a.x), bfhi(a.x), bflo(a.y), bfhi(a.y)} * rs * ga; o[1] = (f32x4){bflo(a.z), bfhi(a.z), bflo(a.w), bfhi(a.w)} * rs * gb;
            o[128] = (f32x4){bflo(b.x), bfhi(b.x), bflo(b.y), bfhi(b.y)} * rs * gc; o[129] = (f32x4){bflo(b.z), bfhi(b.z), bflo(b.w), bfhi(b.w)} * rs * gd;
        }
    }
}

__global__ void __launch_bounds__(NTHREADS, 2) fwd_megakernel(Params p) {
    extern __shared__ __attribute__((aligned(16))) unsigned char lds_raw[];
    LAS unsigned char* lds = (LAS unsigned char*)lds_raw;
    cg::grid_group grid = cg::this_grid();
    const int tid = threadIdx.x, lane = tid & 63, wid = __builtin_amdgcn_readfirstlane(tid >> 6), G = gridDim.x, bx = blockIdx.x;
    unsigned char* ws = p.ws;
    bf16* A1 = (bf16*)(ws + WS_A1); bf16* HB = (bf16*)(ws + WS_HB); bf16* PB = (bf16*)(ws + WS_PB); bf16* PP = (bf16*)(ws + WS_PP); bf16* HID = (bf16*)(ws + WS_HID); bf16* MIX = (bf16*)(ws + WS_MIX); bf16* H3B = (bf16*)(ws + WS_A1);
    unsigned* ctl = (unsigned*)(ws + WS_CTL);
    float* RSS1 = (float*)(ws + WS_RSS1); float* RSS2 = (float*)(ws + WS_RSS2); float* RSS3 = (float*)(ws + WS_RSS3);

    volatile LAS unsigned* MISC = (volatile LAS unsigned*)(lds + MISC_OFF);
    if (tid < 64) MISC[tid] = 0u;
    __syncthreads();
    XcdBarrier bar = xcd_barrier_post((unsigned*)(ws + WS_CTL), MISC + 8);
    p0_prologue(p, lds, G, tid, wid, lane);
    if (p.ws == nullptr) grid.sync();
    xcd_barrier(bar);
    {
        pg8::Gemm g{A1, (const bf16*)(ws + WS_WIN), MT, NIN, D}; pg8::StaticOrder S; S.init(MT, NIN, D, G, bx);
        EpiIn E{(bf16*)(ws + WS_U), (bf16*)(ws + WS_Q), (bf16*)(ws + WS_KB), (bf16*)(ws + WS_VB), (const float*)(ws + WS_ROPE), p.out};
        pg8::gemm_phase<EpiIn, pg8::StaticOrder, true, true>(lds, g, S, E);
        pg8::Gemm g2{PB, (const bf16*)(ws + WS_WP), MT, D, DPLE}; pg8::StaticOrder S2; S2.init(MT, D, DPLE, G, G - 1 - bx);
        EpiPlain E2{PP, D};
        pg8::gemm_phase<EpiPlain, pg8::StaticOrder, true, true>(lds, g2, S2, E2);
    }
    xcd_barrier(bar);
    for (int it = bx; it < N_ATT; it += G) { if (G == 256 && bx >= G - 4 && it == bx + 3 * G) continue; attn_item(p, lds, it, tid, wid, lane); }
    if (G == 256 && bx >= 16 && bx < 20) attn_item(p, lds, (G - 4 + (bx - 16)) + 3 * G, tid, wid, lane);
    for (int it = G - 1 - bx; it < N_CONV; it += G) conv_item(p, lds, it, tid, wid, lane);
    xcd_barrier(bar);
    float* PARTA = (float*)(ws + WS_PART); float* PARTB = (float*)(ws + WS_PARTB);
    unsigned* cnt3 = ctl + CW_SPLIT; unsigned* cnt4 = ctl + CW_SPLIT + 64; unsigned* cnt5 = ctl + CW_SPLIT + 128;
    {
        pg8::Gemm g{MIX, (const bf16*)(ws + WS_WOUT), MT, D, D}; pg8::SplitOrder S; S.init(MP, D, D, 256, G, bx, nullptr, 0u);
        EpiRes<true> E{p.in[0], p.in[1], HB, RSS1};
        pg8::gemm_phase<EpiRes<true>, pg8::SplitOrder, true, true>(lds, g, S, E, pg8::SplitCtx{PARTA, D});
    }
    xcd_barrier(bar);
    {
        if (bx >= G - 32) { EpiRes<true> Ef{p.in[0], p.in[1], HB, RSS1}; sample_fixup<4>(PARTA, D, G - 1 - bx, Ef, cnt3); }
        pg8::Gemm g{HB, (const bf16*)(ws + WS_W1), MT, FF, D}; pg8::SplitOrder S; S.init(MP, FF, D, 256, G, bx, cnt3, 32u);
        EpiFF1 E{HID, RSS1};
        pg8::gemm_phase<EpiFF1, pg8::SplitOrder, true, true>(lds, g, S, E, pg8::SplitCtx{PARTB, FF});
    }
    xcd_barrier(bar);
    {
        if (bx >= G - 128) { EpiFF1 Ef{HID, RSS1}; sample_fixup<4>(PARTB, FF, G - 1 - bx, Ef, cnt4); }
        pg8::Gemm g{HID, (const bf16*)(ws + WS_W2), MT, D, FF}; pg8::SplitOrder S; S.init(MP, D, FF, 512, G, bx, cnt4, 128u);
        EpiRes<false> E{nullptr, nullptr, HB, RSS2, RSS1};
        pg8::gemm_phase<EpiRes<false>, pg8::SplitOrder, true, true>(lds, g, S, E, pg8::SplitCtx{PARTA, D});
    }
    xcd_barrier(bar);
    {
        if (bx >= G - 32) { EpiRes<false> Ef{nullptr, nullptr, HB, RSS2, RSS1}; sample_fixup<8>(PARTA, D, G - 1 - bx, Ef, cnt5); }
        pg8::Gemm g{HB, (const bf16*)(ws + WS_WG), MT, D, D}; pg8::SplitOrder S; S.init(MP, D, D, 256, G, bx, cnt5, 32u);
        EpiGate E{HB, H3B, PP, RSS2, RSS3};
        pg8::gemm_phase<EpiGate, pg8::SplitOrder, true, true>(lds, g, S, E, pg8::SplitCtx{PARTB, D});
    }
    xcd_barrier(bar);
    if (G != 256) {
        if (bx >= G - 32) { EpiGate Ef{HB, H3B, PP, RSS2, RSS3}; sample_fixup<4>(PARTB, D, G - 1 - bx, Ef, nullptr); }
        p7_rows(p.out, H3B, RSS3, p.in[21], bx * NWAVES * 2, MP, G * NWAVES * 2);
        xcd_barrier(bar);
        p7_rows(p.out, H3B, RSS3, p.in[21], MP + bx * NWAVES * 2, MT, G * NWAVES * 2);
    } else if (bx >= G - 32) {
        const int f = bx - (G - 32);
        { EpiGate Ef{HB, H3B, PP, RSS2, RSS3}; sample_fixup<4>(PARTB, D, G - 1 - bx, Ef, nullptr); }
        unsigned* cnt6 = ctl + CW_SPLIT + 192;
        asm volatile("s_waitcnt vmcnt(0)" ::: "memory");
        __syncthreads();
        if (tid < 64) {
            __builtin_amdgcn_fence(__ATOMIC_RELEASE, "agent");
            asm volatile("s_waitcnt vmcnt(0)" ::: "memory");
            if (lane == 0) (void)__hip_atomic_fetch_add(cnt6, 1u, __ATOMIC_RELAXED, __HIP_MEMORY_SCOPE_AGENT);
            unsigned polls = 0;
            while ((unsigned)__builtin_amdgcn_readfirstlane((int)__hip_atomic_load(cnt6, __ATOMIC_RELAXED, __HIP_MEMORY_SCOPE_AGENT)) < 32u) { __builtin_amdgcn_s_sleep(2); if (++polls > (1u << 22)) break; }
            __builtin_amdgcn_fence(__ATOMIC_ACQUIRE, "agent");
            asm volatile("s_waitcnt vmcnt(0)" ::: "memory");
        }
        __syncthreads();
        p7_rows(p.out, H3B, RSS3, p.in[21], MP + f * 8, MP + f * 8 + 8, 16);
        p7_rows(p.out, H3B, RSS3, p.in[21], (1792 + f) * 16, 1952 * 16, 32 * 16);
    } else {
        p7_rows(p.out, H3B, RSS3, p.in[21], bx * 16, 1792 * 16, 224 * 16);
        if (bx < 96) p7_rows(p.out, H3B, RSS3, p.in[21], (1952 + bx) * 16, (1952 + bx) * 16 + 16, 16);
    }
}

extern "C" void kernel_launch(void* const* d_in, const int* in_sizes, int n_in, void* d_out, int out_size, void* d_ws, size_t ws_size, hipStream_t stream) {
    static int grid_blocks = 0;
    if (grid_blocks == 0) {
        if (n_in != 22 || ws_size < WS_END) { fprintf(stderr, "kernel_launch: unexpected n_in %d / ws_size %zu\n", n_in, ws_size); grid_blocks = -1; return; }
        int dev = 0, cus = 0, per_cu = 0;
        (void)hipGetDevice(&dev);
        (void)hipDeviceGetAttribute(&cus, hipDeviceAttributeMultiprocessorCount, dev);
        (void)hipFuncSetAttribute((const void*)fwd_megakernel, hipFuncAttributeMaxDynamicSharedMemorySize, LDS_BYTES);
        (void)hipOccupancyMaxActiveBlocksPerMultiprocessor(&per_cu, (const void*)fwd_megakernel, NTHREADS, LDS_BYTES);
        if (per_cu < 1) { fprintf(stderr, "kernel_launch: occupancy query reports %d blocks per CU\n", per_cu); per_cu = 1; }
        if (per_cu > 1) per_cu = 1;
        grid_blocks = cus * per_cu;
    }
    if (grid_blocks < 0) return;
    Params p{};
    for (int i = 0; i < 22; ++i) p.in[i] = (const float*)d_in[i];
    p.out = (float*)d_out; p.ws = (unsigned char*)d_ws;
    (void)hipMemsetAsync((char*)d_ws + WS_CTL, 0, CTL_ZERO_BYTES, stream);
    void* args[] = {&p};
    hipError_t e = hipLaunchCooperativeKernel((const void*)fwd_megakernel, dim3(grid_blocks), dim3(NTHREADS), args, LDS_BYTES, stream);
    if (e != hipSuccess) fprintf(stderr, "cooperative launch failed: %s (grid %d)\n", hipGetErrorString(e), grid_blocks);
}
```

```cpp
#include <hip/hip_runtime.h>
#include <hip/hip_cooperative_groups.h>
#include <cstdio>
#include <cstdint>
namespace cg = cooperative_groups;

namespace pg8 {
#define PG8_LAS __attribute__((address_space(3)))
typedef unsigned short bf16_t;
typedef short bf16x8 __attribute__((ext_vector_type(8)));
typedef float f32x4 __attribute__((ext_vector_type(4)));
typedef unsigned u32x4 __attribute__((ext_vector_type(4)));
constexpr int BM = 256, BK = 64, HALF = 128, HTB = HALF * BK * 2  , STAGE_BYTES = 8 * HTB, NXCD = 8, WGM = 8;

__host__ __device__ __forceinline__ int lds_byte(int r, int c) { const int st = (r >> 4) * 2 + (c >> 5), rr = r & 15, cc = c & 31, ob = rr * 64 + cc * 2; return st * 1024 + (ob ^ (((ob >> 9) & 1) << 5)); }
__host__ __device__ __forceinline__ void stage_rc(int b, int& R, int& C) { const int st = b / 1024, sb = b % 1024, swz = sb ^ (((sb >> 9) & 1) << 5); R = (st >> 1) * 16 + swz / 64; C = (st & 1) * 32 + (swz % 64) / 2; }
__host__ __device__ __forceinline__ int perm32(int rho) { const int n = rho >> 4, i = rho & 15; return 8 * (i >> 2) + 4 * n + (i & 3); }

struct Unit { int pm, pn, k0, nt, split; };
struct Gemm { const bf16_t* A; const bf16_t* Bt; int M, N, K; };

struct StaticOrder {
    int nM, nN, nwg, G, c, ntfull;
    __host__ __device__ void init(int M, int N, int K, int G_, int c_) { nM = M / BM; nN = N / BM; nwg = nM * nN; G = G_; c = c_; ntfull = K / BK; }
    __host__ __device__ bool next(int i, Unit& u) const {
        const long L = (long)i * G + c; if (L >= nwg) return false;
        int wgid = (int)L; { const int q = nwg / NXCD, r = nwg % NXCD, xcd = wgid % NXCD, off = wgid / NXCD; wgid = (xcd < r ? xcd * (q + 1) : r * (q + 1) + (xcd - r) * q) + off; }
        const int nig = WGM * nN, gid = wgid / nig, fm = gid * WGM, gsz = (nM - fm) < WGM ? (nM - fm) : WGM;
        u.pm = fm + ((wgid % nig) % gsz); u.pn = (wgid % nig) / gsz; u.k0 = 0; u.nt = ntfull; u.split = 0; return true;
    }
    __device__ __forceinline__ void a_ready(const Unit&) const {}
    __device__ __forceinline__ void done(const Unit&) const {}
};

struct SplitOrder {
    StaticOrder so; int nmain, nsplit, ntsub, nsub; unsigned* ready; unsigned need;
    __device__ void init(int Mmain, int N, int K, int klen, int G_, int c_, unsigned* ready_, unsigned need_) { so.init(Mmain, N, K, G_, c_); nmain = so.nwg; nsplit = K / klen; ntsub = klen / BK; nsub = (N / BM) * nsplit; ready = ready_; need = need_; }
    __device__ bool next(int i, Unit& u) const {
        if (so.next(i, u)) return true;
        const int nmine = (nmain - so.c + so.G - 1) / so.G;
        const int j = (i - nmine) * so.G + so.c;
        if (j < 0 || j >= nsub) return false;
        u.pm = so.nM; u.pn = j / nsplit; u.k0 = (j % nsplit) * ntsub * BK; u.nt = ntsub; u.split = 1; return true;
    }
    __device__ __forceinline__ void a_ready(const Unit& u) const {
        if (!u.split || need == 0u) return;
        if (threadIdx.x < 64) {
            unsigned polls = 0;
            while ((unsigned)__builtin_amdgcn_readfirstlane((int)__hip_atomic_load(ready, __ATOMIC_RELAXED, __HIP_MEMORY_SCOPE_AGENT)) < need) { __builtin_amdgcn_s_sleep(2); if (++polls > (1u << 22)) break; }
            __builtin_amdgcn_fence(__ATOMIC_ACQUIRE, "agent");
            asm volatile("s_waitcnt vmcnt(0)" ::: "memory");
        }
        asm volatile("" ::: "memory"); __builtin_amdgcn_s_barrier(); asm volatile("" ::: "memory");
    }
    __device__ __forceinline__ void done(const Unit&) const {}
};
struct SplitCtx { float* sum; int ldn; };
typedef float f32x2 __attribute__((ext_vector_type(2)));
typedef __bf16 bf16x2v __attribute__((ext_vector_type(2)));
__device__ __forceinline__ unsigned pk2(float lo, float hi) { f32x2 v = {lo, hi}; return __builtin_bit_cast(unsigned, __builtin_convertvector(v, bf16x2v)); }
__device__ __forceinline__ u32x4 pk8(const f32x4& a, const f32x4& b) { u32x4 w; w.x = pk2(a[0], a[1]); w.y = pk2(a[2], a[3]); w.z = pk2(b[0], b[1]); w.w = pk2(b[2], b[3]); return w; }
__device__ __forceinline__ float bflo(unsigned w) { return __builtin_bit_cast(float, w << 16); }
__device__ __forceinline__ float bfhi(unsigned w) { return __builtin_bit_cast(float, w & 0xffff0000u); }
__device__ __forceinline__ float sigmoidf_(float x) { return __builtin_amdgcn_rcpf(1.0f + __expf(-x)); }
template <class Epi, class Sched, bool ALIGN_EPI = false, bool SP2 = false>
__device__ __forceinline__ void gemm_phase(PG8_LAS unsigned char* lds, const Gemm g, const Sched& S, const Epi& E, const SplitCtx X = SplitCtx{nullptr, 0}) {
    int tid_ = threadIdx.x; asm volatile("" : "+v"(tid_));
    const int tid = tid_, wid = __builtin_amdgcn_readfirstlane(tid >> 6), lane = tid & 63, wr = wid >> 2, wc = wid & 3, fr = lane & 15, fq = lane >> 4;
    const int K = g.K;
    unsigned voffA[2], voffB[2];
#pragma unroll
    for (int i = 0; i < 2; ++i) { int R, C; stage_rc(tid * 16 + i * 8192, R, C); const int Rb = Epi::PERM ? ((R & ~31) + perm32(R & 31)) : R;
        voffA[i] = (unsigned)(R * K + C) * 2u; voffB[i] = (unsigned)(Rb * K + C) * 2u; }
    const size_t kstep = (size_t)(BK * 2);
    const size_t hstep = (size_t)HALF * K * 2;
    const size_t tstep = 2 * hstep;
    const unsigned ldsw = (unsigned)wid * 1024u;
    const int aoff = lds_byte(wr * 64 + fr, fq * 8), boff = lds_byte(wc * 32 + fr, fq * 8);
#define PG8_SA(b, h) (((b) * 2 + (h)) * HTB)
#define PG8_SB(b, h) ((4 + (b) * 2 + (h)) * HTB)
#define PG8_STAGE(bufoff, gbase, voff) do { _Pragma("unroll") for (int _i = 0; _i < 2; ++_i) \
        __builtin_amdgcn_global_load_lds((const unsigned*)((const char*)(gbase) + (voff)[_i]), (PG8_LAS unsigned*)(lds + (bufoff) + ldsw + _i * 8192), 16, 0, 0); } while (0)
#define PG8_LDA(dst, b, h) do { _Pragma("unroll") for (int m = 0; m < 4; ++m) _Pragma("unroll") for (int k = 0; k < 2; ++k) dst[m][k] = *(const PG8_LAS bf16x8*)(lds + PG8_SA(b, h) + aoff + m * 2048 + k * 1024); } while (0)
#define PG8_LDB(dst, b, h) do { _Pragma("unroll") for (int n = 0; n < 2; ++n) _Pragma("unroll") for (int k = 0; k < 2; ++k) dst[n][k] = *(const PG8_LAS bf16x8*)(lds + PG8_SB(b, h) + boff + n * 2048 + k * 1024); } while (0)
#define PG8_MMA(ai, bj, At, Bt) do { __builtin_amdgcn_s_setprio(1); _Pragma("unroll") for (int m = 0; m < 4; ++m) _Pragma("unroll") for (int n = 0; n < 2; ++n) _Pragma("unroll") for (int k = 0; k < 2; ++k) \
        acc[ai][bj][m][n] = __builtin_amdgcn_mfma_f32_16x16x32_bf16(Bt[n][k], At[m][k], acc[ai][bj][m][n], 0, 0, 0); __builtin_amdgcn_s_setprio(0); } while (0)
#define PG8_WAIT_V(n) asm volatile("s_waitcnt vmcnt(" #n ")" ::: "memory")
#define PG8_WAIT_L(n) asm volatile("s_waitcnt lgkmcnt(" #n ")" ::: "memory")
#define PG8_BAR __builtin_amdgcn_s_barrier()
#define PG8_SCHED __builtin_amdgcn_sched_barrier(0)
    Unit cur, nxt; int ui = 0;
    if (!S.next(0, cur)) return;
    f32x4 acc[2][2][4][2];
#pragma unroll
    for (int a = 0; a < 2; ++a)
#pragma unroll
        for (int b = 0; b < 2; ++b)
#pragma unroll
            for (int m = 0; m < 4; ++m)
#pragma unroll
                for (int n = 0; n < 2; ++n) acc[a][b][m][n] = (f32x4){0.f, 0.f, 0.f, 0.f};
    bf16x8 At[4][2], B0[2][2], B1[2][2];
    const char* cA = (const char*)g.A + (size_t)cur.pm * tstep + (size_t)cur.k0 * 2; const char* cB = (const char*)g.Bt + (size_t)cur.pn * tstep + (size_t)cur.k0 * 2;
    S.a_ready(cur);
    if constexpr (SP2) {
        PG8_STAGE(PG8_SB(0, 0), cB, voffB); PG8_STAGE(PG8_SB(0, 1), cB + hstep, voffB); PG8_STAGE(PG8_SA(0, 0), cA, voffA); PG8_STAGE(PG8_SA(0, 1), cA + hstep, voffA);
        if (wr == 1) PG8_BAR;
        PG8_WAIT_V(2); PG8_BAR;
        PG8_STAGE(PG8_SB(1, 0), cB + kstep, voffB); PG8_STAGE(PG8_SA(1, 0), cA + kstep, voffA); PG8_STAGE(PG8_SB(1, 1), cB + hstep + kstep, voffB);
        PG8_WAIT_V(6); PG8_BAR;
    } else {
        PG8_STAGE(PG8_SB(0, 0), cB, voffB); PG8_STAGE(PG8_SA(0, 0), cA, voffA); PG8_STAGE(PG8_SB(0, 1), cB + hstep, voffB); PG8_STAGE(PG8_SA(0, 1), cA + hstep, voffA);
        if (wr == 1) PG8_BAR;
        PG8_WAIT_V(4); PG8_BAR;
        PG8_STAGE(PG8_SB(1, 0), cB + kstep, voffB); PG8_STAGE(PG8_SA(1, 0), cA + kstep, voffA); PG8_STAGE(PG8_SB(1, 1), cB + hstep + kstep, voffB);
        PG8_WAIT_V(6); PG8_BAR;
    }
    for (;;) {
        const bool has_next = S.next(ui + 1, nxt);
        const char* nA = has_next ? (const char*)g.A + (size_t)nxt.pm * tstep + (size_t)nxt.k0 * 2 : cA; const char* nB = has_next ? (const char*)g.Bt + (size_t)nxt.pn * tstep + (size_t)nxt.k0 * 2 : cB;
        const int nt = cur.nt;
#pragma unroll 1
        for (int t = 0; t < nt; t += 2) {
            const bool last = (t == nt - 2);
            const char* a1 = cA + (size_t)(t + 1) * kstep;
            const char* a2 = last ? nA : cA + (size_t)(t + 2) * kstep; const char* b2 = last ? nB : cB + (size_t)(t + 2) * kstep;
            const char* a3 = a2 + kstep; const char* b3 = b2 + kstep;
            if (last && has_next) S.a_ready(nxt);
            if constexpr (SP2) {
            PG8_LDB(B0, 0, 0); PG8_LDB(B1, 0, 1); PG8_SCHED; PG8_LDA(At, 0, 0); PG8_STAGE(PG8_SA(1, 1), a1 + hstep, voffA);
            PG8_WAIT_V(8); PG8_WAIT_L(0); PG8_BAR; PG8_MMA(0, 0, At, B0); PG8_MMA(0, 1, At, B1); PG8_BAR; PG8_SCHED;
            PG8_LDA(At, 0, 1); PG8_STAGE(PG8_SB(0, 0), b2, voffB); PG8_STAGE(PG8_SB(0, 1), b2 + hstep, voffB); PG8_STAGE(PG8_SA(0, 0), a2, voffA);
            PG8_WAIT_V(8); PG8_WAIT_L(0); PG8_BAR; PG8_MMA(1, 0, At, B0); PG8_MMA(1, 1, At, B1); PG8_BAR; PG8_SCHED;
            PG8_LDB(B0, 1, 0); PG8_LDB(B1, 1, 1); PG8_SCHED; PG8_LDA(At, 1, 0); PG8_STAGE(PG8_SA(0, 1), a2 + hstep, voffA);
            PG8_WAIT_V(8); PG8_WAIT_L(0); PG8_BAR; PG8_MMA(0, 0, At, B0); PG8_MMA(0, 1, At, B1); PG8_BAR; PG8_SCHED;
            PG8_LDA(At, 1, 1); PG8_STAGE(PG8_SB(1, 0), b3, voffB); PG8_STAGE(PG8_SB(1, 1), b3 + hstep, voffB); PG8_STAGE(PG8_SA(1, 0), a3, voffA);
            PG8_WAIT_V(8); PG8_WAIT_L(0); PG8_BAR; PG8_MMA(1, 0, At, B0); PG8_MMA(1, 1, At, B1); PG8_BAR; PG8_SCHED;
            } else {
            PG8_LDB(B0, 0, 0); PG8_SCHED; PG8_LDA(At, 0, 0); PG8_STAGE(PG8_SA(1, 1), a1 + hstep, voffA);
            PG8_WAIT_L(8); PG8_BAR; PG8_WAIT_L(0); PG8_MMA(0, 0, At, B0); PG8_BAR; PG8_SCHED;
            PG8_LDB(B1, 0, 1); PG8_STAGE(PG8_SB(0, 0), b2, voffB);
            PG8_BAR; PG8_WAIT_L(0); PG8_MMA(0, 1, At, B1); PG8_BAR;
            PG8_LDA(At, 0, 1); PG8_STAGE(PG8_SA(0, 0), a2, voffA);
            PG8_BAR; PG8_WAIT_L(0); PG8_MMA(1, 0, At, B0); PG8_BAR; PG8_SCHED;
            PG8_STAGE(PG8_SB(0, 1), b2 + hstep, voffB);
            PG8_WAIT_V(6); PG8_BAR; PG8_MMA(1, 1, At, B1); PG8_BAR;
            PG8_LDB(B0, 1, 0); PG8_SCHED; PG8_LDA(At, 1, 0); PG8_STAGE(PG8_SA(0, 1), a2 + hstep, voffA);
            PG8_WAIT_L(8); PG8_BAR; PG8_WAIT_L(0); PG8_MMA(0, 0, At, B0); PG8_BAR; PG8_SCHED;
            PG8_LDB(B1, 1, 1); PG8_STAGE(PG8_SB(1, 0), b3, voffB);
            PG8_BAR; PG8_WAIT_L(0); PG8_MMA(0, 1, At, B1); PG8_BAR;
            PG8_LDA(At, 1, 1); PG8_STAGE(PG8_SA(1, 0), a3, voffA);
            PG8_BAR; PG8_WAIT_L(0); PG8_MMA(1, 0, At, B0); PG8_BAR; PG8_SCHED;
            PG8_STAGE(PG8_SB(1, 1), b3 + hstep, voffB);
            PG8_WAIT_V(6); PG8_BAR; PG8_MMA(1, 1, At, B1); PG8_BAR;
            }
        }
        if constexpr (ALIGN_EPI) { if (wr == 0) PG8_BAR; }
        bool do_epi = true;
        if (cur.split) {
            const size_t slice = (size_t)BM * X.ldn, rstep = (size_t)16 * X.ldn;
            float* rp = X.sum + (size_t)(cur.k0 / (cur.nt * BK)) * slice + (size_t)(wr * 64 + fr) * X.ldn + cur.pn * BM + wc * 32 + 8 * fq;
#pragma unroll
            for (int a = 0; a < 2; ++a) {
#pragma unroll
                for (int m = 0; m < 4; ++m) {
#pragma unroll
                    for (int b = 0; b < 2; ++b) { *(f32x4*)(rp + b * HALF) = acc[a][b][m][0]; *(f32x4*)(rp + b * HALF + 4) = acc[a][b][m][1]; }
                    rp += rstep;
                }
                rp += 4 * rstep;
            }
            do_epi = false;
        }
        if (do_epi) E(acc, cur, wr, wc, fr, fq);
        if (!has_next) break;
#pragma unroll
        for (int a = 0; a < 2; ++a)
#pragma unroll
            for (int b = 0; b < 2; ++b)
#pragma unroll
                for (int m = 0; m < 4; ++m)
#pragma unroll
                    for (int n = 0; n < 2; ++n) acc[a][b][m][n] = (f32x4){0.f, 0.f, 0.f, 0.f};
        cur = nxt; cA = nA; cB = nB; ++ui;
        if constexpr (ALIGN_EPI) { if (wr == 1) PG8_BAR; }
    }
    PG8_WAIT_V(0);
    if constexpr (!ALIGN_EPI) { if (wr == 0) PG8_BAR; }
    PG8_BAR;
    if constexpr (Epi::AFTER_DRAIN) { E.fused(acc, cur, wr, wc, fr, fq, lds, wid, lane); S.done(cur); }
#undef PG8_SA
#undef PG8_SB
#undef PG8_STAGE
#undef PG8_LDA
#undef PG8_LDB
#undef PG8_MMA
#undef PG8_WAIT_V
#undef PG8_WAIT_L
#undef PG8_BAR
#undef PG8_SCHED
}
}
constexpr int D = 1024, SEQ = 16384, MP = 2 * SEQ, MS = 256, MT = MP + MS, NIN = 1792, FF = 4096, DPLE = 256, CC = 512, QC = 512, KVC = 128;
constexpr float EPS = 1e-6f;
constexpr int NTHREADS = 512, NWAVES = 8;
constexpr int LDS_BYTES = 135168 + 256;
constexpr int MISC_OFF = 135168;
constexpr size_t WS_CTL = 0, CTL_ZERO_BYTES = 32768; constexpr int CW_SPLIT = 4096;
constexpr size_t OFF_Y = 0, OFF_NKP = (size_t)MT * D, OFF_NVP = OFF_NKP + 32768, OFF_NCP = OFF_NVP + 32768, OFF_NKS = OFF_NCP + 30720, OFF_NVS = OFF_NKS + 32768, OFF_NCS = OFF_NVS + 32768;
constexpr size_t MiB = 1u << 20;
constexpr size_t WS_WIN = 1 * MiB, WS_WOUT = 5 * MiB, WS_W1 = 7 * MiB, WS_W2 = 15 * MiB, WS_WG = 23 * MiB, WS_WP = 25 * MiB, WS_ROPE = 26 * MiB;
constexpr size_t WS_RSS1 = 30 * MiB, WS_RSS2 = 33 * MiB, WS_RSS3 = 36 * MiB;
constexpr size_t WS_HB = 40 * MiB, WS_PB = 105 * MiB, WS_PP = 122 * MiB, WS_HID = 188 * MiB;
constexpr size_t WS_A1 = 188 * MiB, WS_MIX = 253 * MiB, WS_U = 318 * MiB, WS_Q = 351 * MiB, WS_KB = 384 * MiB, WS_VB = 393 * MiB;
constexpr size_t WS_PART = 446 * MiB, WS_PARTB = 462 * MiB;
constexpr size_t WS_END = 478 * MiB;
static_assert(WS_HID + (size_t)MT * FF * 2 <= WS_PART && WS_VB + (size_t)MT * KVC * 2 <= WS_END && WS_PP + (size_t)MT * D * 2 <= WS_HID && WS_HB + (size_t)MT * D * 2 <= WS_PB && WS_PB + (size_t)MT * DPLE * 2 <= WS_PP, "ws map");

#define LAS __attribute__((address_space(3)))
typedef unsigned short bf16;
using pg8::f32x4; using pg8::u32x4; using pg8::bf16x8; using pg8::Unit;
typedef float f32x16 __attribute__((ext_vector_type(16)));
typedef unsigned u32x2 __attribute__((ext_vector_type(2)));
using pg8::pk2; using pg8::pk8; using pg8::bflo; using pg8::bfhi; using pg8::sigmoidf_;

struct Params { const float* in[22]; float* out; unsigned char* ws; };

__host__ __device__ __forceinline__ int win_dest(int c) {
    if (c < 512) return 256 * (c >> 7) + (c & 127);
    if (c < 1024) { c -= 512; return 256 * (c >> 7) + 128 + (c & 127); }
    if (c < 1536) { c -= 1024; const int hq = c >> 6, r = c & 63; return 256 * (4 + (hq >> 2)) + (r >> 5) * 128 + (hq & 3) * 32 + (r & 31); }
    if (c < 1664) { c -= 1536; const int hd = c >> 6, r = c & 63; return 1536 + (r >> 5) * 128 + hd * 32 + (r & 31); }
    c -= 1664; return 1536 + (c >> 6) * 128 + 64 + (c & 63);
}
__device__ __forceinline__ float wave_sum(float v) {
#pragma unroll
    for (int o = 1; o < 64; o <<= 1) v += __shfl_xor(v, o);
    return v;
}
#define LDS_WAIT() asm volatile("s_waitcnt lgkmcnt(0)" ::: "memory")

struct EpiIn {
    static constexpr bool PERM = true, AFTER_DRAIN = false;
    bf16 *U, *Q, *KB, *VB; const float* rope; float* out;
    __device__ __forceinline__ void operator()(const f32x4 (&acc)[2][2][4][2], const Unit& u, int wr, int wc, int fr, int fq) const {
        const int rowb = u.pm * 256 + wr * 64 + fr;
        if (u.pn < 4) {
            const int ch = 128 * u.pn + 32 * wc + 8 * fq;
#pragma unroll
            for (int ai = 0; ai < 2; ++ai)
#pragma unroll
                for (int m = 0; m < 4; ++m) {
                    const int row = rowb + ai * 128 + m * 16;
                    const bool isp = row < MP; const int srow = row - MP;
                    const int t = isp ? (row & (SEQ - 1)) : (srow & 31), bb = isp ? (row >> 14) : (srow >> 5);
                    f32x4 o0, o1;
#pragma unroll
                    for (int i = 0; i < 4; ++i) { o0[i] = acc[ai][0][m][0][i] * sigmoidf_(acc[ai][1][m][0][i]); o1[i] = acc[ai][0][m][1][i] * sigmoidf_(acc[ai][1][m][1][i]); }
                    *(u32x4*)(U + (size_t)row * CC + ch) = pk8(o0, o1);
                    float* dst = nullptr;
                    if (isp) { if (t >= SEQ - 30) dst = out + OFF_NCP + ((size_t)(bb * 30 + (t - (SEQ - 30)))) * CC + ch; }
                    else { if (t >= 2) dst = out + OFF_NCS + ((size_t)(bb * 30 + (t - 2))) * CC + ch; }
                    if (dst) { *(f32x4*)dst = o0; *(f32x4*)(dst + 4) = o1; }
                }
        } else if (u.pn < 6 || wc < 2) {
            const bool isq = u.pn < 6;
#pragma unroll
            for (int ai = 0; ai < 2; ++ai)
#pragma unroll
            for (int mh = 0; mh < 4; mh += 2) {
                f32x4 rp4[4][4];
#pragma unroll
                for (int m = mh; m < mh + 2; ++m) {
                    const int row = rowb + ai * 128 + m * 16;
                    const int pos = (row < MP) ? (row & (SEQ - 1)) : 2048 + ((row - MP) & 31);
                    const f32x4* rp = (const f32x4*)(rope + ((size_t)pos * 32 + 8 * fq) * 2);
                    rp4[m][0] = rp[0]; rp4[m][1] = rp[1]; rp4[m][2] = rp[2]; rp4[m][3] = rp[3];
                }
                asm volatile("" ::: "memory");
#pragma unroll
                for (int m = mh; m < mh + 2; ++m) {
                    const int row = rowb + ai * 128 + m * 16;
                    const bool isp = row < MP; const int srow = row - MP;
                    const int t = isp ? (row & (SEQ - 1)) : (srow & 31), bb = isp ? (row >> 14) : (srow >> 5);
                    bf16* op = isq ? Q + (size_t)row * QC + (4 * (u.pn - 4) + wc) * 64 + 8 * fq : KB + (size_t)row * KVC + wc * 64 + 8 * fq;
                    float* dst = nullptr;
                    if (!isq) {
                        if (isp) { if (t >= SEQ - 128) dst = out + OFF_NKP + ((size_t)((bb * 128 + (t - (SEQ - 128))) * 2 + wc)) * 64 + 8 * fq; }
                        else dst = out + OFF_NKS + ((size_t)(srow * 2 + wc)) * 64 + 8 * fq;
                    }
                    f32x4 a[2], b[2];
#pragma unroll
                    for (int n = 0; n < 2; ++n) {
                        const f32x4 r0 = rp4[m][2 * n], r1 = rp4[m][2 * n + 1];
                        const float cs[4] = {r0[0], r0[2], r1[0], r1[2]}, sn[4] = {r0[1], r0[3], r1[1], r1[3]};
#pragma unroll
                        for (int i = 0; i < 4; ++i) { const float x1 = acc[ai][0][m][n][i], x2 = acc[ai][1][m][n][i]; a[n][i] = x1 * cs[i] - x2 * sn[i]; b[n][i] = x2 * cs[i] + x1 * sn[i]; }
                    }
                    *(u32x4*)op = pk8(a[0], a[1]); *(u32x4*)(op + 32) = pk8(b[0], b[1]);
                    if (dst) { *(f32x4*)dst = a[0]; *(f32x4*)(dst + 4) = a[1]; *(f32x4*)(dst + 32) = b[0]; *(f32x4*)(dst + 36) = b[1]; }
                }
                asm volatile("" ::: "memory");
            }
        } else {
            const int dd = 32 * (wc - 2) + 8 * fq;
#pragma unroll
            for (int ai = 0; ai < 2; ++ai)
#pragma unroll
                for (int m = 0; m < 4; ++m) {
                    const int row = rowb + ai * 128 + m * 16;
                    const bool isp = row < MP; const int srow = row - MP;
                    const int t = isp ? (row & (SEQ - 1)) : (srow & 31), bb = isp ? (row >> 14) : (srow >> 5);
#pragma unroll
                    for (int bj = 0; bj < 2; ++bj) {
                        *(u32x4*)(VB + (size_t)row * KVC + 64 * bj + dd) = pk8(acc[ai][bj][m][0], acc[ai][bj][m][1]);
                        float* dst = nullptr;
                        if (isp) { if (t >= SEQ - 128) dst = out + OFF_NVP + ((size_t)((bb * 128 + (t - (SEQ - 128))) * 2 + bj)) * 64 + dd; }
                        else dst = out + OFF_NVS + ((size_t)(srow * 2 + bj)) * 64 + dd;
                        if (dst) { *(f32x4*)dst = acc[ai][bj][m][0]; *(f32x4*)(dst + 4) = acc[ai][bj][m][1]; }
                    }
                }
        }
    }
};
struct EpiPlain {
    static constexpr bool PERM = true, AFTER_DRAIN = false;
    bf16* O; int ldc;
    __device__ __forceinline__ void operator()(const f32x4 (&acc)[2][2][4][2], const Unit& u, int wr, int wc, int fr, int fq) const {
        const int rowb = u.pm * 256 + wr * 64 + fr, colb = u.pn * 256 + wc * 32 + 8 * fq;
#pragma unroll
        for (int ai = 0; ai < 2; ++ai)
#pragma unroll
            for (int m = 0; m < 4; ++m)
#pragma unroll
                for (int bj = 0; bj < 2; ++bj)
                    *(u32x4*)(O + (size_t)(rowb + ai * 128 + m * 16) * ldc + colb + bj * 128) = pk8(acc[ai][bj][m][0], acc[ai][bj][m][1]);
    }
};
__device__ __forceinline__ void wave_row_rs(const float* RSS, int base, int lane, int fr, float (&rs)[2][4]) {
    float r2[2];
#pragma unroll
    for (int a = 0; a < 2; ++a) {
        const f32x4* q = (const f32x4*)(RSS + (size_t)(base + 128 * a + lane) * 16);
        const f32x4 x0 = q[0], x1 = q[1], x2 = q[2], x3 = q[3];
        const float sm = (((x0[0] + x0[1]) + (x0[2] + x0[3])) + ((x1[0] + x1[1]) + (x1[2] + x1[3]))) + (((x2[0] + x2[1]) + (x2[2] + x2[3])) + ((x3[0] + x3[1]) + (x3[2] + x3[3])));
        r2[a] = __builtin_amdgcn_rsqf(sm * (1.0f / D) + EPS);
    }
#pragma unroll
    for (int a = 0; a < 2; ++a)
#pragma unroll
        for (int m = 0; m < 4; ++m) rs[a][m] = __shfl(r2[a], 16 * m + fr);
}
__device__ __forceinline__ float row_rs(const float* RSS, int row) {
    const f32x4* p = (const f32x4*)(RSS + (size_t)row * 16);
    const f32x4 a = p[0], b = p[1], c = p[2], d = p[3];
    const float s = ((a[0] + a[1]) + (a[2] + a[3])) + ((b[0] + b[1]) + (b[2] + b[3])) + ((c[0] + c[1]) + (c[2] + c[3])) + ((d[0] + d[1]) + (d[2] + d[3]));
    return __builtin_amdgcn_rsqf(s * (1.0f / D) + EPS);
}
template <bool FIRST>
struct EpiRes {
    static constexpr bool PERM = true, AFTER_DRAIN = false;
    const float* bp; const float* bs; bf16* HB; float* RSS; const float* RSSs = nullptr;
    bool seam = false; int ai0 = 0, ai1 = 2, m0 = 0, m1 = 4;
    __device__ __forceinline__ void operator()(const f32x4 (&acc)[2][2][4][2], const Unit& u, int wr, int wc, int fr, int fq) const {
        const int rowb = u.pm * 256 + wr * 64 + fr, colb = u.pn * 256 + wc * 32 + 8 * fq;
        float rs[2][4];
        if (!FIRST) wave_row_rs(RSSs, u.pm * 256 + wr * 64, fr + 16 * fq, fr, rs);
#pragma unroll
        for (int ai = 0; ai < 2; ++ai) if (ai >= ai0 && ai < ai1) {
            f32x4 bf[4][2][2]; u32x4 bw[4][2];
#pragma unroll
            for (int m = 0; m < 4; ++m) if (m >= m0 && m < m1) {
                const int row = rowb + ai * 128 + m * 16;
                if (FIRST) { const float* brow = (row < MP) ? bp + (size_t)row * D : bs + (size_t)(row - MP) * D;
#pragma unroll
                    for (int bj = 0; bj < 2; ++bj) { bf[m][bj][0] = *(const f32x4*)(brow + colb + bj * 128); bf[m][bj][1] = *(const f32x4*)(brow + colb + bj * 128 + 4); } }
                else {
#pragma unroll
                    for (int bj = 0; bj < 2; ++bj) bw[m][bj] = *(const u32x4*)(HB + (size_t)row * D + colb + bj * 128); }
            }
            asm volatile("" ::: "memory");
#pragma unroll
            for (int m = 0; m < 4; ++m) if (m >= m0 && m < m1) {
                const int row = rowb + ai * 128 + m * 16;
                float sc = 1.f; if (!FIRST) sc = rs[ai][m] * rs[ai][m];
                float ss = 0.f;
#pragma unroll
                for (int bj = 0; bj < 2; ++bj) {
                    const int col = colb + bj * 128;
                    f32x4 b0, b1;
                    if (FIRST) { b0 = bf[m][bj][0]; b1 = bf[m][bj][1]; }
                    else { const u32x4 w = bw[m][bj]; b0 = (f32x4){bflo(w.x), bfhi(w.x), bflo(w.y), bfhi(w.y)}; b1 = (f32x4){bflo(w.z), bfhi(w.z), bflo(w.w), bfhi(w.w)}; }
                    const f32x4 v0 = acc[ai][bj][m][0] * sc + b0, v1 = acc[ai][bj][m][1] * sc + b1;
                    *(u32x4*)(HB + (size_t)row * D + col) = pk8(v0, v1);
                    ss += (v0[0] * v0[0] + v0[1] * v0[1]) + (v0[2] * v0[2] + v0[3] * v0[3]) + (v1[0] * v1[0] + v1[1] * v1[1]) + (v1[2] * v1[2] + v1[3] * v1[3]);
                }
                ss += __shfl_xor(ss, 16); ss += __shfl_xor(ss, 32);
                if (fq == 0) RSS[(size_t)row * 16 + u.pn * 4 + wc] = ss;
            }
            asm volatile("" ::: "memory");
        }
    }
};
struct EpiFF1 {
    static constexpr bool PERM = true, AFTER_DRAIN = false;
    bf16* O; const float* RSS; bool seam = false; int ai0 = 0, ai1 = 2, m0 = 0, m1 = 4;
    __device__ __forceinline__ void operator()(const f32x4 (&acc)[2][2][4][2], const Unit& u, int wr, int wc, int fr, int fq) const {
        const int rowb = u.pm * 256 + wr * 64 + fr, colb = u.pn * 256 + wc * 32 + 8 * fq;
#pragma unroll
        for (int ai = 0; ai < 2; ++ai) if (ai >= ai0 && ai < ai1)
#pragma unroll
            for (int m = 0; m < 4; ++m) if (m >= m0 && m < m1) {
                const int row = rowb + ai * 128 + m * 16;
#pragma unroll
                for (int bj = 0; bj < 2; ++bj) {
                    f32x4 v0 = acc[ai][bj][m][0], v1 = acc[ai][bj][m][1];
#pragma unroll
                    for (int i = 0; i < 4; ++i) { const float a = fmaxf(v0[i], 0.f), b = fmaxf(v1[i], 0.f); v0[i] = a * a; v1[i] = b * b; }
                    *(u32x4*)(O + (size_t)row * FF + colb + bj * 128) = pk8(v0, v1);
                }
                if (seam) asm volatile("" ::: "memory");
            }
    }
};
struct EpiGate {
    static constexpr bool PERM = true, AFTER_DRAIN = false;
    const bf16* HB; bf16* H3B; const bf16* PP; const float* RSSin; float* RSSout; bool seam = false; int ai0 = 0, ai1 = 2, m0 = 0, m1 = 4;
    __device__ __forceinline__ void operator()(const f32x4 (&acc)[2][2][4][2], const Unit& u, int wr, int wc, int fr, int fq) const {
        const int rowb = u.pm * 256 + wr * 64 + fr, colb = u.pn * 256 + wc * 32 + 8 * fq;
        float rs[2][4];
        wave_row_rs(RSSin, u.pm * 256 + wr * 64, fr + 16 * fq, fr, rs);
#pragma unroll
        for (int ai = 0; ai < 2; ++ai) if (ai >= ai0 && ai < ai1) {
            u32x4 pwv[4][2], hwv[4][2];
#pragma unroll
            for (int m = 0; m < 4; ++m) if (m >= m0 && m < m1) {
                const int row = rowb + ai * 128 + m * 16;
#pragma unroll
                for (int bj = 0; bj < 2; ++bj) { pwv[m][bj] = *(const u32x4*)(PP + (size_t)row * D + colb + bj * 128); hwv[m][bj] = *(const u32x4*)(HB + (size_t)row * D + colb + bj * 128); }
            }
            asm volatile("" ::: "memory");
#pragma unroll
            for (int m = 0; m < 4; ++m) if (m >= m0 && m < m1) {
                const int row = rowb + ai * 128 + m * 16; const float r1 = rs[ai][m];
                float ss = 0.f;
#pragma unroll
                for (int bj = 0; bj < 2; ++bj) {
                    const int col = colb + bj * 128;
                    const u32x4 pw = pwv[m][bj], hw = hwv[m][bj];
                    const f32x4 p0 = {bflo(pw.x), bfhi(pw.x), bflo(pw.y), bfhi(pw.y)}, p1 = {bflo(pw.z), bfhi(pw.z), bflo(pw.w), bfhi(pw.w)};
                    f32x4 v0 = {bflo(hw.x), bfhi(hw.x), bflo(hw.y), bfhi(hw.y)}, v1 = {bflo(hw.z), bfhi(hw.z), bflo(hw.w), bfhi(hw.w)};
#pragma unroll
                    for (int i = 0; i < 4; ++i) { v0[i] += sigmoidf_(acc[ai][bj][m][0][i] * r1) * p0[i]; v1[i] += sigmoidf_(acc[ai][bj][m][1][i] * r1) * p1[i]; }
                    *(u32x4*)(H3B + (size_t)row * D + col) = pk8(v0, v1);
                    ss += (v0[0] * v0[0] + v0[1] * v0[1]) + (v0[2] * v0[2] + v0[3] * v0[3]) + (v1[0] * v1[0] + v1[1] * v1[1]) + (v1[2] * v1[2] + v1[3] * v1[3]);
                }
                ss += __shfl_xor(ss, 16); ss += __shfl_xor(ss, 32);
                if (fq == 0) RSSout[(size_t)row * 16 + u.pn * 4 + wc] = ss;
            }
            asm volatile("" ::: "memory");
        }
    }
};
template <bool MAP>
__device__ __forceinline__ void p0_transpose_item(const float* W, int K, int N, const float* gk, bf16* WT, LAS float* scr, int item, int lane) {
    const int nblk = N / 32, kb = item / nblk, nb = item % nblk, k0 = 64 * kb, n0 = 32 * nb;
#pragma unroll
    for (int i = 0; i < 32; ++i) { const int kk = 2 * i + (lane >> 5); float v = W[(size_t)(k0 + kk) * N + n0 + (lane & 31)]; if (gk) v *= gk[k0 + kk]; scr[kk * 33 + (lane & 31)] = v; }
    LDS_WAIT(); asm volatile("" ::: "memory");
    const int c = lane & 7, nd0 = MAP ? win_dest(n0) : n0;
#pragma unroll
    for (int j = 0; j < 4; ++j) { const int n = (lane >> 3) + 8 * j; const LAS float* s = scr + (8 * c) * 33 + n;
        u32x4 o; o.x = pk2(s[0 * 33], s[1 * 33]); o.y = pk2(s[2 * 33], s[3 * 33]); o.z = pk2(s[4 * 33], s[5 * 33]); o.w = pk2(s[6 * 33], s[7 * 33]);
        *(u32x4*)(WT + (size_t)(nd0 + n) * K + k0 + 8 * c) = o; }
    LDS_WAIT(); asm volatile("" ::: "memory");
}
__device__ __forceinline__ void p0_prologue(const Params& p, LAS unsigned char* lds, int G, int tid, int wid, int lane) {
    unsigned char* ws = p.ws;
    LAS float* scr = (LAS float*)(lds + wid * 16384);
    const int gw = blockIdx.x * NWAVES + wid, NGW = G * NWAVES;
    constexpr int I_IN = (D / 64) * (NIN / 32), I_O = (D / 64) * (D / 32), I_P = (DPLE / 64) * (D / 32);
    constexpr int NITEMS = I_IN + I_O + I_P;
    for (int it = gw; it < NITEMS; it += NGW) {
        int r = it;
        if (r < I_IN) { p0_transpose_item<true>(p.in[8], D, NIN, nullptr, (bf16*)(ws + WS_WIN), scr, r, lane); continue; } r -= I_IN;
        if (r < I_O) { p0_transpose_item<false>(p.in[14], D, D, nullptr, (bf16*)(ws + WS_WOUT), scr, r, lane); continue; } r -= I_O;
        p0_transpose_item<false>(p.in[20], DPLE, D, nullptr, (bf16*)(ws + WS_WP), scr, r, lane);
    }
    const f32x4* g4 = (const f32x4*)p.in[7] + lane;
    bf16* A1 = (bf16*)(ws + WS_A1); bf16* PB = (bf16*)(ws + WS_PB);
    for (int row = gw * 2; row < MT; row += NGW * 2) {
        f32x4 v[2][4]; f32x4 pv[2]; float s[2];
#pragma unroll
        for (int k = 0; k < 2; ++k) {
            const int rr = row + k;
            const float* xr = (rr < MP) ? p.in[0] + (size_t)rr * D : p.in[1] + (size_t)(rr - MP) * D;
            const f32x4* x4 = (const f32x4*)xr + lane;
#pragma unroll
            for (int j = 0; j < 4; ++j) v[k][j] = x4[64 * j];
            const float* pr = (rr < MP) ? p.in[2] + (size_t)rr * DPLE : p.in[3] + (size_t)(rr - MP) * DPLE;
            pv[k] = ((const f32x4*)pr)[lane];
        }
#pragma unroll
        for (int k = 0; k < 2; ++k) {
            s[k] = 0.f;
#pragma unroll
            for (int j = 0; j < 4; ++j) s[k] += (v[k][j][0] * v[k][j][0] + v[k][j][1] * v[k][j][1]) + (v[k][j][2] * v[k][j][2] + v[k][j][3] * v[k][j][3]);
            const float rs = __builtin_amdgcn_rsqf(wave_sum(s[k]) * (1.0f / D) + EPS);
            u32x2* o = (u32x2*)(A1 + (size_t)(row + k) * D) + lane;
#pragma unroll
            for (int j = 0; j < 4; ++j) { const f32x4 g = g4[64 * j]; u32x2 w; w.x = pk2(v[k][j][0] * rs * g[0], v[k][j][1] * rs * g[1]); w.y = pk2(v[k][j][2] * rs * g[2], v[k][j][3] * rs * g[3]); o[64 * j] = w; }
            u32x2 w; w.x = pk2(pv[k][0], pv[k][1]); w.y = pk2(pv[k][2], pv[k][3]); ((u32x2*)(PB + (size_t)(row + k) * DPLE))[lane] = w;
        }
    }
    float* rope = (float*)(ws + WS_ROPE);
    for (int idx = blockIdx.x * NTHREADS + tid; idx < SEQ * 32; idx += G * NTHREADS) {
        const int pos = idx >> 5, d = idx & 31;
        const float inv = (float)(1.0 / exp2((double)d * (13.287712379549449 / 32.0)));
        const float ang = (float)pos * inv;
        const double a = (double)ang, k = rint(a * 0.15915494309189535);
        const double r = fma(-k, 1.2246467991473532e-16 * 2.0, fma(-k, 6.283185307179586, a));
        const float rf = (float)r;
        ((pg8::f32x2*)rope)[idx] = (pg8::f32x2){cosf(rf), sinf(rf)};
    }
}

__device__ __forceinline__ void shadow_transpose(const float* W, int K, int N, const float* gk, bf16* WT, LAS unsigned char* lds, int cu, int ncu) {
    int t = threadIdx.x; asm volatile("" : "+v"(t));
    const int lane = t & 63, wid = __builtin_amdgcn_readfirstlane(t >> 6);
    LAS float* scr = (LAS float*)(lds + wid * 16384);
    const int nitems = (K / 64) * (N / 32);
    for (int it = cu * NWAVES + wid; it < nitems; it += ncu * NWAVES) p0_transpose_item<false>(W, K, N, gk, WT, scr, it, lane);
}

constexpr int N_ATT_P = 2 * 256 * 2, N_ATT = N_ATT_P + 16, N_CONV_P = MP / 64, N_CONV = N_CONV_P + 4;
constexpr int DCP = 516;
static_assert(64 * DCP * 4 <= MISC_OFF, "conv tile fits under the barrier words");
__device__ __forceinline__ void conv_item(const Params& p, LAS unsigned char* lds, int item, int tid, int wid, int lane) {
    typedef pg8::f32x2 f2;
    const bf16* U = (const bf16*)(p.ws + WS_U); bf16* MIX = (bf16*)(p.ws + WS_MIX);
    LAS float* DC = (LAS float*)lds;
    const int half = wid >> 2, c2 = 2 * (tid & 255);
    const bool sample = item >= N_CONV_P;
    const int row0 = item * 64, rowh = row0 + 32 * half;
    f2 win[62];
    if (!sample) {
        const int t0 = rowh & (SEQ - 1);
#pragma unroll
        for (int k = 0; k < 62; ++k) {
            const int tk = t0 - 30 + k;
            unsigned w = *(const unsigned*)(U + (size_t)(rowh - 30 + k - (tk < 0 ? tk : 0)) * CC + c2);
            if (tk < 0) w = 0u;
            win[k] = (f2){bflo(w), bfhi(w)};
        }
    } else {
        const float* sc = p.in[6] + (size_t)((item - N_CONV_P) * 2 + half) * 30 * CC + c2;
#pragma unroll
        for (int k = 0; k < 30; ++k) win[k] = *(const f2*)(sc + (size_t)k * CC);
#pragma unroll
        for (int k = 30; k < 62; ++k) { const unsigned w = *(const unsigned*)(U + (size_t)(rowh - 30 + k) * CC + c2); win[k] = (f2){bflo(w), bfhi(w)}; }
    }
    f2 w[31];
#pragma unroll
    for (int j = 0; j < 31; ++j) w[j] = *(const f2*)(p.in[9] + j * CC + c2);
    const f2 bias = *(const f2*)(p.in[10] + c2);
#pragma unroll
    for (int r = 0; r < 32; ++r) {
        f2 a = bias;
#pragma unroll
        for (int j = 0; j < 31; ++j) a = w[j] * win[r + j] + a;
        *(LAS f2*)(DC + (32 * half + r) * DCP + c2) = a;
    }
    __syncthreads();
    const int c8 = lane * 8;
    const f32x4 g0 = *(const f32x4*)(p.in[11] + c8), g1 = *(const f32x4*)(p.in[11] + c8 + 4), b0 = *(const f32x4*)(p.in[12] + c8), b1 = *(const f32x4*)(p.in[12] + c8 + 4);
#pragma unroll
    for (int rr = 0; rr < 8; ++rr) {
        const int r = 8 * wid + rr;
        f32x4 x0 = *(const LAS f32x4*)(DC + r * DCP + c8), x1 = *(const LAS f32x4*)(DC + r * DCP + c8 + 4);
        const float mean = wave_sum((x0[0] + x0[1]) + (x0[2] + x0[3]) + (x1[0] + x1[1]) + (x1[2] + x1[3])) * (1.0f / CC);
        x0 = x0 - mean; x1 = x1 - mean;
        const float var = wave_sum((x0[0] * x0[0] + x0[1] * x0[1]) + (x0[2] * x0[2] + x0[3] * x0[3]) + (x1[0] * x1[0] + x1[1] * x1[1]) + (x1[2] * x1[2] + x1[3] * x1[3])) * (1.0f / CC);
        const float rstd = __builtin_amdgcn_rsqf(var + EPS);
        f32x4 y0 = x0 * rstd * g0 + b0, y1 = x1 * rstd * g1 + b1;
#pragma unroll
        for (int i = 0; i < 4; ++i) { y0[i] *= sigmoidf_(y0[i]); y1[i] *= sigmoidf_(y1[i]); }
        *(u32x4*)(MIX + (size_t)(row0 + r) * D + c8) = pk8(y0, y1);
    }
    __syncthreads();
}

constexpr int KSP = 144, VTP = 408, VT_OFF = 192 * KSP;
#define MFMA32(a, b, c) __builtin_amdgcn_mfma_f32_32x32x16_bf16((a), (b), (c), 0, 0, 0)
__device__ __forceinline__ void attn_item(const Params& p, LAS unsigned char* lds, int item, int tid, int wid, int lane) {
    const bf16* Q = (const bf16*)(p.ws + WS_Q); const bf16* KB = (const bf16*)(p.ws + WS_KB); const bf16* VB = (const bf16*)(p.ws + WS_VB); bf16* MIX = (bf16*)(p.ws + WS_MIX);
    const bool sample = item >= N_ATT_P;
    int b, n, kvh, kt0, kt1;
    if (!sample) { b = item >> 9; n = (item >> 1) & 255; kvh = item & 1; kt0 = (n >= 2) ? 0 : (n == 1 ? 2 : 4); kt1 = 6; }
    else { const int s = item - N_ATT_P; b = s >> 1; n = 0; kvh = s & 1; kt0 = 0; kt1 = 5; }
    const int keyrow0 = b * SEQ + (n - 2) * 64;
    if (!sample) {
        u32x4 kv[3], vv[3];
#pragma unroll
        for (int i = 0; i < 3; ++i) {
            const int id = tid + NTHREADS * i, j = id >> 3, c = id & 7, jc = j < 32 * kt0 ? 32 * kt0 : j;
            const size_t grow = (size_t)(keyrow0 + jc);
            kv[i] = *(const u32x4*)(KB + grow * KVC + kvh * 64 + c * 8); vv[i] = *(const u32x4*)(VB + grow * KVC + kvh * 64 + c * 8);
        }
#pragma unroll
        for (int i = 0; i < 3; ++i) {
            const int id = tid + NTHREADS * i, j = id >> 3, c = id & 7;
            if (j >= 32 * kt0) {
                *(LAS u32x4*)(lds + j * KSP + c * 16) = kv[i];
                LAS unsigned short* vt = (LAS unsigned short*)(lds + VT_OFF + (8 * c) * VTP) + j;
                vt[0 * (VTP / 2)] = (unsigned short)(vv[i].x & 0xffffu); vt[1 * (VTP / 2)] = (unsigned short)(vv[i].x >> 16);
                vt[2 * (VTP / 2)] = (unsigned short)(vv[i].y & 0xffffu); vt[3 * (VTP / 2)] = (unsigned short)(vv[i].y >> 16);
                vt[4 * (VTP / 2)] = (unsigned short)(vv[i].z & 0xffffu); vt[5 * (VTP / 2)] = (unsigned short)(vv[i].z >> 16);
                vt[6 * (VTP / 2)] = (unsigned short)(vv[i].w & 0xffffu); vt[7 * (VTP / 2)] = (unsigned short)(vv[i].w >> 16);
            }
        }
    } else {
#pragma unroll
    for (int i = 0; i < 3; ++i) {
        const int id = tid + NTHREADS * i, j = id >> 3, c = id & 7;
        if (j >= 32 * kt0 && j < 32 * kt1) {
            u32x4 kv, vv;
            if (!sample || j >= 128) {
                const size_t grow = sample ? (size_t)(MP + b * 32 + (j - 128)) : (size_t)(keyrow0 + j);
                kv = *(const u32x4*)(KB + grow * KVC + kvh * 64 + c * 8); vv = *(const u32x4*)(VB + grow * KVC + kvh * 64 + c * 8);
            } else {
                const size_t off = ((size_t)(b * 128 + j) * 2 + kvh) * 64 + c * 8;
                const f32x4 k0 = *(const f32x4*)(p.in[4] + off), k1 = *(const f32x4*)(p.in[4] + off + 4), v0 = *(const f32x4*)(p.in[5] + off), v1 = *(const f32x4*)(p.in[5] + off + 4);
                kv = pk8(k0, k1); vv = pk8(v0, v1);
            }
            *(LAS u32x4*)(lds + j * KSP + c * 16) = kv;
            LAS unsigned short* vt = (LAS unsigned short*)(lds + VT_OFF + (8 * c) * VTP) + j;
            vt[0 * (VTP / 2)] = (unsigned short)(vv.x & 0xffffu); vt[1 * (VTP / 2)] = (unsigned short)(vv.x >> 16);
            vt[2 * (VTP / 2)] = (unsigned short)(vv.y & 0xffffu); vt[3 * (VTP / 2)] = (unsigned short)(vv.y >> 16);
            vt[4 * (VTP / 2)] = (unsigned short)(vv.z & 0xffffu); vt[5 * (VTP / 2)] = (unsigned short)(vv.z >> 16);
            vt[6 * (VTP / 2)] = (unsigned short)(vv.w & 0xffffu); vt[7 * (VTP / 2)] = (unsigned short)(vv.w >> 16);
        }
    }
    }
    __syncthreads();
    const int g = wid >> 1, qh = wid & 1, head = kvh * 4 + g, q = lane & 31, h = lane >> 5;
    if (!sample || qh == 0) {
        const size_t qrow = sample ? (size_t)(MP + b * 32 + q) : (size_t)(b * SEQ + n * 64 + qh * 32 + q);
        bf16x8 bq[4];
#pragma unroll
        for (int ks = 0; ks < 4; ++ks) bq[ks] = *(const bf16x8*)(Q + qrow * QC + head * 64 + ks * 16 + 8 * h);
        f32x16 st[6];
#pragma unroll
        for (int kt = 0; kt < 6; ++kt) {
#pragma unroll
            for (int r = 0; r < 16; ++r) st[kt][r] = 0.f;
            if (kt >= kt0 && kt < kt1) {
#pragma unroll
                for (int ks = 0; ks < 4; ++ks) { const bf16x8 a = *(const LAS bf16x8*)(lds + (32 * kt + q) * KSP + (16 * ks + 8 * h) * 2); st[kt] = MFMA32(a, bq[ks], st[kt]); }
            }
        }
        const float sk = p.in[13][head];
        float mx = sk;
#pragma unroll
        for (int kt = 0; kt < 6; ++kt) if (kt >= kt0 && kt < kt1) {
#pragma unroll
            for (int r = 0; r < 16; ++r) mx = fmaxf(mx, st[kt][r] * 0.125f);
        }
        mx = fmaxf(mx, __shfl_xor(mx, 32));
        float sum = 0.f;
#pragma unroll
        for (int kt = 0; kt < 6; ++kt) if (kt >= kt0 && kt < kt1) {
#pragma unroll
            for (int r = 0; r < 16; ++r) { const float e = __expf(st[kt][r] * 0.125f - mx); st[kt][r] = e; sum += e; }
        }
        sum += __shfl_xor(sum, 32); sum += __expf(sk - mx);
        f32x16 o[2];
#pragma unroll
        for (int r = 0; r < 16; ++r) { o[0][r] = 0.f; o[1][r] = 0.f; }
#pragma unroll
        for (int kt = 0; kt < 6; ++kt) if (kt >= kt0 && kt < kt1) {
#pragma unroll
            for (int s = 0; s < 2; ++s) {
                u32x4 pw; pw.x = pk2(st[kt][8 * s + 0], st[kt][8 * s + 1]); pw.y = pk2(st[kt][8 * s + 2], st[kt][8 * s + 3]); pw.z = pk2(st[kt][8 * s + 4], st[kt][8 * s + 5]); pw.w = pk2(st[kt][8 * s + 6], st[kt][8 * s + 7]);
                const bf16x8 pb = __builtin_bit_cast(bf16x8, pw);
#pragma unroll
                for (int dt = 0; dt < 2; ++dt) {
                    const LAS unsigned char* vp = lds + VT_OFF + (32 * dt + q) * VTP + (32 * kt + 16 * s + 4 * h) * 2;
                    const u32x2 lo = *(const LAS u32x2*)vp, hi = *(const LAS u32x2*)(vp + 16);
                    const u32x4 aw = {lo.x, lo.y, hi.x, hi.y};
                    o[dt] = MFMA32(__builtin_bit_cast(bf16x8, aw), pb, o[dt]);
                }
            }
        }
        const float inv = 1.0f / sum;
        bf16* op = MIX + qrow * D + CC + head * 64 + 4 * h;
#pragma unroll
        for (int dt = 0; dt < 2; ++dt)
#pragma unroll
            for (int gq = 0; gq < 4; ++gq) { u32x2 w; w.x = pk2(o[dt][4 * gq + 0] * inv, o[dt][4 * gq + 1] * inv); w.y = pk2(o[dt][4 * gq + 2] * inv, o[dt][4 * gq + 3] * inv); *(u32x2*)(op + 32 * dt + 8 * gq) = w; }
    }
    __syncthreads();
}

#define XB_TMO      128
#define XB_XCNT(j)  (256  + 64 * (j))
#define XB_XSUB(j)  (1280 + 64 * (j))
#define XB_XGEN(j)  (2304 + 64 * (j))
#define XB_TOP      3328
#define XB_TOPGEN   3392
#define XCD_BAR_WORDS 3456
#define XB_SPIN_CAP (1u << 18)

__device__ __forceinline__ unsigned xb_ld(unsigned* p)              { return __hip_atomic_load(p, __ATOMIC_RELAXED, __HIP_MEMORY_SCOPE_AGENT); }
__device__ __forceinline__ unsigned xb_add(unsigned* p, unsigned v) { return __hip_atomic_fetch_add(p, v, __ATOMIC_RELAXED, __HIP_MEMORY_SCOPE_AGENT); }
__device__ __forceinline__ unsigned xb_xcc_id() { return (unsigned)__builtin_amdgcn_s_getreg((3 << 11) | 20) & 0xFu; }
#define XB_SPIN(cond, bar) do { unsigned _sp = 0; while (cond) { __builtin_amdgcn_s_sleep(1); \
    if ((++_sp & 255u) == 0u) { if (xb_ld(&(bar)[XB_TMO])) break; if (_sp > XB_SPIN_CAP) { atomicAdd(&(bar)[XB_TMO], 1u); break; } } } } while (0)

struct XcdBarrier {
    unsigned* bar; unsigned x;
    volatile LAS unsigned* st;
};

__device__ __forceinline__ XcdBarrier xcd_barrier_post(unsigned* bar, volatile LAS unsigned* st) {
    XcdBarrier b; b.bar = bar; b.x = xb_xcc_id(); b.st = st;
    if (threadIdx.x == 0) (void)xb_add(&bar[XB_XCNT(b.x)], 1u);
    return b;
}
__device__ __forceinline__ void xcd_barrier_complete(unsigned* bar, unsigned x, unsigned& nloc, unsigned& nx) {
    const unsigned G = gridDim.x * gridDim.y * gridDim.z;
    unsigned sum, cnt, mine, sp = 0u;
    for (;;) {
        sum = 0u; cnt = 0u; mine = 0u;
#pragma unroll
        for (unsigned j = 0; j < 16; ++j) { const unsigned c = xb_ld(&bar[XB_XCNT(j)]); sum += c; cnt += (c > 0u) ? 1u : 0u; mine = (j == x) ? c : mine; }
        if (sum == G) break;
        __builtin_amdgcn_s_sleep(1);
        if ((++sp & 255u) == 0u) { if (xb_ld(&bar[XB_TMO])) break; if (sp > XB_SPIN_CAP) { atomicAdd(&bar[XB_TMO], 1u); break; } }
    }
    nloc = mine > 0u ? mine : 1u; nx = cnt > 0u ? cnt : 1u;
}

__device__ __forceinline__ void xcd_barrier(const XcdBarrier& b) {
    asm volatile("s_waitcnt vmcnt(0)" ::: "memory");
    __syncthreads();
    if (threadIdx.x == 0) {
        unsigned* bar = b.bar;
        __builtin_amdgcn_s_waitcnt(0);
        unsigned nloc = b.st[0], nx = b.st[1];
        if (nloc == 0u) { xcd_barrier_complete(bar, b.x, nloc, nx); b.st[0] = nloc; b.st[1] = nx; }
        const unsigned old = xb_add(&bar[XB_XSUB(b.x)], 1u);
        const unsigned gen = old / nloc;
        if (old + 1u == (gen + 1u) * nloc) {
            __builtin_amdgcn_fence(__ATOMIC_RELEASE, "agent");
            asm volatile("s_waitcnt vmcnt(0)" ::: "memory");
            const unsigned og = xb_add(&bar[XB_TOP], 1u);
            const unsigned tg = og / nx;
            if (og + 1u == (tg + 1u) * nx) xb_add(&bar[XB_TOPGEN], 1u);
            else XB_SPIN(xb_ld(&bar[XB_TOPGEN]) == tg, bar);
            __builtin_amdgcn_fence(__ATOMIC_ACQUIRE, "agent");
            xb_add(&bar[XB_XGEN(b.x)], 1u);
            asm volatile("s_waitcnt vmcnt(0)" ::: "memory");
        } else {
            XB_SPIN(xb_ld(&bar[XB_XGEN(b.x)]) == gen, bar);
            __builtin_amdgcn_fence(__ATOMIC_ACQUIRE, "agent");
            asm volatile("s_waitcnt vmcnt(0)" ::: "memory");
        }
    }
    __syncthreads();
}


template <int NS, class Epi>
__device__ __forceinline__ void sample_fixup(const float* part, int ldn, int item, const Epi& E, unsigned* cnt) {
    int tid_ = threadIdx.x; asm volatile("" : "+v"(tid_));
    const int lane = tid_ & 63, wid = __builtin_amdgcn_readfirstlane(tid_ >> 6), wr = wid >> 2, wc = wid & 3, fr = lane & 15, fq = lane >> 4;
    const int pn = item >> 3, ah = (item >> 2) & 1, mh = item & 3;
    const size_t slice = (size_t)256 * ldn;
    const float* q = part + (size_t)(ah * 128 + wr * 64 + mh * 16 + fr) * ldn + pn * 256 + wc * 32 + 8 * fq;
    f32x4 s0 = {0.f, 0.f, 0.f, 0.f}, s1 = s0, s2 = s0, s3 = s0;
#pragma unroll
    for (int k4 = 0; k4 < NS; k4 += 4) {
        f32x4 l[4][4];
#pragma unroll
        for (int ks = 0; ks < 4; ++ks) { l[ks][0] = *(const f32x4*)(q); l[ks][1] = *(const f32x4*)(q + 4); l[ks][2] = *(const f32x4*)(q + 128); l[ks][3] = *(const f32x4*)(q + 132); q += slice; }
        s0 += (l[0][0] + l[1][0]) + (l[2][0] + l[3][0]); s1 += (l[0][1] + l[1][1]) + (l[2][1] + l[3][1]); s2 += (l[0][2] + l[1][2]) + (l[2][2] + l[3][2]); s3 += (l[0][3] + l[1][3]) + (l[2][3] + l[3][3]);
    }
    Unit u; u.pm = MP / 256; u.pn = pn; u.k0 = 0; u.nt = 0; u.split = 0;
#pragma unroll
    for (int a = 0; a < 2; ++a)
#pragma unroll
        for (int m = 0; m < 4; ++m)
            if (a == ah && m == mh) {
                f32x4 acc[2][2][4][2];
#pragma unroll
                for (int x = 0; x < 2; ++x)
#pragma unroll
                    for (int b = 0; b < 2; ++b)
#pragma unroll
                        for (int y = 0; y < 4; ++y) { acc[x][b][y][0] = (f32x4){0.f, 0.f, 0.f, 0.f}; acc[x][b][y][1] = (f32x4){0.f, 0.f, 0.f, 0.f}; }
                acc[a][0][m][0] = s0; acc[a][0][m][1] = s1; acc[a][1][m][0] = s2; acc[a][1][m][1] = s3;
                Epi Eh = E; Eh.ai0 = a; Eh.ai1 = a + 1; Eh.m0 = m; Eh.m1 = m + 1;
                Eh(acc, u, wr, wc, fr, fq);
            }
    if (cnt) {
        asm volatile("s_waitcnt vmcnt(0)" ::: "memory");
        __syncthreads();
        if (wid == 0) {
            __builtin_amdgcn_fence(__ATOMIC_RELEASE, "agent");
            asm volatile("s_waitcnt vmcnt(0)" ::: "memory");
            if (lane == 0) (void)__hip_atomic_fetch_add(cnt, 1u, __ATOMIC_RELAXED, __HIP_MEMORY_SCOPE_AGENT);
        }
    }
}

__device__ __forceinline__ void p7_rows(float* out, const bf16* H3B, const float* RSS3, const float* gfin, int row0, int row_end, int step) {
    int t7 = threadIdx.x; asm volatile("" : "+v"(t7));
    const int lane = t7 & 63, wid = __builtin_amdgcn_readfirstlane(t7 >> 6);
    const f32x4* g4 = (const f32x4*)gfin + 2 * lane;
    const f32x4 ga = g4[0], gb = g4[1], gc = g4[128], gd = g4[129];
    for (int row = row0 + wid * 2; row < row_end; row += step) {
        float part[2]; u32x4 w[2][2];
#pragma unroll
        for (int k = 0; k < 2; ++k) {
            part[k] = RSS3[(size_t)(row + k) * 16 + (lane & 15)]; if (lane >= 16) part[k] = 0.f;
            const u32x4* hp = (const u32x4*)(H3B + (size_t)(row + k) * D) + lane;
            w[k][0] = hp[0]; w[k][1] = hp[64];
        }
#pragma unroll
        for (int k = 0; k < 2; ++k) {
            const float rs = __builtin_amdgcn_rsqf(wave_sum(part[k]) * (1.0f / D) + EPS);
            f32x4* o = (f32x4*)(out + (size_t)(row + k) * D) + 2 * lane;
            const u32x4 a = w[k][0], b = w[k][1];
            o[0] = (f32x4){bflo(a.x), bfhi(a.x), bflo(a.y), bfhi(a.y)} * rs * ga; o[1] = (f32x4){bflo(a.z), bfhi(a.z), bflo(a.w), bfhi(a.w)} * rs * gb;
            o[128] = (f32x4){bflo(b.x), bfhi(b.x), bflo(b.y), bfhi(b.y)} * rs * gc; o[129] = (f32x4){bflo(b.z), bfhi(b.z), bflo(b.w), bfhi(b.w)} * rs * gd;
        }
    }
}

__global__ void __launch_bounds__(NTHREADS, 2) fwd_megakernel(Params p) {
    extern __shared__ __attribute__((aligned(16))) unsigned char lds_raw[];
    LAS unsigned char* lds = (LAS unsigned char*)lds_raw;
    cg::grid_group grid = cg::this_grid();
    const int tid = threadIdx.x, lane = tid & 63, wid = __builtin_amdgcn_readfirstlane(tid >> 6), G = gridDim.x, bx = blockIdx.x;
    unsigned char* ws = p.ws;
    bf16* A1 = (bf16*)(ws + WS_A1); bf16* HB = (bf16*)(ws + WS_HB); bf16* PB = (bf16*)(ws + WS_PB); bf16* PP = (bf16*)(ws + WS_PP); bf16* HID = (bf16*)(ws + WS_HID); bf16* MIX = (bf16*)(ws + WS_MIX); bf16* H3B = (bf16*)(ws + WS_A1);
    unsigned* ctl = (unsigned*)(ws + WS_CTL);
    float* RSS1 = (float*)(ws + WS_RSS1); float* RSS2 = (float*)(ws + WS_RSS2); float* RSS3 = (float*)(ws + WS_RSS3);

    volatile LAS unsigned* MISC = (volatile LAS unsigned*)(lds + MISC_OFF);
    if (tid < 64) MISC[tid] = 0u;
    __syncthreads();
    XcdBarrier bar = xcd_barrier_post((unsigned*)(ws + WS_CTL), MISC + 8);
    p0_prologue(p, lds, G, tid, wid, lane);
    if (p.ws == nullptr) grid.sync();
    xcd_barrier(bar);
    {
        pg8::Gemm g{A1, (const bf16*)(ws + WS_WIN), MT, NIN, D}; pg8::StaticOrder S; S.init(MT, NIN, D, G, bx);
        EpiIn E{(bf16*)(ws + WS_U), (bf16*)(ws + WS_Q), (bf16*)(ws + WS_KB), (bf16*)(ws + WS_VB), (const float*)(ws + WS_ROPE), p.out};
        pg8::gemm_phase<EpiIn, pg8::StaticOrder, true, true>(lds, g, S, E);
        pg8::Gemm g2{PB, (const bf16*)(ws + WS_WP), MT, D, DPLE}; pg8::StaticOrder S2; S2.init(MT, D, DPLE, G, G - 1 - bx);
        EpiPlain E2{PP, D};
        pg8::gemm_phase<EpiPlain, pg8::StaticOrder, true, true>(lds, g2, S2, E2);
    }
    xcd_barrier(bar);
    for (int it = bx; it < N_ATT; it += G) { if (G == 256 && bx >= G - 4 && it == bx + 3 * G) continue; attn_item(p, lds, it, tid, wid, lane); }
    if (G == 256 && bx >= 16 && bx < 20) attn_item(p, lds, (G - 4 + (bx - 16)) + 3 * G, tid, wid, lane);
    for (int it = G - 1 - bx; it < N_CONV; it += G) conv_item(p, lds, it, tid, wid, lane);
    xcd_barrier(bar);
    float* PARTA = (float*)(ws + WS_PART); float* PARTB = (float*)(ws + WS_PARTB);
    unsigned* cnt3 = ctl + CW_SPLIT; unsigned* cnt4 = ctl + CW_SPLIT + 64; unsigned* cnt5 = ctl + CW_SPLIT + 128;
    {
        pg8::Gemm g{MIX, (const bf16*)(ws + WS_WOUT), MT, D, D}; pg8::SplitOrder S; S.init(MP, D, D, 256, G, bx, nullptr, 0u);
        EpiRes<true> E{p.in[0], p.in[1], HB, RSS1};
        pg8::gemm_phase<EpiRes<true>, pg8::SplitOrder, true, true>(lds, g, S, E, pg8::SplitCtx{PARTA, D});
        if (bx >= 16) shadow_transpose(p.in[16], D, FF, p.in[15], (bf16*)(ws + WS_W1), lds, bx - 16, G - 16);
    }
    xcd_barrier(bar);
    {
        if (bx >= G - 32) { EpiRes<true> Ef{p.in[0], p.in[1], HB, RSS1}; sample_fixup<4>(PARTA, D, G - 1 - bx, Ef, cnt3); }
        pg8::Gemm g{HB, (const bf16*)(ws + WS_W1), MT, FF, D}; pg8::SplitOrder S; S.init(MP, FF, D, 256, G, bx, cnt3, 32u);
        EpiFF1 E{HID, RSS1};
        pg8::gemm_phase<EpiFF1, pg8::SplitOrder, true, true>(lds, g, S, E, pg8::SplitCtx{PARTB, FF});
        if (bx >= 64) shadow_transpose(p.in[17], FF, D, nullptr, (bf16*)(ws + WS_W2), lds, bx - 64, G - 64);
    }
    xcd_barrier(bar);
    {
        if (bx >= G - 128) { EpiFF1 Ef{HID, RSS1}; sample_fixup<4>(PARTB, FF, G - 1 - bx, Ef, cnt4); }
        pg8::Gemm g{HID, (const bf16*)(ws + WS_W2), MT, D, FF}; pg8::SplitOrder S; S.init(MP, D, FF, 512, G, bx, cnt4, 128u);
        EpiRes<false> E{nullptr, nullptr, HB, RSS2, RSS1};
        pg8::gemm_phase<EpiRes<false>, pg8::SplitOrder, true, true>(lds, g, S, E, pg8::SplitCtx{PARTA, D});
        if (bx >= 32) shadow_transpose(p.in[19], D, D, p.in[18], (bf16*)(ws + WS_WG), lds, bx - 32, G - 32);
    }
    xcd_barrier(bar);
    {
        if (bx >= G - 32) { EpiRes<false> Ef{nullptr, nullptr, HB, RSS2, RSS1}; sample_fixup<8>(PARTA, D, G - 1 - bx, Ef, cnt5); }
        pg8::Gemm g{HB, (const bf16*)(ws + WS_WG), MT, D, D}; pg8::SplitOrder S; S.init(MP, D, D, 256, G, bx, cnt5, 32u);
        EpiGate E{HB, H3B, PP, RSS2, RSS3};
        pg8::gemm_phase<EpiGate, pg8::SplitOrder, true, true>(lds, g, S, E, pg8::SplitCtx{PARTB, D});
    }
    xcd_barrier(bar);
    if (G != 256) {
        if (bx >= G - 32) { EpiGate Ef{HB, H3B, PP, RSS2, RSS3}; sample_fixup<4>(PARTB, D, G - 1 - bx, Ef, nullptr); }
        p7_rows(p.out, H3B, RSS3, p.in[21], bx * NWAVES * 2, MP, G * NWAVES * 2);
        xcd_barrier(bar);
        p7_rows(p.out, H3B, RSS3, p.in[21], MP + bx * NWAVES * 2, MT, G * NWAVES * 2);
    } else if (bx >= G - 32) {
        const int f = bx - (G - 32);
        { EpiGate Ef{HB, H3B, PP, RSS2, RSS3}; sample_fixup<4>(PARTB, D, G - 1 - bx, Ef, nullptr); }
        unsigned* cnt6 = ctl + CW_SPLIT + 192;
        asm volatile("s_waitcnt vmcnt(0)" ::: "memory");
        __syncthreads();
        if (tid < 64) {
            __builtin_amdgcn_fence(__ATOMIC_RELEASE, "agent");
            asm volatile("s_waitcnt vmcnt(0)" ::: "memory");
            if (lane == 0) (void)__hip_atomic_fetch_add(cnt6, 1u, __ATOMIC_RELAXED, __HIP_MEMORY_SCOPE_AGENT);
            unsigned polls = 0;
            while ((unsigned)__builtin_amdgcn_readfirstlane((int)__hip_atomic_load(cnt6, __ATOMIC_RELAXED, __HIP_MEMORY_SCOPE_AGENT)) < 32u) { __builtin_amdgcn_s_sleep(2); if (++polls > (1u << 22)) break; }
            __builtin_amdgcn_fence(__ATOMIC_ACQUIRE, "agent");
            asm volatile("s_waitcnt vmcnt(0)" ::: "memory");
        }
        __syncthreads();
        p7_rows(p.out, H3B, RSS3, p.in[21], MP + f * 8, MP + f * 8 + 8, 16);
        p7_rows(p.out, H3B, RSS3, p.in[21], (1792 + f) * 16, 1952 * 16, 32 * 16);
    } else {
        p7_rows(p.out, H3B, RSS3, p.in[21], bx * 16, 1792 * 16, 224 * 16);
        if (bx < 96) p7_rows(p.out, H3B, RSS3, p.in[21], (1952 + bx) * 16, (1952 + bx) * 16 + 16, 16);
    }
}

extern "C" void kernel_launch(void* const* d_in, const int* in_sizes, int n_in, void* d_out, int out_size, void* d_ws, size_t ws_size, hipStream_t stream) {
    static int grid_blocks = 0;
    if (grid_blocks == 0) {
        if (n_in != 22 || ws_size < WS_END) { fprintf(stderr, "kernel_launch: unexpected n_in %d / ws_size %zu\n", n_in, ws_size); grid_blocks = -1; return; }
        int dev = 0, cus = 0, per_cu = 0;
        (void)hipGetDevice(&dev);
        (void)hipDeviceGetAttribute(&cus, hipDeviceAttributeMultiprocessorCount, dev);
        (void)hipFuncSetAttribute((const void*)fwd_megakernel, hipFuncAttributeMaxDynamicSharedMemorySize, LDS_BYTES);
        (void)hipOccupancyMaxActiveBlocksPerMultiprocessor(&per_cu, (const void*)fwd_megakernel, NTHREADS, LDS_BYTES);
        if (per_cu < 1) { fprintf(stderr, "kernel_launch: occupancy query reports %d blocks per CU\n", per_cu); per_cu = 1; }
        if (per_cu > 1) per_cu = 1;
        grid_blocks = cus * per_cu;
    }
    if (grid_blocks < 0) return;
    Params p{};
    for (int i = 0; i < 22; ++i) p.in[i] = (const float*)d_in[i];
    p.out = (float*)d_out; p.ws = (unsigned char*)d_ws;
    (void)hipMemsetAsync((char*)d_ws + WS_CTL, 0, CTL_ZERO_BYTES, stream);
    void* args[] = {&p};
    hipError_t e = hipLaunchCooperativeKernel((const void*)fwd_megakernel, dim3(grid_blocks), dim3(NTHREADS), args, LDS_BYTES, stream);
    if (e != hipSuccess) fprintf(stderr, "cooperative launch failed: %s (grid %d)\n", hipGetErrorString(e), grid_blocks);
}
```

```cpp
#include <hip/hip_runtime.h>
#include <hip/hip_cooperative_groups.h>
#include <cstdio>
#include <cstdint>
namespace cg = cooperative_groups;

namespace pg8 {
#define PG8_LAS __attribute__((address_space(3)))
typedef unsigned short bf16_t;
typedef short bf16x8 __attribute__((ext_vector_type(8)));
typedef float f32x4 __attribute__((ext_vector_type(4)));
typedef unsigned u32x4 __attribute__((ext_vector_type(4)));
constexpr int BM = 256, BK = 64, HALF = 128, HTB = HALF * BK * 2  , STAGE_BYTES = 8 * HTB, NXCD = 8, WGM = 8;

__host__ __device__ __forceinline__ int lds_byte(int r, int c) { const int st = (r >> 4) * 2 + (c >> 5), rr = r & 15, cc = c & 31, ob = rr * 64 + cc * 2; return st * 1024 + (ob ^ (((ob >> 9) & 1) << 5)); }
__host__ __device__ __forceinline__ void stage_rc(int b, int& R, int& C) { const int st = b / 1024, sb = b % 1024, swz = sb ^ (((sb >> 9) & 1) << 5); R = (st >> 1) * 16 + swz / 64; C = (st & 1) * 32 + (swz % 64) / 2; }
__host__ __device__ __forceinline__ int perm32(int rho) { const int n = rho >> 4, i = rho & 15; return 8 * (i >> 2) + 4 * n + (i & 3); }

struct Unit { int pm, pn, k0, nt, split; };
struct Gemm { const bf16_t* A; const bf16_t* Bt; int M, N, K; };

struct StaticOrder {
    int nM, nN, nwg, G, c, ntfull;
    __host__ __device__ void init(int M, int N, int K, int G_, int c_) { nM = M / BM; nN = N / BM; nwg = nM * nN; G = G_; c = c_; ntfull = K / BK; }
    __host__ __device__ bool next(int i, Unit& u) const {
        const long L = (long)i * G + c; if (L >= nwg) return false;
        int wgid = (int)L; { const int q = nwg / NXCD, r = nwg % NXCD, xcd = wgid % NXCD, off = wgid / NXCD; wgid = (xcd < r ? xcd * (q + 1) : r * (q + 1) + (xcd - r) * q) + off; }
        const int nig = WGM * nN, gid = wgid / nig, fm = gid * WGM, gsz = (nM - fm) < WGM ? (nM - fm) : WGM;
        u.pm = fm + ((wgid % nig) % gsz); u.pn = (wgid % nig) / gsz; u.k0 = 0; u.nt = ntfull; u.split = 0; return true;
    }
    __device__ __forceinline__ void a_ready(const Unit&) const {}
    __device__ __forceinline__ void done(const Unit&) const {}
};

struct SplitOrder {
    StaticOrder so; int nmain, nsplit, ntsub, nsub; unsigned* ready; unsigned need;
    __device__ void init(int Mmain, int N, int K, int klen, int G_, int c_, unsigned* ready_, unsigned need_) { so.init(Mmain, N, K, G_, c_); nmain = so.nwg; nsplit = K / klen; ntsub = klen / BK; nsub = (N / BM) * nsplit; ready = ready_; need = need_; }
    __device__ bool next(int i, Unit& u) const {
        if (so.next(i, u)) return true;
        const int nmine = (nmain - so.c + so.G - 1) / so.G;
        const int j = (i - nmine) * so.G + so.c;
        if (j < 0 || j >= nsub) return false;
        u.pm = so.nM; u.pn = j / nsplit; u.k0 = (j % nsplit) * ntsub * BK; u.nt = ntsub; u.split = 1; return true;
    }
    __device__ __forceinline__ void a_ready(const Unit& u) const {
        if (!u.split || need == 0u) return;
        if (threadIdx.x < 64) {
            unsigned polls = 0;
            while ((unsigned)__builtin_amdgcn_readfirstlane((int)__hip_atomic_load(ready, __ATOMIC_RELAXED, __HIP_MEMORY_SCOPE_AGENT)) < need) { __builtin_amdgcn_s_sleep(2); if (++polls > (1u << 22)) break; }
            __builtin_amdgcn_fence(__ATOMIC_ACQUIRE, "agent");
            asm volatile("s_waitcnt vmcnt(0)" ::: "memory");
        }
        asm volatile("" ::: "memory"); __builtin_amdgcn_s_barrier(); asm volatile("" ::: "memory");
    }
    __device__ __forceinline__ void done(const Unit&) const {}
};
struct SplitCtx { float* sum; int ldn; };
typedef float f32x2 __attribute__((ext_vector_type(2)));
typedef __bf16 bf16x2v __attribute__((ext_vector_type(2)));
__device__ __forceinline__ unsigned pk2(float lo, float hi) { f32x2 v = {lo, hi}; return __builtin_bit_cast(unsigned, __builtin_convertvector(v, bf16x2v)); }
__device__ __forceinline__ u32x4 pk8(const f32x4& a, const f32x4& b) { u32x4 w; w.x = pk2(a[0], a[1]); w.y = pk2(a[2], a[3]); w.z = pk2(b[0], b[1]); w.w = pk2(b[2], b[3]); return w; }
__device__ __forceinline__ float bflo(unsigned w) { return __builtin_bit_cast(float, w << 16); }
__device__ __forceinline__ float bfhi(unsigned w) { return __builtin_bit_cast(float, w & 0xffff0000u); }
__device__ __forceinline__ float sigmoidf_(float x) { return __builtin_amdgcn_rcpf(1.0f + __expf(-x)); }
template <class Epi, class Sched, bool ALIGN_EPI = false, bool SP2 = false>
__device__ __forceinline__ void gemm_phase(PG8_LAS unsigned char* lds, const Gemm g, const Sched& S, const Epi& E, const SplitCtx X = SplitCtx{nullptr, 0}) {
    int tid_ = threadIdx.x; asm volatile("" : "+v"(tid_));
    const int tid = tid_, wid = __builtin_amdgcn_readfirstlane(tid >> 6), lane = tid & 63, wr = wid >> 2, wc = wid & 3, fr = lane & 15, fq = lane >> 4;
    const int K = g.K;
    unsigned voffA[2], voffB[2];
#pragma unroll
    for (int i = 0; i < 2; ++i) { int R, C; stage_rc(tid * 16 + i * 8192, R, C); const int Rb = Epi::PERM ? ((R & ~31) + perm32(R & 31)) : R;
        voffA[i] = (unsigned)(R * K + C) * 2u; voffB[i] = (unsigned)(Rb * K + C) * 2u; }
    const size_t kstep = (size_t)(BK * 2);
    const size_t hstep = (size_t)HALF * K * 2;
    const size_t tstep = 2 * hstep;
    const unsigned ldsw = (unsigned)wid * 1024u;
    const int aoff = lds_byte(wr * 64 + fr, fq * 8), boff = lds_byte(wc * 32 + fr, fq * 8);
#define PG8_SA(b, h) (((b) * 2 + (h)) * HTB)
#define PG8_SB(b, h) ((4 + (b) * 2 + (h)) * HTB)
#define PG8_STAGE(bufoff, gbase, voff) do { _Pragma("unroll") for (int _i = 0; _i < 2; ++_i) \
        __builtin_amdgcn_global_load_lds((const unsigned*)((const char*)(gbase) + (voff)[_i]), (PG8_LAS unsigned*)(lds + (bufoff) + ldsw + _i * 8192), 16, 0, 0); } while (0)
#define PG8_LDA(dst, b, h) do { _Pragma("unroll") for (int m = 0; m < 4; ++m) _Pragma("unroll") for (int k = 0; k < 2; ++k) dst[m][k] = *(const PG8_LAS bf16x8*)(lds + PG8_SA(b, h) + aoff + m * 2048 + k * 1024); } while (0)
#define PG8_LDB(dst, b, h) do { _Pragma("unroll") for (int n = 0; n < 2; ++n) _Pragma("unroll") for (int k = 0; k < 2; ++k) dst[n][k] = *(const PG8_LAS bf16x8*)(lds + PG8_SB(b, h) + boff + n * 2048 + k * 1024); } while (0)
#define PG8_MMA(ai, bj, At, Bt) do { __builtin_amdgcn_s_setprio(1); _Pragma("unroll") for (int m = 0; m < 4; ++m) _Pragma("unroll") for (int n = 0; n < 2; ++n) _Pragma("unroll") for (int k = 0; k < 2; ++k) \
        acc[ai][bj][m][n] = __builtin_amdgcn_mfma_f32_16x16x32_bf16(Bt[n][k], At[m][k], acc[ai][bj][m][n], 0, 0, 0); __builtin_amdgcn_s_setprio(0); } while (0)
#define PG8_WAIT_V(n) asm volatile("s_waitcnt vmcnt(" #n ")" ::: "memory")
#define PG8_WAIT_L(n) asm volatile("s_waitcnt lgkmcnt(" #n ")" ::: "memory")
#define PG8_BAR __builtin_amdgcn_s_barrier()
#define PG8_SCHED __builtin_amdgcn_sched_barrier(0)
    Unit cur, nxt; int ui = 0;
    if (!S.next(0, cur)) return;
    f32x4 acc[2][2][4][2];
#pragma unroll
    for (int a = 0; a < 2; ++a)
#pragma unroll
        for (int b = 0; b < 2; ++b)
#pragma unroll
            for (int m = 0; m < 4; ++m)
#pragma unroll
                for (int n = 0; n < 2; ++n) acc[a][b][m][n] = (f32x4){0.f, 0.f, 0.f, 0.f};
    bf16x8 At[4][2], B0[2][2], B1[2][2];
    const char* cA = (const char*)g.A + (size_t)cur.pm * tstep + (size_t)cur.k0 * 2; const char* cB = (const char*)g.Bt + (size_t)cur.pn * tstep + (size_t)cur.k0 * 2;
    S.a_ready(cur);
    if constexpr (SP2) {
        PG8_STAGE(PG8_SB(0, 0), cB, voffB); PG8_STAGE(PG8_SB(0, 1), cB + hstep, voffB); PG8_STAGE(PG8_SA(0, 0), cA, voffA); PG8_STAGE(PG8_SA(0, 1), cA + hstep, voffA);
        if (wr == 1) PG8_BAR;
        PG8_WAIT_V(2); PG8_BAR;
        PG8_STAGE(PG8_SB(1, 0), cB + kstep, voffB); PG8_STAGE(PG8_SA(1, 0), cA + kstep, voffA); PG8_STAGE(PG8_SB(1, 1), cB + hstep + kstep, voffB);
        PG8_WAIT_V(6); PG8_BAR;
    } else {
        PG8_STAGE(PG8_SB(0, 0), cB, voffB); PG8_STAGE(PG8_SA(0, 0), cA, voffA); PG8_STAGE(PG8_SB(0, 1), cB + hstep, voffB); PG8_STAGE(PG8_SA(0, 1), cA + hstep, voffA);
        if (wr == 1) PG8_BAR;
        PG8_WAIT_V(4); PG8_BAR;
        PG8_STAGE(PG8_SB(1, 0), cB + kstep, voffB); PG8_STAGE(PG8_SA(1, 0), cA + kstep, voffA); PG8_STAGE(PG8_SB(1, 1), cB + hstep + kstep, voffB);
        PG8_WAIT_V(6); PG8_BAR;
    }
    for (;;) {
        const bool has_next = S.next(ui + 1, nxt);
        const char* nA = has_next ? (const char*)g.A + (size_t)nxt.pm * tstep + (size_t)nxt.k0 * 2 : cA; const char* nB = has_next ? (const char*)g.Bt + (size_t)nxt.pn * tstep + (size_t)nxt.k0 * 2 : cB;
        const int nt = cur.nt;
#pragma unroll 1
        for (int t = 0; t < nt; t += 2) {
            const bool last = (t == nt - 2);
            const char* a1 = cA + (size_t)(t + 1) * kstep;
            const char* a2 = last ? nA : cA + (size_t)(t + 2) * kstep; const char* b2 = last ? nB : cB + (size_t)(t + 2) * kstep;
            const char* a3 = a2 + kstep; const char* b3 = b2 + kstep;
            if (last && has_next) S.a_ready(nxt);
            if constexpr (SP2) {
            PG8_LDB(B0, 0, 0); PG8_LDB(B1, 0, 1); PG8_SCHED; PG8_LDA(At, 0, 0); PG8_STAGE(PG8_SA(1, 1), a1 + hstep, voffA);
            PG8_WAIT_V(8); PG8_WAIT_L(0); PG8_BAR; PG8_MMA(0, 0, At, B0); PG8_MMA(0, 1, At, B1); PG8_BAR; PG8_SCHED;
            PG8_LDA(At, 0, 1); PG8_STAGE(PG8_SB(0, 0), b2, voffB); PG8_STAGE(PG8_SB(0, 1), b2 + hstep, voffB); PG8_STAGE(PG8_SA(0, 0), a2, voffA);
            PG8_WAIT_V(8); PG8_WAIT_L(0); PG8_BAR; PG8_MMA(1, 0, At, B0); PG8_MMA(1, 1, At, B1); PG8_BAR; PG8_SCHED;
            PG8_LDB(B0, 1, 0); PG8_LDB(B1, 1, 1); PG8_SCHED; PG8_LDA(At, 1, 0); PG8_STAGE(PG8_SA(0, 1), a2 + hstep, voffA);
            PG8_WAIT_V(8); PG8_WAIT_L(0); PG8_BAR; PG8_MMA(0, 0, At, B0); PG8_MMA(0, 1, At, B1); PG8_BAR; PG8_SCHED;
            PG8_LDA(At, 1, 1); PG8_STAGE(PG8_SB(1, 0), b3, voffB); PG8_STAGE(PG8_SB(1, 1), b3 + hstep, voffB); PG8_STAGE(PG8_SA(1, 0), a3, voffA);
            PG8_WAIT_V(8); PG8_WAIT_L(0); PG8_BAR; PG8_MMA(1, 0, At, B0); PG8_MMA(1, 1, At, B1); PG8_BAR; PG8_SCHED;
            } else {
            PG8_LDB(B0, 0, 0); PG8_SCHED; PG8_LDA(At, 0, 0); PG8_STAGE(PG8_SA(1, 1), a1 + hstep, voffA);
            PG8_WAIT_L(8); PG8_BAR; PG8_WAIT_L(0); PG8_MMA(0, 0, At, B0); PG8_BAR; PG8_SCHED;
            PG8_LDB(B1, 0, 1); PG8_STAGE(PG8_SB(0, 0), b2, voffB);
            PG8_BAR; PG8_WAIT_L(0); PG8_MMA(0, 1, At, B1); PG8_BAR;
            PG8_LDA(At, 0, 1); PG8_STAGE(PG8_SA(0, 0), a2, voffA);
            PG8_BAR; PG8_WAIT_L(0); PG8_MMA(1, 0, At, B0); PG8_BAR; PG8_SCHED;
            PG8_STAGE(PG8_SB(0, 1), b2 + hstep, voffB);
            PG8_WAIT_V(6); PG8_BAR; PG8_MMA(1, 1, At, B1); PG8_BAR;
            PG8_LDB(B0, 1, 0); PG8_SCHED; PG8_LDA(At, 1, 0); PG8_STAGE(PG8_SA(0, 1), a2 + hstep, voffA);
            PG8_WAIT_L(8); PG8_BAR; PG8_WAIT_L(0); PG8_MMA(0, 0, At, B0); PG8_BAR; PG8_SCHED;
            PG8_LDB(B1, 1, 1); PG8_STAGE(PG8_SB(1, 0), b3, voffB);
            PG8_BAR; PG8_WAIT_L(0); PG8_MMA(0, 1, At, B1); PG8_BAR;
            PG8_LDA(At, 1, 1); PG8_STAGE(PG8_SA(1, 0), a3, voffA);
            PG8_BAR; PG8_WAIT_L(0); PG8_MMA(1, 0, At, B0); PG8_BAR; PG8_SCHED;
            PG8_STAGE(PG8_SB(1, 1), b3 + hstep, voffB);
            PG8_WAIT_V(6); PG8_BAR; PG8_MMA(1, 1, At, B1); PG8_BAR;
            }
        }
        if constexpr (ALIGN_EPI) { if (wr == 0) PG8_BAR; }
        bool do_epi = true;
        if (cur.split) {
            const size_t slice = (size_t)BM * X.ldn, rstep = (size_t)16 * X.ldn;
            float* rp = X.sum + (size_t)(cur.k0 / (cur.nt * BK)) * slice + (size_t)(wr * 64 + fr) * X.ldn + cur.pn * BM + wc * 32 + 8 * fq;
#pragma unroll
            for (int a = 0; a < 2; ++a) {
#pragma unroll
                for (int m = 0; m < 4; ++m) {
#pragma unroll
                    for (int b = 0; b < 2; ++b) { *(f32x4*)(rp + b * HALF) = acc[a][b][m][0]; *(f32x4*)(rp + b * HALF + 4) = acc[a][b][m][1]; }
                    rp += rstep;
                }
                rp += 4 * rstep;
            }
            do_epi = false;
        }
        if (do_epi) E(acc, cur, wr, wc, fr, fq);
        if (!has_next) break;
#pragma unroll
        for (int a = 0; a < 2; ++a)
#pragma unroll
            for (int b = 0; b < 2; ++b)
#pragma unroll
                for (int m = 0; m < 4; ++m)
#pragma unroll
                    for (int n = 0; n < 2; ++n) acc[a][b][m][n] = (f32x4){0.f, 0.f, 0.f, 0.f};
        cur = nxt; cA = nA; cB = nB; ++ui;
        if constexpr (ALIGN_EPI) { if (wr == 1) PG8_BAR; }
    }
    PG8_WAIT_V(0);
    if constexpr (!ALIGN_EPI) { if (wr == 0) PG8_BAR; }
    PG8_BAR;
    if constexpr (Epi::AFTER_DRAIN) { E.fused(acc, cur, wr, wc, fr, fq, lds, wid, lane); S.done(cur); }
#undef PG8_SA
#undef PG8_SB
#undef PG8_STAGE
#undef PG8_LDA
#undef PG8_LDB
#undef PG8_MMA
#undef PG8_WAIT_V
#undef PG8_WAIT_L
#undef PG8_BAR
#undef PG8_SCHED
}
}
constexpr int D = 1024, SEQ = 16384, MP = 2 * SEQ, MS = 256, MT = MP + MS, NIN = 1792, FF = 4096, DPLE = 256, CC = 512, QC = 512, KVC = 128;
constexpr float EPS = 1e-6f;
constexpr int NTHREADS = 512, NWAVES = 8;
constexpr int LDS_BYTES = 135168 + 256;
constexpr int MISC_OFF = 135168;
constexpr size_t WS_CTL = 0, CTL_ZERO_BYTES = 32768; constexpr int CW_SPLIT = 4096;
constexpr size_t OFF_Y = 0, OFF_NKP = (size_t)MT * D, OFF_NVP = OFF_NKP + 32768, OFF_NCP = OFF_NVP + 32768, OFF_NKS = OFF_NCP + 30720, OFF_NVS = OFF_NKS + 32768, OFF_NCS = OFF_NVS + 32768;
constexpr size_t MiB = 1u << 20;
constexpr size_t WS_WIN = 1 * MiB, WS_WOUT = 5 * MiB, WS_W1 = 7 * MiB, WS_W2 = 15 * MiB, WS_WG = 23 * MiB, WS_WP = 25 * MiB, WS_ROPE = 26 * MiB;
constexpr size_t WS_RSS1 = 30 * MiB, WS_RSS2 = 33 * MiB, WS_RSS3 = 36 * MiB;
constexpr size_t WS_HB = 40 * MiB, WS_PB = 105 * MiB, WS_PP = 122 * MiB, WS_HID = 188 * MiB;
constexpr size_t WS_A1 = 188 * MiB, WS_MIX = 253 * MiB, WS_U = 318 * MiB, WS_Q = 351 * MiB, WS_KB = 384 * MiB, WS_VB = 393 * MiB;
constexpr size_t WS_PART = 446 * MiB, WS_PARTB = 462 * MiB;
constexpr size_t WS_END = 478 * MiB;
static_assert(WS_HID + (size_t)MT * FF * 2 <= WS_PART && WS_VB + (size_t)MT * KVC * 2 <= WS_END && WS_PP + (size_t)MT * D * 2 <= WS_HID && WS_HB + (size_t)MT * D * 2 <= WS_PB && WS_PB + (size_t)MT * DPLE * 2 <= WS_PP, "ws map");

#define LAS __attribute__((address_space(3)))
typedef unsigned short bf16;
using pg8::f32x4; using pg8::u32x4; using pg8::bf16x8; using pg8::Unit;
typedef float f32x16 __attribute__((ext_vector_type(16)));
typedef unsigned u32x2 __attribute__((ext_vector_type(2)));
using pg8::pk2; using pg8::pk8; using pg8::bflo; using pg8::bfhi; using pg8::sigmoidf_;

struct Params { const float* in[22]; float* out; unsigned char* ws; };

__host__ __device__ __forceinline__ int win_dest(int c) {
    if (c < 512) return 256 * (c >> 7) + (c & 127);
    if (c < 1024) { c -= 512; return 256 * (c >> 7) + 128 + (c & 127); }
    if (c < 1536) { c -= 1024; const int hq = c >> 6, r = c & 63; return 256 * (4 + (hq >> 2)) + (r >> 5) * 128 + (hq & 3) * 32 + (r & 31); }
    if (c < 1664) { c -= 1536; const int hd = c >> 6, r = c & 63; return 1536 + (r >> 5) * 128 + hd * 32 + (r & 31); }
    c -= 1664; return 1536 + (c >> 6) * 128 + 64 + (c & 63);
}
__device__ __forceinline__ float wave_sum(float v) {
#pragma unroll
    for (int o = 1; o < 64; o <<= 1) v += __shfl_xor(v, o);
    return v;
}
#define LDS_WAIT() asm volatile("s_waitcnt lgkmcnt(0)" ::: "memory")

struct EpiIn {
    static constexpr bool PERM = true, AFTER_DRAIN = false;
    bf16 *U, *Q, *KB, *VB; const float* rope; float* out;
    __device__ __forceinline__ void operator()(const f32x4 (&acc)[2][2][4][2], const Unit& u, int wr, int wc, int fr, int fq) const {
        const int rowb = u.pm * 256 + wr * 64 + fr;
        if (u.pn < 4) {
            const int ch = 128 * u.pn + 32 * wc + 8 * fq;
#pragma unroll
            for (int ai = 0; ai < 2; ++ai)
#pragma unroll
                for (int m = 0; m < 4; ++m) {
                    const int row = rowb + ai * 128 + m * 16;
                    const bool isp = row < MP; const int srow = row - MP;
                    const int t = isp ? (row & (SEQ - 1)) : (srow & 31), bb = isp ? (row >> 14) : (srow >> 5);
                    f32x4 o0, o1;
#pragma unroll
                    for (int i = 0; i < 4; ++i) { o0[i] = acc[ai][0][m][0][i] * sigmoidf_(acc[ai][1][m][0][i]); o1[i] = acc[ai][0][m][1][i] * sigmoidf_(acc[ai][1][m][1][i]); }
                    *(u32x4*)(U + (size_t)row * CC + ch) = pk8(o0, o1);
                    float* dst = nullptr;
                    if (isp) { if (t >= SEQ - 30) dst = out + OFF_NCP + ((size_t)(bb * 30 + (t - (SEQ - 30)))) * CC + ch; }
                    else { if (t >= 2) dst = out + OFF_NCS + ((size_t)(bb * 30 + (t - 2))) * CC + ch; }
                    if (dst) { *(f32x4*)dst = o0; *(f32x4*)(dst + 4) = o1; }
                }
        } else if (u.pn < 6 || wc < 2) {
            const bool isq = u.pn < 6;
#pragma unroll
            for (int ai = 0; ai < 2; ++ai)
#pragma unroll
            for (int mh = 0; mh < 4; mh += 2) {
                f32x4 rp4[4][4];
#pragma unroll
                for (int m = mh; m < mh + 2; ++m) {
                    const int row = rowb + ai * 128 + m * 16;
                    const int pos = (row < MP) ? (row & (SEQ - 1)) : 2048 + ((row - MP) & 31);
                    const f32x4* rp = (const f32x4*)(rope + ((size_t)pos * 32 + 8 * fq) * 2);
                    rp4[m][0] = rp[0]; rp4[m][1] = rp[1]; rp4[m][2] = rp[2]; rp4[m][3] = rp[3];
                }
                asm volatile("" ::: "memory");
#pragma unroll
                for (int m = mh; m < mh + 2; ++m) {
                    const int row = rowb + ai * 128 + m * 16;
                    const bool isp = row < MP; const int srow = row - MP;
                    const int t = isp ? (row & (SEQ - 1)) : (srow & 31), bb = isp ? (row >> 14) : (srow >> 5);
                    bf16* op = isq ? Q + (size_t)row * QC + (4 * (u.pn - 4) + wc) * 64 + 8 * fq : KB + (size_t)row * KVC + wc * 64 + 8 * fq;
                    float* dst = nullptr;
                    if (!isq) {
                        if (isp) { if (t >= SEQ - 128) dst = out + OFF_NKP + ((size_t)((bb * 128 + (t - (SEQ - 128))) * 2 + wc)) * 64 + 8 * fq; }
                        else dst = out + OFF_NKS + ((size_t)(srow * 2 + wc)) * 64 + 8 * fq;
                    }
                    f32x4 a[2], b[2];
#pragma unroll
                    for (int n = 0; n < 2; ++n) {
                        const f32x4 r0 = rp4[m][2 * n], r1 = rp4[m][2 * n + 1];
                        const float cs[4] = {r0[0], r0[2], r1[0], r1[2]}, sn[4] = {r0[1], r0[3], r1[1], r1[3]};
#pragma unroll
                        for (int i = 0; i < 4; ++i) { const float x1 = acc[ai][0][m][n][i], x2 = acc[ai][1][m][n][i]; a[n][i] = x1 * cs[i] - x2 * sn[i]; b[n][i] = x2 * cs[i] + x1 * sn[i]; }
                    }
                    *(u32x4*)op = pk8(a[0], a[1]); *(u32x4*)(op + 32) = pk8(b[0], b[1]);
                    if (dst) { *(f32x4*)dst = a[0]; *(f32x4*)(dst + 4) = a[1]; *(f32x4*)(dst + 32) = b[0]; *(f32x4*)(dst + 36) = b[1]; }
                }
                asm volatile("" ::: "memory");
            }
        } else {
            const int dd = 32 * (wc - 2) + 8 * fq;
#pragma unroll
            for (int ai = 0; ai < 2; ++ai)
#pragma unroll
                for (int m = 0; m < 4; ++m) {
                    const int row = rowb + ai * 128 + m * 16;
                    const bool isp = row < MP; const int srow = row - MP;
                    const int t = isp ? (row & (SEQ - 1)) : (srow & 31), bb = isp ? (row >> 14) : (srow >> 5);
#pragma unroll
                    for (int bj = 0; bj < 2; ++bj) {
                        *(u32x4*)(VB + (size_t)row * KVC + 64 * bj + dd) = pk8(acc[ai][bj][m][0], acc[ai][bj][m][1]);
                        float* dst = nullptr;
                        if (isp) { if (t >= SEQ - 128) dst = out + OFF_NVP + ((size_t)((bb * 128 + (t - (SEQ - 128))) * 2 + bj)) * 64 + dd; }
                        else dst = out + OFF_NVS + ((size_t)(srow * 2 + bj)) * 64 + dd;
                        if (dst) { *(f32x4*)dst = acc[ai][bj][m][0]; *(f32x4*)(dst + 4) = acc[ai][bj][m][1]; }
                    }
                }
        }
    }
};
struct EpiPlain {
    static constexpr bool PERM = true, AFTER_DRAIN = false;
    bf16* O; int ldc;
    __device__ __forceinline__ void operator()(const f32x4 (&acc)[2][2][4][2], const Unit& u, int wr, int wc, int fr, int fq) const {
        const int rowb = u.pm * 256 + wr * 64 + fr, colb = u.pn * 256 + wc * 32 + 8 * fq;
#pragma unroll
        for (int ai = 0; ai < 2; ++ai)
#pragma unroll
            for (int m = 0; m < 4; ++m)
#pragma unroll
                for (int bj = 0; bj < 2; ++bj)
                    *(u32x4*)(O + (size_t)(rowb + ai * 128 + m * 16) * ldc + colb + bj * 128) = pk8(acc[ai][bj][m][0], acc[ai][bj][m][1]);
    }
};
__device__ __forceinline__ void wave_row_rs(const float* RSS, int base, int lane, int fr, float (&rs)[2][4]) {
    float r2[2];
#pragma unroll
    for (int a = 0; a < 2; ++a) {
        const f32x4* q = (const f32x4*)(RSS + (size_t)(base + 128 * a + lane) * 16);
        const f32x4 x0 = q[0], x1 = q[1], x2 = q[2], x3 = q[3];
        const float sm = (((x0[0] + x0[1]) + (x0[2] + x0[3])) + ((x1[0] + x1[1]) + (x1[2] + x1[3]))) + (((x2[0] + x2[1]) + (x2[2] + x2[3])) + ((x3[0] + x3[1]) + (x3[2] + x3[3])));
        r2[a] = __builtin_amdgcn_rsqf(sm * (1.0f / D) + EPS);
    }
#pragma unroll
    for (int a = 0; a < 2; ++a)
#pragma unroll
        for (int m = 0; m < 4; ++m) rs[a][m] = __shfl(r2[a], 16 * m + fr);
}
__device__ __forceinline__ float row_rs(const float* RSS, int row) {
    const f32x4* p = (const f32x4*)(RSS + (size_t)row * 16);
    const f32x4 a = p[0], b = p[1], c = p[2], d = p[3];
    const float s = ((a[0] + a[1]) + (a[2] + a[3])) + ((b[0] + b[1]) + (b[2] + b[3])) + ((c[0] + c[1]) + (c[2] + c[3])) + ((d[0] + d[1]) + (d[2] + d[3]));
    return __builtin_amdgcn_rsqf(s * (1.0f / D) + EPS);
}
template <bool FIRST>
struct EpiRes {
    static constexpr bool PERM = true, AFTER_DRAIN = false;
    const float* bp; const float* bs; bf16* HB; float* RSS; const float* RSSs = nullptr;
    bool seam = false; int ai0 = 0, ai1 = 2, m0 = 0, m1 = 4;
    __device__ __forceinline__ void operator()(const f32x4 (&acc)[2][2][4][2], const Unit& u, int wr, int wc, int fr, int fq) const {
        const int rowb = u.pm * 256 + wr * 64 + fr, colb = u.pn * 256 + wc * 32 + 8 * fq;
        float rs[2][4];
        if (!FIRST) wave_row_rs(RSSs, u.pm * 256 + wr * 64, fr + 16 * fq, fr, rs);
#pragma unroll
        for (int ai = 0; ai < 2; ++ai) if (ai >= ai0 && ai < ai1) {
            f32x4 bf[4][2][2]; u32x4 bw[4][2];
#pragma unroll
            for (int m = 0; m < 4; ++m) if (m >= m0 && m < m1) {
                const int row = rowb + ai * 128 + m * 16;
                if (FIRST) { const float* brow = (row < MP) ? bp + (size_t)row * D : bs + (size_t)(row - MP) * D;
#pragma unroll
                    for (int bj = 0; bj < 2; ++bj) { bf[m][bj][0] = *(const f32x4*)(brow + colb + bj * 128); bf[m][bj][1] = *(const f32x4*)(brow + colb + bj * 128 + 4); } }
                else {
#pragma unroll
                    for (int bj = 0; bj < 2; ++bj) bw[m][bj] = *(const u32x4*)(HB + (size_t)row * D + colb + bj * 128); }
            }
            asm volatile("" ::: "memory");
#pragma unroll
            for (int m = 0; m < 4; ++m) if (m >= m0 && m < m1) {
                const int row = rowb + ai * 128 + m * 16;
                float sc = 1.f; if (!FIRST) sc = rs[ai][m] * rs[ai][m];
                float ss = 0.f;
#pragma unroll
                for (int bj = 0; bj < 2; ++bj) {
                    const int col = colb + bj * 128;
                    f32x4 b0, b1;
                    if (FIRST) { b0 = bf[m][bj][0]; b1 = bf[m][bj][1]; }
                    else { const u32x4 w = bw[m][bj]; b0 = (f32x4){bflo(w.x), bfhi(w.x), bflo(w.y), bfhi(w.y)}; b1 = (f32x4){bflo(w.z), bfhi(w.z), bflo(w.w), bfhi(w.w)}; }
                    const f32x4 v0 = acc[ai][bj][m][0] * sc + b0, v1 = acc[ai][bj][m][1] * sc + b1;
                    *(u32x4*)(HB + (size_t)row * D + col) = pk8(v0, v1);
                    ss += (v0[0] * v0[0] + v0[1] * v0[1]) + (v0[2] * v0[2] + v0[3] * v0[3]) + (v1[0] * v1[0] + v1[1] * v1[1]) + (v1[2] * v1[2] + v1[3] * v1[3]);
                }
                ss += __shfl_xor(ss, 16); ss += __shfl_xor(ss, 32);
                if (fq == 0) RSS[(size_t)row * 16 + u.pn * 4 + wc] = ss;
            }
            asm volatile("" ::: "memory");
        }
    }
};
struct EpiFF1 {
    static constexpr bool PERM = true, AFTER_DRAIN = false;
    bf16* O; const float* RSS; bool seam = false; int ai0 = 0, ai1 = 2, m0 = 0, m1 = 4;
    __device__ __forceinline__ void operator()(const f32x4 (&acc)[2][2][4][2], const Unit& u, int wr, int wc, int fr, int fq) const {
        const int rowb = u.pm * 256 + wr * 64 + fr, colb = u.pn * 256 + wc * 32 + 8 * fq;
#pragma unroll
        for (int ai = 0; ai < 2; ++ai) if (ai >= ai0 && ai < ai1)
#pragma unroll
            for (int m = 0; m < 4; ++m) if (m >= m0 && m < m1) {
                const int row = rowb + ai * 128 + m * 16;
#pragma unroll
                for (int bj = 0; bj < 2; ++bj) {
                    f32x4 v0 = acc[ai][bj][m][0], v1 = acc[ai][bj][m][1];
#pragma unroll
                    for (int i = 0; i < 4; ++i) { const float a = fmaxf(v0[i], 0.f), b = fmaxf(v1[i], 0.f); v0[i] = a * a; v1[i] = b * b; }
                    *(u32x4*)(O + (size_t)row * FF + colb + bj * 128) = pk8(v0, v1);
                }
                if (seam) asm volatile("" ::: "memory");
            }
    }
};
struct EpiGate {
    static constexpr bool PERM = true, AFTER_DRAIN = false;
    const bf16* HB; bf16* H3B; const bf16* PP; const float* RSSin; float* RSSout; bool seam = false; int ai0 = 0, ai1 = 2, m0 = 0, m1 = 4;
    __device__ __forceinline__ void operator()(const f32x4 (&acc)[2][2][4][2], const Unit& u, int wr, int wc, int fr, int fq) const {
        const int rowb = u.pm * 256 + wr * 64 + fr, colb = u.pn * 256 + wc * 32 + 8 * fq;
        float rs[2][4];
        wave_row_rs(RSSin, u.pm * 256 + wr * 64, fr + 16 * fq, fr, rs);
#pragma unroll
        for (int ai = 0; ai < 2; ++ai) if (ai >= ai0 && ai < ai1) {
            u32x4 pwv[4][2], hwv[4][2];
#pragma unroll
            for (int m = 0; m < 4; ++m) if (m >= m0 && m < m1) {
                const int row = rowb + ai * 128 + m * 16;
#pragma unroll
                for (int bj = 0; bj < 2; ++bj) { pwv[m][bj] = *(const u32x4*)(PP + (size_t)row * D + colb + bj * 128); hwv[m][bj] = *(const u32x4*)(HB + (size_t)row * D + colb + bj * 128); }
            }
            asm volatile("" ::: "memory");
#pragma unroll
            for (int m = 0; m < 4; ++m) if (m >= m0 && m < m1) {
                const int row = rowb + ai * 128 + m * 16; const float r1 = rs[ai][m];
                float ss = 0.f;
#pragma unroll
                for (int bj = 0; bj < 2; ++bj) {
                    const int col = colb + bj * 128;
                    const u32x4 pw = pwv[m][bj], hw = hwv[m][bj];
                    const f32x4 p0 = {bflo(pw.x), bfhi(pw.x), bflo(pw.y), bfhi(pw.y)}, p1 = {bflo(pw.z), bfhi(pw.z), bflo(pw.w), bfhi(pw.w)};
                    f32x4 v0 = {bflo(hw.x), bfhi(hw.x), bflo(hw.y), bfhi(hw.y)}, v1 = {bflo(hw.z), bfhi(hw.z), bflo(hw.w), bfhi(hw.w)};
#pragma unroll
                    for (int i = 0; i < 4; ++i) { v0[i] += sigmoidf_(acc[ai][bj][m][0][i] * r1) * p0[i]; v1[i] += sigmoidf_(acc[ai][bj][m][1][i] * r1) * p1[i]; }
                    *(u32x4*)(H3B + (size_t)row * D + col) = pk8(v0, v1);
                    ss += (v0[0] * v0[0] + v0[1] * v0[1]) + (v0[2] * v0[2] + v0[3] * v0[3]) + (v1[0] * v1[0] + v1[1] * v1[1]) + (v1[2] * v1[2] + v1[3] * v1[3]);
                }
                ss += __shfl_xor(ss, 16); ss += __shfl_xor(ss, 32);
                if (fq == 0) RSSout[(size_t)row * 16 + u.pn * 4 + wc] = ss;
            }
            asm volatile("" ::: "memory");
        }
    }
};
template <bool MAP>
__device__ __forceinline__ void p0_transpose_item(const float* W, int K, int N, const float* gk, bf16* WT, LAS float* scr, int item, int lane) {
    const int nblk = N / 32, kb = item / nblk, nb = item % nblk, k0 = 64 * kb, n0 = 32 * nb;
#pragma unroll
    for (int i = 0; i < 32; ++i) { const int kk = 2 * i + (lane >> 5); float v = W[(size_t)(k0 + kk) * N + n0 + (lane & 31)]; if (gk) v *= gk[k0 + kk]; scr[kk * 33 + (lane & 31)] = v; }
    LDS_WAIT(); asm volatile("" ::: "memory");
    const int c = lane & 7, nd0 = MAP ? win_dest(n0) : n0;
#pragma unroll
    for (int j = 0; j < 4; ++j) { const int n = (lane >> 3) + 8 * j; const LAS float* s = scr + (8 * c) * 33 + n;
        u32x4 o; o.x = pk2(s[0 * 33], s[1 * 33]); o.y = pk2(s[2 * 33], s[3 * 33]); o.z = pk2(s[4 * 33], s[5 * 33]); o.w = pk2(s[6 * 33], s[7 * 33]);
        *(u32x4*)(WT + (size_t)(nd0 + n) * K + k0 + 8 * c) = o; }
    LDS_WAIT(); asm volatile("" ::: "memory");
}
__device__ __forceinline__ void p0_prologue(const Params& p, LAS unsigned char* lds, int G, int tid, int wid, int lane) {
    unsigned char* ws = p.ws;
    LAS float* scr = (LAS float*)(lds + wid * 16384);
    const int gw = blockIdx.x * NWAVES + wid, NGW = G * NWAVES;
    constexpr int I_IN = (D / 64) * (NIN / 32), I_O = (D / 64) * (D / 32), I_P = (DPLE / 64) * (D / 32);
    constexpr int NITEMS = I_IN + I_O + I_P;
    for (int it = gw; it < NITEMS; it += NGW) {
        int r = it;
        if (r < I_IN) { p0_transpose_item<true>(p.in[8], D, NIN, nullptr, (bf16*)(ws + WS_WIN), scr, r, lane); continue; } r -= I_IN;
        if (r < I_O) { p0_transpose_item<false>(p.in[14], D, D, nullptr, (bf16*)(ws + WS_WOUT), scr, r, lane); continue; } r -= I_O;
        p0_transpose_item<false>(p.in[20], DPLE, D, nullptr, (bf16*)(ws + WS_WP), scr, r, lane);
    }
    const f32x4* g4 = (const f32x4*)p.in[7] + lane;
    bf16* A1 = (bf16*)(ws + WS_A1); bf16* PB = (bf16*)(ws + WS_PB);
    for (int row = gw * 2; row < MT; row += NGW * 2) {
        f32x4 v[2][4]; f32x4 pv[2]; float s[2];
#pragma unroll
        for (int k = 0; k < 2; ++k) {
            const int rr = row + k;
            const float* xr = (rr < MP) ? p.in[0] + (size_t)rr * D : p.in[1] + (size_t)(rr - MP) * D;
            const f32x4* x4 = (const f32x4*)xr + lane;
#pragma unroll
            for (int j = 0; j < 4; ++j) v[k][j] = x4[64 * j];
            const float* pr = (rr < MP) ? p.in[2] + (size_t)rr * DPLE : p.in[3] + (size_t)(rr - MP) * DPLE;
            pv[k] = ((const f32x4*)pr)[lane];
        }
#pragma unroll
        for (int k = 0; k < 2; ++k) {
            s[k] = 0.f;
#pragma unroll
            for (int j = 0; j < 4; ++j) s[k] += (v[k][j][0] * v[k][j][0] + v[k][j][1] * v[k][j][1]) + (v[k][j][2] * v[k][j][2] + v[k][j][3] * v[k][j][3]);
            const float rs = __builtin_amdgcn_rsqf(wave_sum(s[k]) * (1.0f / D) + EPS);
            u32x2* o = (u32x2*)(A1 + (size_t)(row + k) * D) + lane;
#pragma unroll
            for (int j = 0; j < 4; ++j) { const f32x4 g = g4[64 * j]; u32x2 w; w.x = pk2(v[k][j][0] * rs * g[0], v[k][j][1] * rs * g[1]); w.y = pk2(v[k][j][2] * rs * g[2], v[k][j][3] * rs * g[3]); o[64 * j] = w; }
            u32x2 w; w.x = pk2(pv[k][0], pv[k][1]); w.y = pk2(pv[k][2], pv[k][3]); ((u32x2*)(PB + (size_t)(row + k) * DPLE))[lane] = w;
        }
    }
    float* rope = (float*)(ws + WS_ROPE);
    for (int idx = blockIdx.x * NTHREADS + tid; idx < SEQ * 32; idx += G * NTHREADS) {
        const int pos = idx >> 5, d = idx & 31;
        const float inv = (float)(1.0 / exp2((double)d * (13.287712379549449 / 32.0)));
        const float ang = (float)pos * inv;
        const double a = (double)ang, k = rint(a * 0.15915494309189535);
        const double r = fma(-k, 1.2246467991473532e-16 * 2.0, fma(-k, 6.283185307179586, a));
        const float rf = (float)r;
        ((pg8::f32x2*)rope)[idx] = (pg8::f32x2){cosf(rf), sinf(rf)};
    }
}

__device__ __forceinline__ void shadow_transpose(const float* W, int K, int N, const float* gk, bf16* WT, LAS unsigned char* lds, int cu, int ncu) {
    int t = threadIdx.x; asm volatile("" : "+v"(t));
    const int lane = t & 63, wid = __builtin_amdgcn_readfirstlane(t >> 6);
    LAS float* scr = (LAS float*)(lds + wid * 16384);
    const int nitems = (K / 64) * (N / 32);
    for (int it = cu * NWAVES + wid; it < nitems; it += ncu * NWAVES) p0_transpose_item<false>(W, K, N, gk, WT, scr, it, lane);
}

constexpr int N_ATT_P = 2 * 256 * 2, N_ATT = N_ATT_P + 16, N_CONV_P = MP / 64, N_CONV = N_CONV_P + 4;
constexpr int DCP = 516;
static_assert(64 * DCP * 4 <= MISC_OFF, "conv tile fits under the barrier words");
__device__ __forceinline__ void conv_item(const Params& p, LAS unsigned char* lds, int item, int tid, int wid, int lane) {
    typedef pg8::f32x2 f2;
    const bf16* U = (const bf16*)(p.ws + WS_U); bf16* MIX = (bf16*)(p.ws + WS_MIX);
    LAS float* DC = (LAS float*)lds;
    const int half = wid >> 2, c2 = 2 * (tid & 255);
    const bool sample = item >= N_CONV_P;
    const int row0 = item * 64, rowh = row0 + 32 * half;
    f2 win[62];
    if (!sample) {
        const int t0 = rowh & (SEQ - 1);
#pragma unroll
        for (int k = 0; k < 62; ++k) {
            const int tk = t0 - 30 + k;
            unsigned w = *(const unsigned*)(U + (size_t)(rowh - 30 + k - (tk < 0 ? tk : 0)) * CC + c2);
            if (tk < 0) w = 0u;
            win[k] = (f2){bflo(w), bfhi(w)};
        }
    } else {
        const float* sc = p.in[6] + (size_t)((item - N_CONV_P) * 2 + half) * 30 * CC + c2;
#pragma unroll
        for (int k = 0; k < 30; ++k) win[k] = *(const f2*)(sc + (size_t)k * CC);
#pragma unroll
        for (int k = 30; k < 62; ++k) { const unsigned w = *(const unsigned*)(U + (size_t)(rowh - 30 + k) * CC + c2); win[k] = (f2){bflo(w), bfhi(w)}; }
    }
    f2 w[31];
#pragma unroll
    for (int j = 0; j < 31; ++j) w[j] = *(const f2*)(p.in[9] + j * CC + c2);
    const f2 bias = *(const f2*)(p.in[10] + c2);
#pragma unroll
    for (int r = 0; r < 32; ++r) {
        f2 a = bias;
#pragma unroll
        for (int j = 0; j < 31; ++j) a = w[j] * win[r + j] + a;
        *(LAS f2*)(DC + (32 * half + r) * DCP + c2) = a;
    }
    __syncthreads();
    const int c8 = lane * 8;
    const f32x4 g0 = *(const f32x4*)(p.in[11] + c8), g1 = *(const f32x4*)(p.in[11] + c8 + 4), b0 = *(const f32x4*)(p.in[12] + c8), b1 = *(const f32x4*)(p.in[12] + c8 + 4);
#pragma unroll
    for (int rr = 0; rr < 8; ++rr) {
        const int r = 8 * wid + rr;
        f32x4 x0 = *(const LAS f32x4*)(DC + r * DCP + c8), x1 = *(const LAS f32x4*)(DC + r * DCP + c8 + 4);
        const float mean = wave_sum((x0[0] + x0[1]) + (x0[2] + x0[3]) + (x1[0] + x1[1]) + (x1[2] + x1[3])) * (1.0f / CC);
        x0 = x0 - mean; x1 = x1 - mean;
        const float var = wave_sum((x0[0] * x0[0] + x0[1] * x0[1]) + (x0[2] * x0[2] + x0[3] * x0[3]) + (x1[0] * x1[0] + x1[1] * x1[1]) + (x1[2] * x1[2] + x1[3] * x1[3])) * (1.0f / CC);
        const float rstd = __builtin_amdgcn_rsqf(var + EPS);
        f32x4 y0 = x0 * rstd * g0 + b0, y1 = x1 * rstd * g1 + b1;
#pragma unroll
        for (int i = 0; i < 4; ++i) { y0[i] *= sigmoidf_(y0[i]); y1[i] *= sigmoidf_(y1[i]); }
        *(u32x4*)(MIX + (size_t)(row0 + r) * D + c8) = pk8(y0, y1);
    }
    __syncthreads();
}

constexpr int KSP = 144, VTP = 408, VT_OFF = 192 * KSP;
#define MFMA32(a, b, c) __builtin_amdgcn_mfma_f32_32x32x16_bf16((a), (b), (c), 0, 0, 0)
__device__ __forceinline__ void attn_item(const Params& p, LAS unsigned char* lds, int item, int tid, int wid, int lane) {
    const bf16* Q = (const bf16*)(p.ws + WS_Q); const bf16* KB = (const bf16*)(p.ws + WS_KB); const bf16* VB = (const bf16*)(p.ws + WS_VB); bf16* MIX = (bf16*)(p.ws + WS_MIX);
    const bool sample = item >= N_ATT_P;
    int b, n, kvh, kt0, kt1;
    if (!sample) { b = item >> 9; n = (item >> 1) & 255; kvh = item & 1; kt0 = (n >= 2) ? 0 : (n == 1 ? 2 : 4); kt1 = 6; }
    else { const int s = item - N_ATT_P; b = s >> 1; n = 0; kvh = s & 1; kt0 = 0; kt1 = 5; }
    const int keyrow0 = b * SEQ + (n - 2) * 64;
    if (!sample) {
        u32x4 kv[3], vv[3];
#pragma unroll
        for (int i = 0; i < 3; ++i) {
            const int id = tid + NTHREADS * i, j = id >> 3, c = id & 7, jc = j < 32 * kt0 ? 32 * kt0 : j;
            const size_t grow = (size_t)(keyrow0 + jc);
            kv[i] = *(const u32x4*)(KB + grow * KVC + kvh * 64 + c * 8); vv[i] = *(const u32x4*)(VB + grow * KVC + kvh * 64 + c * 8);
        }
#pragma unroll
        for (int i = 0; i < 3; ++i) {
            const int id = tid + NTHREADS * i, j = id >> 3, c = id & 7;
            if (j >= 32 * kt0) {
                *(LAS u32x4*)(lds + j * KSP + c * 16) = kv[i];
                LAS unsigned short* vt = (LAS unsigned short*)(lds + VT_OFF + (8 * c) * VTP) + j;
                vt[0 * (VTP / 2)] = (unsigned short)(vv[i].x & 0xffffu); vt[1 * (VTP / 2)] = (unsigned short)(vv[i].x >> 16);
                vt[2 * (VTP / 2)] = (unsigned short)(vv[i].y & 0xffffu); vt[3 * (VTP / 2)] = (unsigned short)(vv[i].y >> 16);
                vt[4 * (VTP / 2)] = (unsigned short)(vv[i].z & 0xffffu); vt[5 * (VTP / 2)] = (unsigned short)(vv[i].z >> 16);
                vt[6 * (VTP / 2)] = (unsigned short)(vv[i].w & 0xffffu); vt[7 * (VTP / 2)] = (unsigned short)(vv[i].w >> 16);
            }
        }
    } else {
#pragma unroll
    for (int i = 0; i < 3; ++i) {
        const int id = tid + NTHREADS * i, j = id >> 3, c = id & 7;
        if (j >= 32 * kt0 && j < 32 * kt1) {
            u32x4 kv, vv;
            if (!sample || j >= 128) {
                const size_t grow = sample ? (size_t)(MP + b * 32 + (j - 128)) : (size_t)(keyrow0 + j);
                kv = *(const u32x4*)(KB + grow * KVC + kvh * 64 + c * 8); vv = *(const u32x4*)(VB + grow * KVC + kvh * 64 + c * 8);
            } else {
                const size_t off = ((size_t)(b * 128 + j) * 2 + kvh) * 64 + c * 8;
                const f32x4 k0 = *(const f32x4*)(p.in[4] + off), k1 = *(const f32x4*)(p.in[4] + off + 4), v0 = *(const f32x4*)(p.in[5] + off), v1 = *(const f32x4*)(p.in[5] + off + 4);
                kv = pk8(k0, k1); vv = pk8(v0, v1);
            }
            *(LAS u32x4*)(lds + j * KSP + c * 16) = kv;
            LAS unsigned short* vt = (LAS unsigned short*)(lds + VT_OFF + (8 * c) * VTP) + j;
            vt[0 * (VTP / 2)] = (unsigned short)(vv.x & 0xffffu); vt[1 * (VTP / 2)] = (unsigned short)(vv.x >> 16);
            vt[2 * (VTP / 2)] = (unsigned short)(vv.y & 0xffffu); vt[3 * (VTP / 2)] = (unsigned short)(vv.y >> 16);
            vt[4 * (VTP / 2)] = (unsigned short)(vv.z & 0xffffu); vt[5 * (VTP / 2)] = (unsigned short)(vv.z >> 16);
            vt[6 * (VTP / 2)] = (unsigned short)(vv.w & 0xffffu); vt[7 * (VTP / 2)] = (unsigned short)(vv.w >> 16);
        }
    }
    }
    __syncthreads();
    const int g = wid >> 1, qh = wid & 1, head = kvh * 4 + g, q = lane & 31, h = lane >> 5;
    if (!sample || qh == 0) {
        const size_t qrow = sample ? (size_t)(MP + b * 32 + q) : (size_t)(b * SEQ + n * 64 + qh * 32 + q);
        bf16x8 bq[4];
#pragma unroll
        for (int ks = 0; ks < 4; ++ks) bq[ks] = *(const bf16x8*)(Q + qrow * QC + head * 64 + ks * 16 + 8 * h);
        f32x16 st[6];
#pragma unroll
        for (int kt = 0; kt < 6; ++kt) {
#pragma unroll
            for (int r = 0; r < 16; ++r) st[kt][r] = 0.f;
            if (kt >= kt0 && kt < kt1) {
#pragma unroll
                for (int ks = 0; ks < 4; ++ks) { const bf16x8 a = *(const LAS bf16x8*)(lds + (32 * kt + q) * KSP + (16 * ks + 8 * h) * 2); st[kt] = MFMA32(a, bq[ks], st[kt]); }
            }
        }
        const float sk = p.in[13][head];
        float mx = sk;
#pragma unroll
        for (int kt = 0; kt < 6; ++kt) if (kt >= kt0 && kt < kt1) {
#pragma unroll
            for (int r = 0; r < 16; ++r) mx = fmaxf(mx, st[kt][r] * 0.125f);
        }
        mx = fmaxf(mx, __shfl_xor(mx, 32));
        float sum = 0.f;
#pragma unroll
        for (int kt = 0; kt < 6; ++kt) if (kt >= kt0 && kt < kt1) {
#pragma unroll
            for (int r = 0; r < 16; ++r) { const float e = __expf(st[kt][r] * 0.125f - mx); st[kt][r] = e; sum += e; }
        }
        sum += __shfl_xor(sum, 32); sum += __expf(sk - mx);
        f32x16 o[2];
#pragma unroll
        for (int r = 0; r < 16; ++r) { o[0][r] = 0.f; o[1][r] = 0.f; }
#pragma unroll
        for (int kt = 0; kt < 6; ++kt) if (kt >= kt0 && kt < kt1) {
#pragma unroll
            for (int s = 0; s < 2; ++s) {
                u32x4 pw; pw.x = pk2(st[kt][8 * s + 0], st[kt][8 * s + 1]); pw.y = pk2(st[kt][8 * s + 2], st[kt][8 * s + 3]); pw.z = pk2(st[kt][8 * s + 4], st[kt][8 * s + 5]); pw.w = pk2(st[kt][8 * s + 6], st[kt][8 * s + 7]);
                const bf16x8 pb = __builtin_bit_cast(bf16x8, pw);
#pragma unroll
                for (int dt = 0; dt < 2; ++dt) {
                    const LAS unsigned char* vp = lds + VT_OFF + (32 * dt + q) * VTP + (32 * kt + 16 * s + 4 * h) * 2;
                    const u32x2 lo = *(const LAS u32x2*)vp, hi = *(const LAS u32x2*)(vp + 16);
                    const u32x4 aw = {lo.x, lo.y, hi.x, hi.y};
                    o[dt] = MFMA32(__builtin_bit_cast(bf16x8, aw), pb, o[dt]);
                }
            }
        }
        const float inv = 1.0f / sum;
        bf16* op = MIX + qrow * D + CC + head * 64 + 4 * h;
#pragma unroll
        for (int dt = 0; dt < 2; ++dt)
#pragma unroll
            for (int gq = 0; gq < 4; ++gq) { u32x2 w; w.x = pk2(o[dt][4 * gq + 0] * inv, o[dt][4 * gq + 1] * inv); w.y = pk2(o[dt][4 * gq + 2] * inv, o[dt][4 * gq + 3] * inv); *(u32x2*)(op + 32 * dt + 8 * gq) = w; }
    }
    __syncthreads();
}

#define XB_TMO      128
#define XB_XCNT(j)  (256  + 64 * (j))
#define XB_XSUB(j)  (1280 + 64 * (j))
#define XB_XGEN(j)  (2304 + 64 * (j))
#define XB_TOP      3328
#define XB_TOPGEN   3392
#define XCD_BAR_WORDS 3456
#define XB_SPIN_CAP (1u << 18)

__device__ __forceinline__ unsigned xb_ld(unsigned* p)              { return __hip_atomic_load(p, __ATOMIC_RELAXED, __HIP_MEMORY_SCOPE_AGENT); }
__device__ __forceinline__ unsigned xb_add(unsigned* p, unsigned v) { return __hip_atomic_fetch_add(p, v, __ATOMIC_RELAXED, __HIP_MEMORY_SCOPE_AGENT); }
__device__ __forceinline__ unsigned xb_xcc_id() { return (unsigned)__builtin_amdgcn_s_getreg((3 << 11) | 20) & 0xFu; }
#define XB_SPIN(cond, bar) do { unsigned _sp = 0; while (cond) { __builtin_amdgcn_s_sleep(1); \
    if ((++_sp & 255u) == 0u) { if (xb_ld(&(bar)[XB_TMO])) break; if (_sp > XB_SPIN_CAP) { atomicAdd(&(bar)[XB_TMO], 1u); break; } } } } while (0)

struct XcdBarrier {
    unsigned* bar; unsigned x;
    volatile LAS unsigned* st;
};

__device__ __forceinline__ XcdBarrier xcd_barrier_post(unsigned* bar, volatile LAS unsigned* st) {
    XcdBarrier b; b.bar = bar; b.x = xb_xcc_id(); b.st = st;
    if (threadIdx.x == 0) (void)xb_add(&bar[XB_XCNT(b.x)], 1u);
    return b;
}
__device__ __forceinline__ void xcd_barrier_complete(unsigned* bar, unsigned x, unsigned& nloc, unsigned& nx) {
    const unsigned G = gridDim.x * gridDim.y * gridDim.z;
    unsigned sum, cnt, mine, sp = 0u;
    for (;;) {
        sum = 0u; cnt = 0u; mine = 0u;
#pragma unroll
        for (unsigned j = 0; j < 16; ++j) { const unsigned c = xb_ld(&bar[XB_XCNT(j)]); sum += c; cnt += (c > 0u) ? 1u : 0u; mine = (j == x) ? c : mine; }
        if (sum == G) break;
        __builtin_amdgcn_s_sleep(1);
        if ((++sp & 255u) == 0u) { if (xb_ld(&bar[XB_TMO])) break; if (sp > XB_SPIN_CAP) { atomicAdd(&bar[XB_TMO], 1u); break; } }
    }
    nloc = mine > 0u ? mine : 1u; nx = cnt > 0u ? cnt : 1u;
}

__device__ __forceinline__ void xcd_barrier(const XcdBarrier& b) {
    asm volatile("s_waitcnt vmcnt(0)" ::: "memory");
    __syncthreads();
    if (threadIdx.x == 0) {
        unsigned* bar = b.bar;
        __builtin_amdgcn_s_waitcnt(0);
        unsigned nloc = b.st[0], nx = b.st[1];
        if (nloc == 0u) { xcd_barrier_complete(bar, b.x, nloc, nx); b.st[0] = nloc; b.st[1] = nx; }
        const unsigned old = xb_add(&bar[XB_XSUB(b.x)], 1u);
        const unsigned gen = old / nloc;
        if (old + 1u == (gen + 1u) * nloc) {
            __builtin_amdgcn_fence(__ATOMIC_RELEASE, "agent");
            asm volatile("s_waitcnt vmcnt(0)" ::: "memory");
            const unsigned og = xb_add(&bar[XB_TOP], 1u);
            const unsigned tg = og / nx;
            if (og + 1u == (tg + 1u) * nx) xb_add(&bar[XB_TOPGEN], 1u);
            else XB_SPIN(xb_ld(&bar[XB_TOPGEN]) == tg, bar);
            __builtin_amdgcn_fence(__ATOMIC_ACQUIRE, "agent");
            xb_add(&bar[XB_XGEN(b.x)], 1u);
            asm volatile("s_waitcnt vmcnt(0)" ::: "memory");
        } else {
            XB_SPIN(xb_ld(&bar[XB_XGEN(b.x)]) == gen, bar);
            __builtin_amdgcn_fence(__ATOMIC_ACQUIRE, "agent");
            asm volatile("s_waitcnt vmcnt(0)" ::: "memory");
        }
    }
    __syncthreads();
}


template <int NS, class Epi>
__device__ __forceinline__ void sample_fixup(const float* part, int ldn, int item, const Epi& E, unsigned* cnt) {
    int tid_ = threadIdx.x; asm volatile("" : "+v"(tid_));
    const int lane = tid_ & 63, wid = __builtin_amdgcn_readfirstlane(tid_ >> 6), wr = wid >> 2, wc = wid & 3, fr = lane & 15, fq = lane >> 4;
    const int pn = item >> 3, ah = (item >> 2) & 1, mh = item & 3;
    const size_t slice = (size_t)256 * ldn;
    const float* q = part + (size_t)(ah * 128 + wr * 64 + mh * 16 + fr) * ldn + pn * 256 + wc * 32 + 8 * fq;
    f32x4 s0 = {0.f, 0.f, 0.f, 0.f}, s1 = s0, s2 = s0, s3 = s0;
#pragma unroll
    for (int k4 = 0; k4 < NS; k4 += 4) {
        f32x4 l[4][4];
#pragma unroll
        for (int ks = 0; ks < 4; ++ks) { l[ks][0] = *(const f32x4*)(q); l[ks][1] = *(const f32x4*)(q + 4); l[ks][2] = *(const f32x4*)(q + 128); l[ks][3] = *(const f32x4*)(q + 132); q += slice; }
        s0 += (l[0][0] + l[1][0]) + (l[2][0] + l[3][0]); s1 += (l[0][1] + l[1][1]) + (l[2][1] + l[3][1]); s2 += (l[0][2] + l[1][2]) + (l[2][2] + l[3][2]); s3 += (l[0][3] + l[1][3]) + (l[2][3] + l[3][3]);
    }
    Unit u; u.pm = MP / 256; u.pn = pn; u.k0 = 0; u.nt = 0; u.split = 0;
#pragma unroll
    for (int a = 0; a < 2; ++a)
#pragma unroll
        for (int m = 0; m < 4; ++m)
            if (a == ah && m == mh) {
                f32x4 acc[2][2][4][2];
#pragma unroll
                for (int x = 0; x < 2; ++x)
#pragma unroll
                    for (int b = 0; b < 2; ++b)
#pragma unroll
                        for (int y = 0; y < 4; ++y) { acc[x][b][y][0] = (f32x4){0.f, 0.f, 0.f, 0.f}; acc[x][b][y][1] = (f32x4){0.f, 0.f, 0.f, 0.f}; }
                acc[a][0][m][0] = s0; acc[a][0][m][1] = s1; acc[a][1][m][0] = s2; acc[a][1][m][1] = s3;
                Epi Eh = E; Eh.ai0 = a; Eh.ai1 = a + 1; Eh.m0 = m; Eh.m1 = m + 1;
                Eh(acc, u, wr, wc, fr, fq);
            }
    if (cnt) {
        asm volatile("s_waitcnt vmcnt(0)" ::: "memory");
        __syncthreads();
        if (wid == 0) {
            __builtin_amdgcn_fence(__ATOMIC_RELEASE, "agent");
            asm volatile("s_waitcnt vmcnt(0)" ::: "memory");
            if (lane == 0) (void)__hip_atomic_fetch_add(cnt, 1u, __ATOMIC_RELAXED, __HIP_MEMORY_SCOPE_AGENT);
        }
    }
}

__device__ __forceinline__ void p7_rows(float* out, const bf16* H3B, const float* RSS3, const float* gfin, int row0, int row_end, int step) {
    int t7 = threadIdx.x; asm volatile("" : "+v"(t7));
    const int lane = t7 & 63, wid = __builtin_amdgcn_readfirstlane(t7 >> 6);
    const f32x4* g4 = (const f32x4*)gfin + 2 * lane;
    const f32x4 ga = g4[0], gb = g4[1], gc = g4[128], gd = g4[129];
    for (int row = row0 + wid * 2; row < row_end; row += step) {
        float part[2]; u32x4 w[2][2];
#pragma unroll
        for (int k = 0; k < 2; ++k) {
            part[k] = RSS3[(size_t)(row + k) * 16 + (lane & 15)]; if (lane >= 16) part[k] = 0.f;
            const u32x4* hp = (const u32x4*)(H3B + (size_t)(row + k) * D) + lane;
            w[k][0] = hp[0]; w[k][1] = hp[64];
        }
#pragma unroll
        for (int k = 0; k < 2; ++k) {
            const float rs = __builtin_amdgcn_rsqf(wave_sum(part[k]) * (1.0f / D) + EPS);
            f32x4* o = (f32x4*)(out + (size_t)(row + k) * D) + 2 * lane;
            const u32x4 a = w[k][0], b = w[k][1];
            o[0] = (f32x4){bflo(a.x), bfhi(a.x), bflo(a.y), bfhi(a.y)} * rs * ga; o[1] = (f32x4){bflo(a.z), bfhi(a.z), bflo(a.w), bfhi(a.w)} * rs * gb;
            o[128] = (f32x4){bflo(b.x), bfhi(b.x), bflo(b.y), bfhi(b.y)} * rs * gc; o[129] = (f32x4){bflo(b.z), bfhi(b.z), bflo(b.w), bfhi(b.w)} * rs * gd;
        }
    }
}

__global__ void __launch_bounds__(NTHREADS, 2) fwd_megakernel(Params p) {
    extern __shared__ __attribute__((aligned(16))) unsigned char lds_raw[];
    LAS unsigned char* lds = (LAS unsigned char*)lds_raw;
    cg::grid_group grid = cg::this_grid();
    const int tid = threadIdx.x, lane = tid & 63, wid = __builtin_amdgcn_readfirstlane(tid >> 6), G = gridDim.x, bx = blockIdx.x;
    unsigned char* ws = p.ws;
    bf16* A1 = (bf16*)(ws + WS_A1); bf16* HB = (bf16*)(ws + WS_HB); bf16* PB = (bf16*)(ws + WS_PB); bf16* PP = (bf16*)(ws + WS_PP); bf16* HID = (bf16*)(ws + WS_HID); bf16* MIX = (bf16*)(ws + WS_MIX); bf16* H3B = (bf16*)(ws + WS_A1);
    unsigned* ctl = (unsigned*)(ws + WS_CTL);
    float* RSS1 = (float*)(ws + WS_RSS1); float* RSS2 = (float*)(ws + WS_RSS2); float* RSS3 = (float*)(ws + WS_RSS3);

    volatile LAS unsigned* MISC = (volatile LAS unsigned*)(lds + MISC_OFF);
    if (tid < 64) MISC[tid] = 0u;
    __syncthreads();
    XcdBarrier bar = xcd_barrier_post((unsigned*)(ws + WS_CTL), MISC + 8);
    p0_prologue(p, lds, G, tid, wid, lane);
    if (p.ws == nullptr) grid.sync();
    xcd_barrier(bar);
    {
        pg8::Gemm g{A1, (const bf16*)(ws + WS_WIN), MT, NIN, D}; pg8::StaticOrder S; S.init(MT, NIN, D, G, bx);
        EpiIn E{(bf16*)(ws + WS_U), (bf16*)(ws + WS_Q), (bf16*)(ws + WS_KB), (bf16*)(ws + WS_VB), (const float*)(ws + WS_ROPE), p.out};
        pg8::gemm_phase<EpiIn, pg8::StaticOrder, true, true>(lds, g, S, E);
        pg8::Gemm g2{PB, (const bf16*)(ws + WS_WP), MT, D, DPLE}; pg8::StaticOrder S2; S2.init(MT, D, DPLE, G, G - 1 - bx);
        EpiPlain E2{PP, D};
        pg8::gemm_phase<EpiPlain, pg8::StaticOrder, true, true>(lds, g2, S2, E2);
    }
    xcd_barrier(bar);
    const int vb = (G % 8 == 0) ? (bx % 8) * (G / 8) + bx / 8 : bx;
    for (int it = vb; it < N_ATT; it += G) { if (G == 256 && vb >= G - 4 && it == vb + 3 * G) continue; attn_item(p, lds, it, tid, wid, lane); }
    if (G == 256 && vb >= 16 && vb < 20) attn_item(p, lds, (G - 4 + (vb - 16)) + 3 * G, tid, wid, lane);
    for (int it = G - 1 - vb; it < N_CONV; it += G) conv_item(p, lds, it, tid, wid, lane);
    xcd_barrier(bar);
    float* PARTA = (float*)(ws + WS_PART); float* PARTB = (float*)(ws + WS_PARTB);
    unsigned* cnt3 = ctl + CW_SPLIT; unsigned* cnt4 = ctl + CW_SPLIT + 64; unsigned* cnt5 = ctl + CW_SPLIT + 128;
    {
        pg8::Gemm g{MIX, (const bf16*)(ws + WS_WOUT), MT, D, D}; pg8::SplitOrder S; S.init(MP, D, D, 256, G, bx, nullptr, 0u);
        EpiRes<true> E{p.in[0], p.in[1], HB, RSS1};
        pg8::gemm_phase<EpiRes<true>, pg8::SplitOrder, true, true>(lds, g, S, E, pg8::SplitCtx{PARTA, D});
        if (bx >= 16) shadow_transpose(p.in[16], D, FF, p.in[15], (bf16*)(ws + WS_W1), lds, bx - 16, G - 16);
    }
    xcd_barrier(bar);
    {
        if (bx >= G - 32) { EpiRes<true> Ef{p.in[0], p.in[1], HB, RSS1}; sample_fixup<4>(PARTA, D, G - 1 - bx, Ef, cnt3); }
        pg8::Gemm g{HB, (const bf16*)(ws + WS_W1), MT, FF, D}; pg8::SplitOrder S; S.init(MP, FF, D, 256, G, bx, cnt3, 32u);
        EpiFF1 E{HID, RSS1};
        pg8::gemm_phase<EpiFF1, pg8::SplitOrder, true, true>(lds, g, S, E, pg8::SplitCtx{PARTB, FF});
        if (bx >= 64) shadow_transpose(p.in[17], FF, D, nullptr, (bf16*)(ws + WS_W2), lds, bx - 64, G - 64);
    }
    xcd_barrier(bar);
    {
        if (bx >= G - 128) { EpiFF1 Ef{HID, RSS1}; sample_fixup<4>(PARTB, FF, G - 1 - bx, Ef, cnt4); }
        pg8::Gemm g{HID, (const bf16*)(ws + WS_W2), MT, D, FF}; pg8::SplitOrder S; S.init(MP, D, FF, 512, G, bx, cnt4, 128u);
        EpiRes<false> E{nullptr, nullptr, HB, RSS2, RSS1};
        pg8::gemm_phase<EpiRes<false>, pg8::SplitOrder, true, true>(lds, g, S, E, pg8::SplitCtx{PARTA, D});
        if (bx >= 32) shadow_transpose(p.in[19], D, D, p.in[18], (bf16*)(ws + WS_WG), lds, bx - 32, G - 32);
    }
    xcd_barrier(bar);
    {
        if (bx >= G - 32) { EpiRes<false> Ef{nullptr, nullptr, HB, RSS2, RSS1}; sample_fixup<8>(PARTA, D, G - 1 - bx, Ef, cnt5); }
        pg8::Gemm g{HB, (const bf16*)(ws + WS_WG), MT, D, D}; pg8::SplitOrder S; S.init(MP, D, D, 256, G, bx, cnt5, 32u);
        EpiGate E{HB, H3B, PP, RSS2, RSS3};
        pg8::gemm_phase<EpiGate, pg8::SplitOrder, true, true>(lds, g, S, E, pg8::SplitCtx{PARTB, D});
    }
    xcd_barrier(bar);
    if (G != 256) {
        if (bx >= G - 32) { EpiGate Ef{HB, H3B, PP, RSS2, RSS3}; sample_fixup<4>(PARTB, D, G - 1 - bx, Ef, nullptr); }
        p7_rows(p.out, H3B, RSS3, p.in[21], bx * NWAVES * 2, MP, G * NWAVES * 2);
        xcd_barrier(bar);
        p7_rows(p.out, H3B, RSS3, p.in[21], MP + bx * NWAVES * 2, MT, G * NWAVES * 2);
    } else if (bx >= G - 32) {
        const int f = bx - (G - 32);
        { EpiGate Ef{HB, H3B, PP, RSS2, RSS3}; sample_fixup<4>(PARTB, D, G - 1 - bx, Ef, nullptr); }
        unsigned* cnt6 = ctl + CW_SPLIT + 192;
        asm volatile("s_waitcnt vmcnt(0)" ::: "memory");
        __syncthreads();
        if (tid < 64) {
            __builtin_amdgcn_fence(__ATOMIC_RELEASE, "agent");
            asm volatile("s_waitcnt vmcnt(0)" ::: "memory");
            if (lane == 0) (void)__hip_atomic_fetch_add(cnt6, 1u, __ATOMIC_RELAXED, __HIP_MEMORY_SCOPE_AGENT);
            unsigned polls = 0;
            while ((unsigned)__builtin_amdgcn_readfirstlane((int)__hip_atomic_load(cnt6, __ATOMIC_RELAXED, __HIP_MEMORY_SCOPE_AGENT)) < 32u) { __builtin_amdgcn_s_sleep(2); if (++polls > (1u << 22)) break; }
            __builtin_amdgcn_fence(__ATOMIC_ACQUIRE, "agent");
            asm volatile("s_waitcnt vmcnt(0)" ::: "memory");
        }
        __syncthreads();
        p7_rows(p.out, H3B, RSS3, p.in[21], MP + f * 8, MP + f * 8 + 8, 16);
        p7_rows(p.out, H3B, RSS3, p.in[21], (1792 + f) * 16, 1952 * 16, 32 * 16);
    } else {
        p7_rows(p.out, H3B, RSS3, p.in[21], bx * 16, 1792 * 16, 224 * 16);
        if (bx < 96) p7_rows(p.out, H3B, RSS3, p.in[21], (1952 + bx) * 16, (1952 + bx) * 16 + 16, 16);
    }
}

extern "C" void kernel_launch(void* const* d_in, const int* in_sizes, int n_in, void* d_out, int out_size, void* d_ws, size_t ws_size, hipStream_t stream) {
    static int grid_blocks = 0;
    if (grid_blocks == 0) {
        if (n_in != 22 || ws_size < WS_END) { fprintf(stderr, "kernel_launch: unexpected n_in %d / ws_size %zu\n", n_in, ws_size); grid_blocks = -1; return; }
        int dev = 0, cus = 0, per_cu = 0;
        (void)hipGetDevice(&dev);
        (void)hipDeviceGetAttribute(&cus, hipDeviceAttributeMultiprocessorCount, dev);
        (void)hipFuncSetAttribute((const void*)fwd_megakernel, hipFuncAttributeMaxDynamicSharedMemorySize, LDS_BYTES);
        (void)hipOccupancyMaxActiveBlocksPerMultiprocessor(&per_cu, (const void*)fwd_megakernel, NTHREADS, LDS_BYTES);
        if (per_cu < 1) { fprintf(stderr, "kernel_launch: occupancy query reports %d blocks per CU\n", per_cu); per_cu = 1; }
        if (per_cu > 1) per_cu = 1;
        grid_blocks = cus * per_cu;
    }
    if (grid_blocks < 0) return;
    Params p{};
    for (int i = 0; i < 22; ++i) p.in[i] = (const float*)d_in[i];
    p.out = (float*)d_out; p.ws = (unsigned char*)d_ws;
    (void)hipMemsetAsync((char*)d_ws + WS_CTL, 0, CTL_ZERO_BYTES, stream);
    void* args[] = {&p};
    hipError_t e = hipLaunchCooperativeKernel((const void*)fwd_megakernel, dim3(grid_blocks), dim3(NTHREADS), args, LDS_BYTES, stream);
    if (e != hipSuccess) fprintf(stderr, "cooperative launch failed: %s (grid %d)\n", hipGetErrorString(e), grid_blocks);
}
```

```cpp
#include <hip/hip_runtime.h>
#include <hip/hip_cooperative_groups.h>
#include <cstdio>
#include <cstdint>
namespace cg = cooperative_groups;

namespace pg8 {
#define PG8_LAS __attribute__((address_space(3)))
typedef unsigned short bf16_t;
typedef short bf16x8 __attribute__((ext_vector_type(8)));
typedef float f32x4 __attribute__((ext_vector_type(4)));
typedef unsigned u32x4 __attribute__((ext_vector_type(4)));
constexpr int BM = 256, BK = 64, HALF = 128, HTB = HALF * BK * 2  , STAGE_BYTES = 8 * HTB, NXCD = 8, WGM = 8;

__host__ __device__ __forceinline__ int lds_byte(int r, int c) { const int st = (r >> 4) * 2 + (c >> 5), rr = r & 15, cc = c & 31, ob = rr * 64 + cc * 2; return st * 1024 + (ob ^ (((ob >> 9) & 1) << 5)); }
__host__ __device__ __forceinline__ void stage_rc(int b, int& R, int& C) { const int st = b / 1024, sb = b % 1024, swz = sb ^ (((sb >> 9) & 1) << 5); R = (st >> 1) * 16 + swz / 64; C = (st & 1) * 32 + (swz % 64) / 2; }
__host__ __device__ __forceinline__ int perm32(int rho) { const int n = rho >> 4, i = rho & 15; return 8 * (i >> 2) + 4 * n + (i & 3); }

struct Unit { int pm, pn, k0, nt, split; };
struct Gemm { const bf16_t* A; const bf16_t* Bt; int M, N, K; };

struct StaticOrder {
    int nM, nN, nwg, G, c, ntfull;
    __host__ __device__ void init(int M, int N, int K, int G_, int c_) { nM = M / BM; nN = N / BM; nwg = nM * nN; G = G_; c = c_; ntfull = K / BK; }
    __host__ __device__ bool next(int i, Unit& u) const {
        const long L = (long)i * G + c; if (L >= nwg) return false;
        int wgid = (int)L; { const int q = nwg / NXCD, r = nwg % NXCD, xcd = wgid % NXCD, off = wgid / NXCD; wgid = (xcd < r ? xcd * (q + 1) : r * (q + 1) + (xcd - r) * q) + off; }
        const int nig = WGM * nN, gid = wgid / nig, fm = gid * WGM, gsz = (nM - fm) < WGM ? (nM - fm) : WGM;
        u.pm = fm + ((wgid % nig) % gsz); u.pn = (wgid % nig) / gsz; u.k0 = 0; u.nt = ntfull; u.split = 0; return true;
    }
    __device__ __forceinline__ void a_ready(const Unit&) const {}
    __device__ __forceinline__ void done(const Unit&) const {}
};

struct SplitOrder {
    StaticOrder so; int nmain, nsplit, ntsub, nsub; unsigned* ready; unsigned need;
    __device__ void init(int Mmain, int N, int K, int klen, int G_, int c_, unsigned* ready_, unsigned need_) { so.init(Mmain, N, K, G_, c_); nmain = so.nwg; nsplit = K / klen; ntsub = klen / BK; nsub = (N / BM) * nsplit; ready = ready_; need = need_; }
    __device__ bool next(int i, Unit& u) const {
        if (so.next(i, u)) return true;
        const int nmine = (nmain - so.c + so.G - 1) / so.G;
        const int j = (i - nmine) * so.G + so.c;
        if (j < 0 || j >= nsub) return false;
        u.pm = so.nM; u.pn = j / nsplit; u.k0 = (j % nsplit) * ntsub * BK; u.nt = ntsub; u.split = 1; return true;
    }
    __device__ __forceinline__ void a_ready(const Unit& u) const {
        if (!u.split || need == 0u) return;
        if (threadIdx.x < 64) {
            unsigned polls = 0;
            while ((unsigned)__builtin_amdgcn_readfirstlane((int)__hip_atomic_load(ready, __ATOMIC_RELAXED, __HIP_MEMORY_SCOPE_AGENT)) < need) { __builtin_amdgcn_s_sleep(2); if (++polls > (1u << 22)) break; }
            __builtin_amdgcn_fence(__ATOMIC_ACQUIRE, "agent");
            asm volatile("s_waitcnt vmcnt(0)" ::: "memory");
        }
        asm volatile("" ::: "memory"); __builtin_amdgcn_s_barrier(); asm volatile("" ::: "memory");
    }
    __device__ __forceinline__ void done(const Unit&) const {}
};
struct SplitCtx { float* sum; int ldn; };
typedef float f32x2 __attribute__((ext_vector_type(2)));
typedef __bf16 bf16x2v __attribute__((ext_vector_type(2)));
__device__ __forceinline__ unsigned pk2(float lo, float hi) { f32x2 v = {lo, hi}; return __builtin_bit_cast(unsigned, __builtin_convertvector(v, bf16x2v)); }
__device__ __forceinline__ u32x4 pk8(const f32x4& a, const f32x4& b) { u32x4 w; w.x = pk2(a[0], a[1]); w.y = pk2(a[2], a[3]); w.z = pk2(b[0], b[1]); w.w = pk2(b[2], b[3]); return w; }
__device__ __forceinline__ float bflo(unsigned w) { return __builtin_bit_cast(float, w << 16); }
__device__ __forceinline__ float bfhi(unsigned w) { return __builtin_bit_cast(float, w & 0xffff0000u); }
__device__ __forceinline__ float sigmoidf_(float x) { return __builtin_amdgcn_rcpf(1.0f + __expf(-x)); }
template <class Epi, class Sched, bool ALIGN_EPI = false, bool SP2 = false>
__device__ __forceinline__ void gemm_phase(PG8_LAS unsigned char* lds, const Gemm g, const Sched& S, const Epi& E, const SplitCtx X = SplitCtx{nullptr, 0}) {
    int tid_ = threadIdx.x; asm volatile("" : "+v"(tid_));
    const int tid = tid_, wid = __builtin_amdgcn_readfirstlane(tid >> 6), lane = tid & 63, wr = wid >> 2, wc = wid & 3, fr = lane & 15, fq = lane >> 4;
    const int K = g.K;
    unsigned voffA[2], voffB[2];
#pragma unroll
    for (int i = 0; i < 2; ++i) { int R, C; stage_rc(tid * 16 + i * 8192, R, C); const int Rb = Epi::PERM ? ((R & ~31) + perm32(R & 31)) : R;
        voffA[i] = (unsigned)(R * K + C) * 2u; voffB[i] = (unsigned)(Rb * K + C) * 2u; }
    const size_t kstep = (size_t)(BK * 2);
    const size_t hstep = (size_t)HALF * K * 2;
    const size_t tstep = 2 * hstep;
    const unsigned ldsw = (unsigned)wid * 1024u;
    const int aoff = lds_byte(wr * 64 + fr, fq * 8), boff = lds_byte(wc * 32 + fr, fq * 8);
#define PG8_SA(b, h) (((b) * 2 + (h)) * HTB)
#define PG8_SB(b, h) ((4 + (b) * 2 + (h)) * HTB)
#define PG8_STAGE(bufoff, gbase, voff) do { _Pragma("unroll") for (int _i = 0; _i < 2; ++_i) \
        __builtin_amdgcn_global_load_lds((const unsigned*)((const char*)(gbase) + (voff)[_i]), (PG8_LAS unsigned*)(lds + (bufoff) + ldsw + _i * 8192), 16, 0, 0); } while (0)
#define PG8_LDA(dst, b, h) do { _Pragma("unroll") for (int m = 0; m < 4; ++m) _Pragma("unroll") for (int k = 0; k < 2; ++k) dst[m][k] = *(const PG8_LAS bf16x8*)(lds + PG8_SA(b, h) + aoff + m * 2048 + k * 1024); } while (0)
#define PG8_LDB(dst, b, h) do { _Pragma("unroll") for (int n = 0; n < 2; ++n) _Pragma("unroll") for (int k = 0; k < 2; ++k) dst[n][k] = *(const PG8_LAS bf16x8*)(lds + PG8_SB(b, h) + boff + n * 2048 + k * 1024); } while (0)
#define PG8_MMA(ai, bj, At, Bt) do { __builtin_amdgcn_s_setprio(1); _Pragma("unroll") for (int m = 0; m < 4; ++m) _Pragma("unroll") for (int n = 0; n < 2; ++n) _Pragma("unroll") for (int k = 0; k < 2; ++k) \
        acc[ai][bj][m][n] = __builtin_amdgcn_mfma_f32_16x16x32_bf16(Bt[n][k], At[m][k], acc[ai][bj][m][n], 0, 0, 0); __builtin_amdgcn_s_setprio(0); } while (0)
#define PG8_WAIT_V(n) asm volatile("s_waitcnt vmcnt(" #n ")" ::: "memory")
#define PG8_WAIT_L(n) asm volatile("s_waitcnt lgkmcnt(" #n ")" ::: "memory")
#define PG8_BAR __builtin_amdgcn_s_barrier()
#define PG8_SCHED __builtin_amdgcn_sched_barrier(0)
    Unit cur, nxt; int ui = 0;
    if (!S.next(0, cur)) return;
    f32x4 acc[2][2][4][2];
#pragma unroll
    for (int a = 0; a < 2; ++a)
#pragma unroll
        for (int b = 0; b < 2; ++b)
#pragma unroll
            for (int m = 0; m < 4; ++m)
#pragma unroll
                for (int n = 0; n < 2; ++n) acc[a][b][m][n] = (f32x4){0.f, 0.f, 0.f, 0.f};
    bf16x8 At[4][2], B0[2][2], B1[2][2];
    const char* cA = (const char*)g.A + (size_t)cur.pm * tstep + (size_t)cur.k0 * 2; const char* cB = (const char*)g.Bt + (size_t)cur.pn * tstep + (size_t)cur.k0 * 2;
    S.a_ready(cur);
    if constexpr (SP2) {
        PG8_STAGE(PG8_SB(0, 0), cB, voffB); PG8_STAGE(PG8_SB(0, 1), cB + hstep, voffB); PG8_STAGE(PG8_SA(0, 0), cA, voffA); PG8_STAGE(PG8_SA(0, 1), cA + hstep, voffA);
        if (wr == 1) PG8_BAR;
        PG8_WAIT_V(2); PG8_BAR;
        PG8_STAGE(PG8_SB(1, 0), cB + kstep, voffB); PG8_STAGE(PG8_SA(1, 0), cA + kstep, voffA); PG8_STAGE(PG8_SB(1, 1), cB + hstep + kstep, voffB);
        PG8_WAIT_V(6); PG8_BAR;
    } else {
        PG8_STAGE(PG8_SB(0, 0), cB, voffB); PG8_STAGE(PG8_SA(0, 0), cA, voffA); PG8_STAGE(PG8_SB(0, 1), cB + hstep, voffB); PG8_STAGE(PG8_SA(0, 1), cA + hstep, voffA);
        if (wr == 1) PG8_BAR;
        PG8_WAIT_V(4); PG8_BAR;
        PG8_STAGE(PG8_SB(1, 0), cB + kstep, voffB); PG8_STAGE(PG8_SA(1, 0), cA + kstep, voffA); PG8_STAGE(PG8_SB(1, 1), cB + hstep + kstep, voffB);
        PG8_WAIT_V(6); PG8_BAR;
    }
    for (;;) {
        const bool has_next = S.next(ui + 1, nxt);
        const char* nA = has_next ? (const char*)g.A + (size_t)nxt.pm * tstep + (size_t)nxt.k0 * 2 : cA; const char* nB = has_next ? (const char*)g.Bt + (size_t)nxt.pn * tstep + (size_t)nxt.k0 * 2 : cB;
        const int nt = cur.nt;
#pragma unroll 1
        for (int t = 0; t < nt; t += 2) {
            const bool last = (t == nt - 2);
            const char* a1 = cA + (size_t)(t + 1) * kstep;
            const char* a2 = last ? nA : cA + (size_t)(t + 2) * kstep; const char* b2 = last ? nB : cB + (size_t)(t + 2) * kstep;
            const char* a3 = a2 + kstep; const char* b3 = b2 + kstep;
            if (last && has_next) S.a_ready(nxt);
            if constexpr (SP2) {
            PG8_LDB(B0, 0, 0); PG8_LDB(B1, 0, 1); PG8_SCHED; PG8_LDA(At, 0, 0); PG8_STAGE(PG8_SA(1, 1), a1 + hstep, voffA);
            PG8_WAIT_V(8); PG8_WAIT_L(0); PG8_BAR; PG8_MMA(0, 0, At, B0); PG8_MMA(0, 1, At, B1); PG8_BAR; PG8_SCHED;
            PG8_LDA(At, 0, 1); PG8_STAGE(PG8_SB(0, 0), b2, voffB); PG8_STAGE(PG8_SB(0, 1), b2 + hstep, voffB); PG8_STAGE(PG8_SA(0, 0), a2, voffA);
            PG8_WAIT_V(8); PG8_WAIT_L(0); PG8_BAR; PG8_MMA(1, 0, At, B0); PG8_MMA(1, 1, At, B1); PG8_BAR; PG8_SCHED;
            PG8_LDB(B0, 1, 0); PG8_LDB(B1, 1, 1); PG8_SCHED; PG8_LDA(At, 1, 0); PG8_STAGE(PG8_SA(0, 1), a2 + hstep, voffA);
            PG8_WAIT_V(8); PG8_WAIT_L(0); PG8_BAR; PG8_MMA(0, 0, At, B0); PG8_MMA(0, 1, At, B1); PG8_BAR; PG8_SCHED;
            PG8_LDA(At, 1, 1); PG8_STAGE(PG8_SB(1, 0), b3, voffB); PG8_STAGE(PG8_SB(1, 1), b3 + hstep, voffB); PG8_STAGE(PG8_SA(1, 0), a3, voffA);
            PG8_WAIT_V(8); PG8_WAIT_L(0); PG8_BAR; PG8_MMA(1, 0, At, B0); PG8_MMA(1, 1, At, B1); PG8_BAR; PG8_SCHED;
            } else {
            PG8_LDB(B0, 0, 0); PG8_SCHED; PG8_LDA(At, 0, 0); PG8_STAGE(PG8_SA(1, 1), a1 + hstep, voffA);
            PG8_WAIT_L(8); PG8_BAR; PG8_WAIT_L(0); PG8_MMA(0, 0, At, B0); PG8_BAR; PG8_SCHED;
            PG8_LDB(B1, 0, 1); PG8_STAGE(PG8_SB(0, 0), b2, voffB);
            PG8_BAR; PG8_WAIT_L(0); PG8_MMA(0, 1, At, B1); PG8_BAR;
            PG8_LDA(At, 0, 1); PG8_STAGE(PG8_SA(0, 0), a2, voffA);
            PG8_BAR; PG8_WAIT_L(0); PG8_MMA(1, 0, At, B0); PG8_BAR; PG8_SCHED;
            PG8_STAGE(PG8_SB(0, 1), b2 + hstep, voffB);
            PG8_WAIT_V(6); PG8_BAR; PG8_MMA(1, 1, At, B1); PG8_BAR;
            PG8_LDB(B0, 1, 0); PG8_SCHED; PG8_LDA(At, 1, 0); PG8_STAGE(PG8_SA(0, 1), a2 + hstep, voffA);
            PG8_WAIT_L(8); PG8_BAR; PG8_WAIT_L(0); PG8_MMA(0, 0, At, B0); PG8_BAR; PG8_SCHED;
            PG8_LDB(B1, 1, 1); PG8_STAGE(PG8_SB(1, 0), b3, voffB);
            PG8_BAR; PG8_WAIT_L(0); PG8_MMA(0, 1, At, B1); PG8_BAR;
            PG8_LDA(At, 1, 1); PG8_STAGE(PG8_SA(1, 0), a3, voffA);
            PG8_BAR; PG8_WAIT_L(0); PG8_MMA(1, 0, At, B0); PG8_BAR; PG8_SCHED;
            PG8_STAGE(PG8_SB(1, 1), b3 + hstep, voffB);
            PG8_WAIT_V(6); PG8_BAR; PG8_MMA(1, 1, At, B1); PG8_BAR;
            }
        }
        if constexpr (ALIGN_EPI) { if (wr == 0) PG8_BAR; }
        bool do_epi = true;
        if (cur.split) {
            const size_t slice = (size_t)BM * X.ldn, rstep = (size_t)16 * X.ldn;
            float* rp = X.sum + (size_t)(cur.k0 / (cur.nt * BK)) * slice + (size_t)(wr * 64 + fr) * X.ldn + cur.pn * BM + wc * 32 + 8 * fq;
#pragma unroll
            for (int a = 0; a < 2; ++a) {
#pragma unroll
                for (int m = 0; m < 4; ++m) {
#pragma unroll
                    for (int b = 0; b < 2; ++b) { *(f32x4*)(rp + b * HALF) = acc[a][b][m][0]; *(f32x4*)(rp + b * HALF + 4) = acc[a][b][m][1]; }
                    rp += rstep;
                }
                rp += 4 * rstep;
            }
            do_epi = false;
        }
        if (do_epi) E(acc, cur, wr, wc, fr, fq);
        if (!has_next) break;
#pragma unroll
        for (int a = 0; a < 2; ++a)
#pragma unroll
            for (int b = 0; b < 2; ++b)
#pragma unroll
                for (int m = 0; m < 4; ++m)
#pragma unroll
                    for (int n = 0; n < 2; ++n) acc[a][b][m][n] = (f32x4){0.f, 0.f, 0.f, 0.f};
        cur = nxt; cA = nA; cB = nB; ++ui;
        if constexpr (ALIGN_EPI) { if (wr == 1) PG8_BAR; }
    }
    PG8_WAIT_V(0);
    if constexpr (!ALIGN_EPI) { if (wr == 0) PG8_BAR; }
    PG8_BAR;
    if constexpr (Epi::AFTER_DRAIN) { E.fused(acc, cur, wr, wc, fr, fq, lds, wid, lane); S.done(cur); }
#undef PG8_SA
#undef PG8_SB
#undef PG8_STAGE
#undef PG8_LDA
#undef PG8_LDB
#undef PG8_MMA
#undef PG8_WAIT_V
#undef PG8_WAIT_L
#undef PG8_BAR
#undef PG8_SCHED
}
}
constexpr int D = 1024, SEQ = 16384, MP = 2 * SEQ, MS = 256, MT = MP + MS, NIN = 1792, FF = 4096, DPLE = 256, CC = 512, QC = 512, KVC = 128;
constexpr float EPS = 1e-6f;
constexpr int NTHREADS = 512, NWAVES = 8;
constexpr int LDS_BYTES = 135168 + 256;
constexpr int MISC_OFF = 135168;
constexpr size_t WS_CTL = 0, CTL_ZERO_BYTES = 32768; constexpr int CW_SPLIT = 4096;
constexpr size_t OFF_Y = 0, OFF_NKP = (size_t)MT * D, OFF_NVP = OFF_NKP + 32768, OFF_NCP = OFF_NVP + 32768, OFF_NKS = OFF_NCP + 30720, OFF_NVS = OFF_NKS + 32768, OFF_NCS = OFF_NVS + 32768;
constexpr size_t MiB = 1u << 20;
constexpr size_t WS_WIN = 1 * MiB, WS_WOUT = 5 * MiB, WS_W1 = 7 * MiB, WS_W2 = 15 * MiB, WS_WG = 23 * MiB, WS_WP = 25 * MiB, WS_ROPE = 26 * MiB;
constexpr size_t WS_RSS1 = 30 * MiB, WS_RSS2 = 33 * MiB, WS_RSS3 = 36 * MiB;
constexpr size_t WS_HB = 40 * MiB, WS_PB = 105 * MiB, WS_PP = 122 * MiB, WS_HID = 188 * MiB;
constexpr size_t WS_A1 = 188 * MiB, WS_MIX = 253 * MiB, WS_U = 318 * MiB, WS_Q = 351 * MiB, WS_KB = 384 * MiB, WS_VB = 393 * MiB;
constexpr size_t WS_PART = 446 * MiB, WS_PARTB = 462 * MiB;
constexpr size_t WS_END = 478 * MiB;
static_assert(WS_HID + (size_t)MT * FF * 2 <= WS_PART && WS_VB + (size_t)MT * KVC * 2 <= WS_END && WS_PP + (size_t)MT * D * 2 <= WS_HID && WS_HB + (size_t)MT * D * 2 <= WS_PB && WS_PB + (size_t)MT * DPLE * 2 <= WS_PP, "ws map");

#define LAS __attribute__((address_space(3)))
typedef unsigned short bf16;
using pg8::f32x4; using pg8::u32x4; using pg8::bf16x8; using pg8::Unit;
typedef float f32x16 __attribute__((ext_vector_type(16)));
typedef unsigned u32x2 __attribute__((ext_vector_type(2)));
using pg8::pk2; using pg8::pk8; using pg8::bflo; using pg8::bfhi; using pg8::sigmoidf_;

struct Params { const float* in[22]; float* out; unsigned char* ws; };

__host__ __device__ __forceinline__ int win_dest(int c) {
    if (c < 512) return 256 * (c >> 7) + (c & 127);
    if (c < 1024) { c -= 512; return 256 * (c >> 7) + 128 + (c & 127); }
    if (c < 1536) { c -= 1024; const int hq = c >> 6, r = c & 63; return 256 * (4 + (hq >> 2)) + (r >> 5) * 128 + (hq & 3) * 32 + (r & 31); }
    if (c < 1664) { c -= 1536; const int hd = c >> 6, r = c & 63; return 1536 + (r >> 5) * 128 + hd * 32 + (r & 31); }
    c -= 1664; return 1536 + (c >> 6) * 128 + 64 + (c & 63);
}
__device__ __forceinline__ float wave_sum(float v) {
#pragma unroll
    for (int o = 1; o < 64; o <<= 1) v += __shfl_xor(v, o);
    return v;
}
#define LDS_WAIT() asm volatile("s_waitcnt lgkmcnt(0)" ::: "memory")

struct EpiIn {
    static constexpr bool PERM = true, AFTER_DRAIN = false;
    bf16 *U, *Q, *KB, *VB; const float* rope; float* out;
    __device__ __forceinline__ void operator()(const f32x4 (&acc)[2][2][4][2], const Unit& u, int wr, int wc, int fr, int fq) const {
        const int rowb = u.pm * 256 + wr * 64 + fr;
        if (u.pn < 4) {
            const int ch = 128 * u.pn + 32 * wc + 8 * fq;
#pragma unroll
            for (int ai = 0; ai < 2; ++ai)
#pragma unroll
                for (int m = 0; m < 4; ++m) {
                    const int row = rowb + ai * 128 + m * 16;
                    const bool isp = row < MP; const int srow = row - MP;
                    const int t = isp ? (row & (SEQ - 1)) : (srow & 31), bb = isp ? (row >> 14) : (srow >> 5);
                    f32x4 o0, o1;
#pragma unroll
                    for (int i = 0; i < 4; ++i) { o0[i] = acc[ai][0][m][0][i] * sigmoidf_(acc[ai][1][m][0][i]); o1[i] = acc[ai][0][m][1][i] * sigmoidf_(acc[ai][1][m][1][i]); }
                    *(u32x4*)(U + (size_t)row * CC + ch) = pk8(o0, o1);
                    float* dst = nullptr;
                    if (isp) { if (t >= SEQ - 30) dst = out + OFF_NCP + ((size_t)(bb * 30 + (t - (SEQ - 30)))) * CC + ch; }
                    else { if (t >= 2) dst = out + OFF_NCS + ((size_t)(bb * 30 + (t - 2))) * CC + ch; }
                    if (dst) { *(f32x4*)dst = o0; *(f32x4*)(dst + 4) = o1; }
                }
        } else if (u.pn < 6 || wc < 2) {
            const bool isq = u.pn < 6;
#pragma unroll
            for (int ai = 0; ai < 2; ++ai)
#pragma unroll
            for (int mh = 0; mh < 4; mh += 2) {
                f32x4 rp4[4][4];
#pragma unroll
                for (int m = mh; m < mh + 2; ++m) {
                    const int row = rowb + ai * 128 + m * 16;
                    const int pos = (row < MP) ? (row & (SEQ - 1)) : 2048 + ((row - MP) & 31);
                    const f32x4* rp = (const f32x4*)(rope + ((size_t)pos * 32 + 8 * fq) * 2);
                    rp4[m][0] = rp[0]; rp4[m][1] = rp[1]; rp4[m][2] = rp[2]; rp4[m][3] = rp[3];
                }
                asm volatile("" ::: "memory");
#pragma unroll
                for (int m = mh; m < mh + 2; ++m) {
                    const int row = rowb + ai * 128 + m * 16;
                    const bool isp = row < MP; const int srow = row - MP;
                    const int t = isp ? (row & (SEQ - 1)) : (srow & 31), bb = isp ? (row >> 14) : (srow >> 5);
                    bf16* op = isq ? Q + (size_t)row * QC + (4 * (u.pn - 4) + wc) * 64 + 8 * fq : KB + (size_t)row * KVC + wc * 64 + 8 * fq;
                    float* dst = nullptr;
                    if (!isq) {
                        if (isp) { if (t >= SEQ - 128) dst = out + OFF_NKP + ((size_t)((bb * 128 + (t - (SEQ - 128))) * 2 + wc)) * 64 + 8 * fq; }
                        else dst = out + OFF_NKS + ((size_t)(srow * 2 + wc)) * 64 + 8 * fq;
                    }
                    f32x4 a[2], b[2];
#pragma unroll
                    for (int n = 0; n < 2; ++n) {
                        const f32x4 r0 = rp4[m][2 * n], r1 = rp4[m][2 * n + 1];
                        const float cs[4] = {r0[0], r0[2], r1[0], r1[2]}, sn[4] = {r0[1], r0[3], r1[1], r1[3]};
#pragma unroll
                        for (int i = 0; i < 4; ++i) { const float x1 = acc[ai][0][m][n][i], x2 = acc[ai][1][m][n][i]; a[n][i] = x1 * cs[i] - x2 * sn[i]; b[n][i] = x2 * cs[i] + x1 * sn[i]; }
                    }
                    *(u32x4*)op = pk8(a[0], a[1]); *(u32x4*)(op + 32) = pk8(b[0], b[1]);
                    if (dst) { *(f32x4*)dst = a[0]; *(f32x4*)(dst + 4) = a[1]; *(f32x4*)(dst + 32) = b[0]; *(f32x4*)(dst + 36) = b[1]; }
                }
                asm volatile("" ::: "memory");
            }
        } else {
            const int dd = 32 * (wc - 2) + 8 * fq;
#pragma unroll
            for (int ai = 0; ai < 2; ++ai)
#pragma unroll
                for (int m = 0; m < 4; ++m) {
                    const int row = rowb + ai * 128 + m * 16;
                    const bool isp = row < MP; const int srow = row - MP;
                    const int t = isp ? (row & (SEQ - 1)) : (srow & 31), bb = isp ? (row >> 14) : (srow >> 5);
#pragma unroll
                    for (int bj = 0; bj < 2; ++bj) {
                        *(u32x4*)(VB + (size_t)row * KVC + 64 * bj + dd) = pk8(acc[ai][bj][m][0], acc[ai][bj][m][1]);
                        float* dst = nullptr;
                        if (isp) { if (t >= SEQ - 128) dst = out + OFF_NVP + ((size_t)((bb * 128 + (t - (SEQ - 128))) * 2 + bj)) * 64 + dd; }
                        else dst = out + OFF_NVS + ((size_t)(srow * 2 + bj)) * 64 + dd;
                        if (dst) { *(f32x4*)dst = acc[ai][bj][m][0]; *(f32x4*)(dst + 4) = acc[ai][bj][m][1]; }
                    }
                }
        }
    }
};
struct EpiPlain {
    static constexpr bool PERM = true, AFTER_DRAIN = false;
    bf16* O; int ldc;
    __device__ __forceinline__ void operator()(const f32x4 (&acc)[2][2][4][2], const Unit& u, int wr, int wc, int fr, int fq) const {
        const int rowb = u.pm * 256 + wr * 64 + fr, colb = u.pn * 256 + wc * 32 + 8 * fq;
#pragma unroll
        for (int ai = 0; ai < 2; ++ai)
#pragma unroll
            for (int m = 0; m < 4; ++m)
#pragma unroll
                for (int bj = 0; bj < 2; ++bj)
                    *(u32x4*)(O + (size_t)(rowb + ai * 128 + m * 16) * ldc + colb + bj * 128) = pk8(acc[ai][bj][m][0], acc[ai][bj][m][1]);
    }
};
__device__ __forceinline__ void wave_row_rs(const float* RSS, int base, int lane, int fr, float (&rs)[2][4]) {
    float r2[2];
#pragma unroll
    for (int a = 0; a < 2; ++a) {
        const f32x4* q = (const f32x4*)(RSS + (size_t)(base + 128 * a + lane) * 16);
        const f32x4 x0 = q[0], x1 = q[1], x2 = q[2], x3 = q[3];
        const float sm = (((x0[0] + x0[1]) + (x0[2] + x0[3])) + ((x1[0] + x1[1]) + (x1[2] + x1[3]))) + (((x2[0] + x2[1]) + (x2[2] + x2[3])) + ((x3[0] + x3[1]) + (x3[2] + x3[3])));
        r2[a] = __builtin_amdgcn_rsqf(sm * (1.0f / D) + EPS);
    }
#pragma unroll
    for (int a = 0; a < 2; ++a)
#pragma unroll
        for (int m = 0; m < 4; ++m) rs[a][m] = __shfl(r2[a], 16 * m + fr);
}
__device__ __forceinline__ float row_rs(const float* RSS, int row) {
    const f32x4* p = (const f32x4*)(RSS + (size_t)row * 16);
    const f32x4 a = p[0], b = p[1], c = p[2], d = p[3];
    const float s = ((a[0] + a[1]) + (a[2] + a[3])) + ((b[0] + b[1]) + (b[2] + b[3])) + ((c[0] + c[1]) + (c[2] + c[3])) + ((d[0] + d[1]) + (d[2] + d[3]));
    return __builtin_amdgcn_rsqf(s * (1.0f / D) + EPS);
}
template <bool FIRST>
struct EpiRes {
    static constexpr bool PERM = true, AFTER_DRAIN = false;
    const float* bp; const float* bs; bf16* HB; float* RSS; const float* RSSs = nullptr;
    bool seam = false; int ai0 = 0, ai1 = 2, m0 = 0, m1 = 4;
    __device__ __forceinline__ void operator()(const f32x4 (&acc)[2][2][4][2], const Unit& u, int wr, int wc, int fr, int fq) const {
        const int rowb = u.pm * 256 + wr * 64 + fr, colb = u.pn * 256 + wc * 32 + 8 * fq;
        float rs[2][4];
        if (!FIRST) wave_row_rs(RSSs, u.pm * 256 + wr * 64, fr + 16 * fq, fr, rs);
#pragma unroll
        for (int ai = 0; ai < 2; ++ai) if (ai >= ai0 && ai < ai1) {
            f32x4 bf[4][2][2]; u32x4 bw[4][2];
#pragma unroll
            for (int m = 0; m < 4; ++m) if (m >= m0 && m < m1) {
                const int row = rowb + ai * 128 + m * 16;
                if (FIRST) { const float* brow = (row < MP) ? bp + (size_t)row * D : bs + (size_t)(row - MP) * D;
#pragma unroll
                    for (int bj = 0; bj < 2; ++bj) { bf[m][bj][0] = *(const f32x4*)(brow + colb + bj * 128); bf[m][bj][1] = *(const f32x4*)(brow + colb + bj * 128 + 4); } }
                else {
#pragma unroll
                    for (int bj = 0; bj < 2; ++bj) bw[m][bj] = *(const u32x4*)(HB + (size_t)row * D + colb + bj * 128); }
            }
            asm volatile("" ::: "memory");
#pragma unroll
            for (int m = 0; m < 4; ++m) if (m >= m0 && m < m1) {
                const int row = rowb + ai * 128 + m * 16;
                float sc = 1.f; if (!FIRST) sc = rs[ai][m] * rs[ai][m];
                float ss = 0.f;
#pragma unroll
                for (int bj = 0; bj < 2; ++bj) {
                    const int col = colb + bj * 128;
                    f32x4 b0, b1;
                    if (FIRST) { b0 = bf[m][bj][0]; b1 = bf[m][bj][1]; }
                    else { const u32x4 w = bw[m][bj]; b0 = (f32x4){bflo(w.x), bfhi(w.x), bflo(w.y), bfhi(w.y)}; b1 = (f32x4){bflo(w.z), bfhi(w.z), bflo(w.w), bfhi(w.w)}; }
                    const f32x4 v0 = acc[ai][bj][m][0] * sc + b0, v1 = acc[ai][bj][m][1] * sc + b1;
                    *(u32x4*)(HB + (size_t)row * D + col) = pk8(v0, v1);
                    ss += (v0[0] * v0[0] + v0[1] * v0[1]) + (v0[2] * v0[2] + v0[3] * v0[3]) + (v1[0] * v1[0] + v1[1] * v1[1]) + (v1[2] * v1[2] + v1[3] * v1[3]);
                }
                ss += __shfl_xor(ss, 16); ss += __shfl_xor(ss, 32);
                if (fq == 0) RSS[(size_t)row * 16 + u.pn * 4 + wc] = ss;
            }
            asm volatile("" ::: "memory");
        }
    }
};
struct EpiFF1 {
    static constexpr bool PERM = true, AFTER_DRAIN = false;
    bf16* O; const float* RSS; bool seam = false; int ai0 = 0, ai1 = 2, m0 = 0, m1 = 4;
    __device__ __forceinline__ void operator()(const f32x4 (&acc)[2][2][4][2], const Unit& u, int wr, int wc, int fr, int fq) const {
        const int rowb = u.pm * 256 + wr * 64 + fr, colb = u.pn * 256 + wc * 32 + 8 * fq;
#pragma unroll
        for (int ai = 0; ai < 2; ++ai) if (ai >= ai0 && ai < ai1)
#pragma unroll
            for (int m = 0; m < 4; ++m) if (m >= m0 && m < m1) {
                const int row = rowb + ai * 128 + m * 16;
#pragma unroll
                for (int bj = 0; bj < 2; ++bj) {
                    f32x4 v0 = acc[ai][bj][m][0], v1 = acc[ai][bj][m][1];
#pragma unroll
                    for (int i = 0; i < 4; ++i) { const float a = fmaxf(v0[i], 0.f), b = fmaxf(v1[i], 0.f); v0[i] = a * a; v1[i] = b * b; }
                    *(u32x4*)(O + (size_t)row * FF + colb + bj * 128) = pk8(v0, v1);
                }
                if (seam) asm volatile("" ::: "memory");
            }
    }
};
struct EpiGate {
    static constexpr bool PERM = true, AFTER_DRAIN = false;
    const bf16* HB; bf16* H3B; const bf16* PP; const float* RSSin; float* RSSout; bool seam = false; int ai0 = 0, ai1 = 2, m0 = 0, m1 = 4;
    __device__ __forceinline__ void operator()(const f32x4 (&acc)[2][2][4][2], const Unit& u, int wr, int wc, int fr, int fq) const {
        const int rowb = u.pm * 256 + wr * 64 + fr, colb = u.pn * 256 + wc * 32 + 8 * fq;
        float rs[2][4];
        wave_row_rs(RSSin, u.pm * 256 + wr * 64, fr + 16 * fq, fr, rs);
#pragma unroll
        for (int ai = 0; ai < 2; ++ai) if (ai >= ai0 && ai < ai1) {
            u32x4 pwv[4][2], hwv[4][2];
#pragma unroll
            for (int m = 0; m < 4; ++m) if (m >= m0 && m < m1) {
                const int row = rowb + ai * 128 + m * 16;
#pragma unroll
                for (int bj = 0; bj < 2; ++bj) { pwv[m][bj] = *(const u32x4*)(PP + (size_t)row * D + colb + bj * 128); hwv[m][bj] = *(const u32x4*)(HB + (size_t)row * D + colb + bj * 128); }
            }
            asm volatile("" ::: "memory");
#pragma unroll
            for (int m = 0; m < 4; ++m) if (m >= m0 && m < m1) {
                const int row = rowb + ai * 128 + m * 16; const float r1 = rs[ai][m];
                float ss = 0.f;
#pragma unroll
                for (int bj = 0; bj < 2; ++bj) {
                    const int col = colb + bj * 128;
                    const u32x4 pw = pwv[m][bj], hw = hwv[m][bj];
                    const f32x4 p0 = {bflo(pw.x), bfhi(pw.x), bflo(pw.y), bfhi(pw.y)}, p1 = {bflo(pw.z), bfhi(pw.z), bflo(pw.w), bfhi(pw.w)};
                    f32x4 v0 = {bflo(hw.x), bfhi(hw.x), bflo(hw.y), bfhi(hw.y)}, v1 = {bflo(hw.z), bfhi(hw.z), bflo(hw.w), bfhi(hw.w)};
#pragma unroll
                    for (int i = 0; i < 4; ++i) { v0[i] += sigmoidf_(acc[ai][bj][m][0][i] * r1) * p0[i]; v1[i] += sigmoidf_(acc[ai][bj][m][1][i] * r1) * p1[i]; }
                    *(u32x4*)(H3B + (size_t)row * D + col) = pk8(v0, v1);
                    ss += (v0[0] * v0[0] + v0[1] * v0[1]) + (v0[2] * v0[2] + v0[3] * v0[3]) + (v1[0] * v1[0] + v1[1] * v1[1]) + (v1[2] * v1[2] + v1[3] * v1[3]);
                }
                ss += __shfl_xor(ss, 16); ss += __shfl_xor(ss, 32);
                if (fq == 0) RSSout[(size_t)row * 16 + u.pn * 4 + wc] = ss;
            }
            asm volatile("" ::: "memory");
        }
    }
};
template <bool MAP>
__device__ __forceinline__ void p0_transpose_item(const float* W, int K, int N, const float* gk, bf16* WT, LAS float* scr, int item, int lane) {
    const int nblk = N / 32, kb = item / nblk, nb = item % nblk, k0 = 64 * kb, n0 = 32 * nb;
#pragma unroll
    for (int i = 0; i < 32; ++i) { const int kk = 2 * i + (lane >> 5); float v = W[(size_t)(k0 + kk) * N + n0 + (lane & 31)]; if (gk) v *= gk[k0 + kk]; scr[kk * 33 + (lane & 31)] = v; }
    LDS_WAIT(); asm volatile("" ::: "memory");
    const int c = lane & 7, nd0 = MAP ? win_dest(n0) : n0;
#pragma unroll
    for (int j = 0; j < 4; ++j) { const int n = (lane >> 3) + 8 * j; const LAS float* s = scr + (8 * c) * 33 + n;
        u32x4 o; o.x = pk2(s[0 * 33], s[1 * 33]); o.y = pk2(s[2 * 33], s[3 * 33]); o.z = pk2(s[4 * 33], s[5 * 33]); o.w = pk2(s[6 * 33], s[7 * 33]);
        *(u32x4*)(WT + (size_t)(nd0 + n) * K + k0 + 8 * c) = o; }
    LDS_WAIT(); asm volatile("" ::: "memory");
}
__device__ __forceinline__ void p0_prologue(const Params& p, LAS unsigned char* lds, int G, int tid, int wid, int lane) {
    unsigned char* ws = p.ws;
    LAS float* scr = (LAS float*)(lds + wid * 16384);
    const int gw = blockIdx.x * NWAVES + wid, NGW = G * NWAVES;
    constexpr int I_IN = (D / 64) * (NIN / 32), I_O = (D / 64) * (D / 32), I_P = (DPLE / 64) * (D / 32);
    constexpr int NITEMS = I_IN + I_P;
    for (int it = gw; it < NITEMS; it += NGW) {
        int r = it;
        if (r < I_IN) { p0_transpose_item<true>(p.in[8], D, NIN, nullptr, (bf16*)(ws + WS_WIN), scr, r, lane); continue; } r -= I_IN;
        p0_transpose_item<false>(p.in[20], DPLE, D, nullptr, (bf16*)(ws + WS_WP), scr, r, lane);
    }
    const f32x4* g4 = (const f32x4*)p.in[7] + lane;
    bf16* A1 = (bf16*)(ws + WS_A1); bf16* PB = (bf16*)(ws + WS_PB);
    for (int row = gw * 2; row < MT; row += NGW * 2) {
        f32x4 v[2][4]; f32x4 pv[2]; float s[2];
#pragma unroll
        for (int k = 0; k < 2; ++k) {
            const int rr = row + k;
            const float* xr = (rr < MP) ? p.in[0] + (size_t)rr * D : p.in[1] + (size_t)(rr - MP) * D;
            const f32x4* x4 = (const f32x4*)xr + lane;
#pragma unroll
            for (int j = 0; j < 4; ++j) v[k][j] = x4[64 * j];
            const float* pr = (rr < MP) ? p.in[2] + (size_t)rr * DPLE : p.in[3] + (size_t)(rr - MP) * DPLE;
            pv[k] = ((const f32x4*)pr)[lane];
        }
#pragma unroll
        for (int k = 0; k < 2; ++k) {
            s[k] = 0.f;
#pragma unroll
            for (int j = 0; j < 4; ++j) s[k] += (v[k][j][0] * v[k][j][0] + v[k][j][1] * v[k][j][1]) + (v[k][j][2] * v[k][j][2] + v[k][j][3] * v[k][j][3]);
            const float rs = __builtin_amdgcn_rsqf(wave_sum(s[k]) * (1.0f / D) + EPS);
            u32x2* o = (u32x2*)(A1 + (size_t)(row + k) * D) + lane;
#pragma unroll
            for (int j = 0; j < 4; ++j) { const f32x4 g = g4[64 * j]; u32x2 w; w.x = pk2(v[k][j][0] * rs * g[0], v[k][j][1] * rs * g[1]); w.y = pk2(v[k][j][2] * rs * g[2], v[k][j][3] * rs * g[3]); o[64 * j] = w; }
            u32x2 w; w.x = pk2(pv[k][0], pv[k][1]); w.y = pk2(pv[k][2], pv[k][3]); ((u32x2*)(PB + (size_t)(row + k) * DPLE))[lane] = w;
        }
    }
    float* rope = (float*)(ws + WS_ROPE);
    for (int idx = blockIdx.x * NTHREADS + tid; idx < SEQ * 32; idx += G * NTHREADS) {
        const int pos = idx >> 5, d = idx & 31;
        const float inv = (float)(1.0 / exp2((double)d * (13.287712379549449 / 32.0)));
        const float ang = (float)pos * inv;
        const double a = (double)ang, k = rint(a * 0.15915494309189535);
        const double r = fma(-k, 1.2246467991473532e-16 * 2.0, fma(-k, 6.283185307179586, a));
        const float rf = (float)r;
        ((pg8::f32x2*)rope)[idx] = (pg8::f32x2){cosf(rf), sinf(rf)};
    }
}

__device__ __forceinline__ void shadow_transpose(const float* W, int K, int N, const float* gk, bf16* WT, LAS unsigned char* lds, int cu, int ncu) {
    int t = threadIdx.x; asm volatile("" : "+v"(t));
    const int lane = t & 63, wid = __builtin_amdgcn_readfirstlane(t >> 6);
    LAS float* scr = (LAS float*)(lds + wid * 16384);
    const int nitems = (K / 64) * (N / 32);
    for (int it = cu * NWAVES + wid; it < nitems; it += ncu * NWAVES) p0_transpose_item<false>(W, K, N, gk, WT, scr, it, lane);
}

constexpr int N_ATT_P = 2 * 256 * 2, N_ATT = N_ATT_P + 16, N_CONV_P = MP / 64, N_CONV = N_CONV_P + 4;
constexpr int DCP = 516;
static_assert(64 * DCP * 4 <= MISC_OFF, "conv tile fits under the barrier words");
__device__ __forceinline__ void conv_item(const Params& p, LAS unsigned char* lds, int item, int tid, int wid, int lane) {
    typedef pg8::f32x2 f2;
    const bf16* U = (const bf16*)(p.ws + WS_U); bf16* MIX = (bf16*)(p.ws + WS_MIX);
    LAS float* DC = (LAS float*)lds;
    const int half = wid >> 2, c2 = 2 * (tid & 255);
    const bool sample = item >= N_CONV_P;
    const int row0 = item * 64, rowh = row0 + 32 * half;
    f2 win[62];
    if (!sample) {
        const int t0 = rowh & (SEQ - 1);
#pragma unroll
        for (int k = 0; k < 62; ++k) {
            const int tk = t0 - 30 + k;
            unsigned w = *(const unsigned*)(U + (size_t)(rowh - 30 + k - (tk < 0 ? tk : 0)) * CC + c2);
            if (tk < 0) w = 0u;
            win[k] = (f2){bflo(w), bfhi(w)};
        }
    } else {
        const float* sc = p.in[6] + (size_t)((item - N_CONV_P) * 2 + half) * 30 * CC + c2;
#pragma unroll
        for (int k = 0; k < 30; ++k) win[k] = *(const f2*)(sc + (size_t)k * CC);
#pragma unroll
        for (int k = 30; k < 62; ++k) { const unsigned w = *(const unsigned*)(U + (size_t)(rowh - 30 + k) * CC + c2); win[k] = (f2){bflo(w), bfhi(w)}; }
    }
    f2 w[31];
#pragma unroll
    for (int j = 0; j < 31; ++j) w[j] = *(const f2*)(p.in[9] + j * CC + c2);
    const f2 bias = *(const f2*)(p.in[10] + c2);
#pragma unroll
    for (int r = 0; r < 32; ++r) {
        f2 a = bias;
#pragma unroll
        for (int j = 0; j < 31; ++j) a = w[j] * win[r + j] + a;
        *(LAS f2*)(DC + (32 * half + r) * DCP + c2) = a;
    }
    __syncthreads();
    const int c8 = lane * 8;
    const f32x4 g0 = *(const f32x4*)(p.in[11] + c8), g1 = *(const f32x4*)(p.in[11] + c8 + 4), b0 = *(const f32x4*)(p.in[12] + c8), b1 = *(const f32x4*)(p.in[12] + c8 + 4);
#pragma unroll
    for (int rr = 0; rr < 8; ++rr) {
        const int r = 8 * wid + rr;
        f32x4 x0 = *(const LAS f32x4*)(DC + r * DCP + c8), x1 = *(const LAS f32x4*)(DC + r * DCP + c8 + 4);
        const float mean = wave_sum((x0[0] + x0[1]) + (x0[2] + x0[3]) + (x1[0] + x1[1]) + (x1[2] + x1[3])) * (1.0f / CC);
        x0 = x0 - mean; x1 = x1 - mean;
        const float var = wave_sum((x0[0] * x0[0] + x0[1] * x0[1]) + (x0[2] * x0[2] + x0[3] * x0[3]) + (x1[0] * x1[0] + x1[1] * x1[1]) + (x1[2] * x1[2] + x1[3] * x1[3])) * (1.0f / CC);
        const float rstd = __builtin_amdgcn_rsqf(var + EPS);
        f32x4 y0 = x0 * rstd * g0 + b0, y1 = x1 * rstd * g1 + b1;
#pragma unroll
        for (int i = 0; i < 4; ++i) { y0[i] *= sigmoidf_(y0[i]); y1[i] *= sigmoidf_(y1[i]); }
        *(u32x4*)(MIX + (size_t)(row0 + r) * D + c8) = pk8(y0, y1);
    }
    __syncthreads();
}

constexpr int KSP = 144, VTP = 408, VT_OFF = 192 * KSP;
#define MFMA32(a, b, c) __builtin_amdgcn_mfma_f32_32x32x16_bf16((a), (b), (c), 0, 0, 0)
__device__ __forceinline__ void attn_item(const Params& p, LAS unsigned char* lds, int item, int tid, int wid, int lane) {
    const bf16* Q = (const bf16*)(p.ws + WS_Q); const bf16* KB = (const bf16*)(p.ws + WS_KB); const bf16* VB = (const bf16*)(p.ws + WS_VB); bf16* MIX = (bf16*)(p.ws + WS_MIX);
    const bool sample = item >= N_ATT_P;
    int b, n, kvh, kt0, kt1;
    if (!sample) { b = item >> 9; n = (item >> 1) & 255; kvh = item & 1; kt0 = (n >= 2) ? 0 : (n == 1 ? 2 : 4); kt1 = 6; }
    else { const int s = item - N_ATT_P; b = s >> 1; n = 0; kvh = s & 1; kt0 = 0; kt1 = 5; }
    const int keyrow0 = b * SEQ + (n - 2) * 64;
    if (!sample) {
        u32x4 kv[3], vv[3];
#pragma unroll
        for (int i = 0; i < 3; ++i) {
            const int id = tid + NTHREADS * i, j = id >> 3, c = id & 7, jc = j < 32 * kt0 ? 32 * kt0 : j;
            const size_t grow = (size_t)(keyrow0 + jc);
            kv[i] = *(const u32x4*)(KB + grow * KVC + kvh * 64 + c * 8); vv[i] = *(const u32x4*)(VB + grow * KVC + kvh * 64 + c * 8);
        }
#pragma unroll
        for (int i = 0; i < 3; ++i) {
            const int id = tid + NTHREADS * i, j = id >> 3, c = id & 7;
            if (j >= 32 * kt0) {
                *(LAS u32x4*)(lds + j * KSP + c * 16) = kv[i];
                LAS unsigned short* vt = (LAS unsigned short*)(lds + VT_OFF + (8 * c) * VTP) + j;
                vt[0 * (VTP / 2)] = (unsigned short)(vv[i].x & 0xffffu); vt[1 * (VTP / 2)] = (unsigned short)(vv[i].x >> 16);
                vt[2 * (VTP / 2)] = (unsigned short)(vv[i].y & 0xffffu); vt[3 * (VTP / 2)] = (unsigned short)(vv[i].y >> 16);
                vt[4 * (VTP / 2)] = (unsigned short)(vv[i].z & 0xffffu); vt[5 * (VTP / 2)] = (unsigned short)(vv[i].z >> 16);
                vt[6 * (VTP / 2)] = (unsigned short)(vv[i].w & 0xffffu); vt[7 * (VTP / 2)] = (unsigned short)(vv[i].w >> 16);
            }
        }
    } else {
#pragma unroll
    for (int i = 0; i < 3; ++i) {
        const int id = tid + NTHREADS * i, j = id >> 3, c = id & 7;
        if (j >= 32 * kt0 && j < 32 * kt1) {
            u32x4 kv, vv;
            if (!sample || j >= 128) {
                const size_t grow = sample ? (size_t)(MP + b * 32 + (j - 128)) : (size_t)(keyrow0 + j);
                kv = *(const u32x4*)(KB + grow * KVC + kvh * 64 + c * 8); vv = *(const u32x4*)(VB + grow * KVC + kvh * 64 + c * 8);
            } else {
                const size_t off = ((size_t)(b * 128 + j) * 2 + kvh) * 64 + c * 8;
                const f32x4 k0 = *(const f32x4*)(p.in[4] + off), k1 = *(const f32x4*)(p.in[4] + off + 4), v0 = *(const f32x4*)(p.in[5] + off), v1 = *(const f32x4*)(p.in[5] + off + 4);
                kv = pk8(k0, k1); vv = pk8(v0, v1);
            }
            *(LAS u32x4*)(lds + j * KSP + c * 16) = kv;
            LAS unsigned short* vt = (LAS unsigned short*)(lds + VT_OFF + (8 * c) * VTP) + j;
            vt[0 * (VTP / 2)] = (unsigned short)(vv.x & 0xffffu); vt[1 * (VTP / 2)] = (unsigned short)(vv.x >> 16);
            vt[2 * (VTP / 2)] = (unsigned short)(vv.y & 0xffffu); vt[3 * (VTP / 2)] = (unsigned short)(vv.y >> 16);
            vt[4 * (VTP / 2)] = (unsigned short)(vv.z & 0xffffu); vt[5 * (VTP / 2)] = (unsigned short)(vv.z >> 16);
            vt[6 * (VTP / 2)] = (unsigned short)(vv.w & 0xffffu); vt[7 * (VTP / 2)] = (unsigned short)(vv.w >> 16);
        }
    }
    }
    __syncthreads();
    const int g = wid >> 1, qh = wid & 1, head = kvh * 4 + g, q = lane & 31, h = lane >> 5;
    if (!sample || qh == 0) {
        const size_t qrow = sample ? (size_t)(MP + b * 32 + q) : (size_t)(b * SEQ + n * 64 + qh * 32 + q);
        bf16x8 bq[4];
#pragma unroll
        for (int ks = 0; ks < 4; ++ks) bq[ks] = *(const bf16x8*)(Q + qrow * QC + head * 64 + ks * 16 + 8 * h);
        f32x16 st[6];
#pragma unroll
        for (int kt = 0; kt < 6; ++kt) {
#pragma unroll
            for (int r = 0; r < 16; ++r) st[kt][r] = 0.f;
            if (kt >= kt0 && kt < kt1) {
#pragma unroll
                for (int ks = 0; ks < 4; ++ks) { const bf16x8 a = *(const LAS bf16x8*)(lds + (32 * kt + q) * KSP + (16 * ks + 8 * h) * 2); st[kt] = MFMA32(a, bq[ks], st[kt]); }
            }
        }
        const float sk = p.in[13][head];
        float mx = sk;
#pragma unroll
        for (int kt = 0; kt < 6; ++kt) if (kt >= kt0 && kt < kt1) {
#pragma unroll
            for (int r = 0; r < 16; ++r) mx = fmaxf(mx, st[kt][r] * 0.125f);
        }
        mx = fmaxf(mx, __shfl_xor(mx, 32));
        float sum = 0.f;
#pragma unroll
        for (int kt = 0; kt < 6; ++kt) if (kt >= kt0 && kt < kt1) {
#pragma unroll
            for (int r = 0; r < 16; ++r) { const float e = __expf(st[kt][r] * 0.125f - mx); st[kt][r] = e; sum += e; }
        }
        sum += __shfl_xor(sum, 32); sum += __expf(sk - mx);
        f32x16 o[2];
#pragma unroll
        for (int r = 0; r < 16; ++r) { o[0][r] = 0.f; o[1][r] = 0.f; }
#pragma unroll
        for (int kt = 0; kt < 6; ++kt) if (kt >= kt0 && kt < kt1) {
#pragma unroll
            for (int s = 0; s < 2; ++s) {
                u32x4 pw; pw.x = pk2(st[kt][8 * s + 0], st[kt][8 * s + 1]); pw.y = pk2(st[kt][8 * s + 2], st[kt][8 * s + 3]); pw.z = pk2(st[kt][8 * s + 4], st[kt][8 * s + 5]); pw.w = pk2(st[kt][8 * s + 6], st[kt][8 * s + 7]);
                const bf16x8 pb = __builtin_bit_cast(bf16x8, pw);
#pragma unroll
                for (int dt = 0; dt < 2; ++dt) {
                    const LAS unsigned char* vp = lds + VT_OFF + (32 * dt + q) * VTP + (32 * kt + 16 * s + 4 * h) * 2;
                    const u32x2 lo = *(const LAS u32x2*)vp, hi = *(const LAS u32x2*)(vp + 16);
                    const u32x4 aw = {lo.x, lo.y, hi.x, hi.y};
                    o[dt] = MFMA32(__builtin_bit_cast(bf16x8, aw), pb, o[dt]);
                }
            }
        }
        const float inv = 1.0f / sum;
        bf16* op = MIX + qrow * D + CC + head * 64 + 4 * h;
#pragma unroll
        for (int dt = 0; dt < 2; ++dt)
#pragma unroll
            for (int gq = 0; gq < 4; ++gq) { u32x2 w; w.x = pk2(o[dt][4 * gq + 0] * inv, o[dt][4 * gq + 1] * inv); w.y = pk2(o[dt][4 * gq + 2] * inv, o[dt][4 * gq + 3] * inv); *(u32x2*)(op + 32 * dt + 8 * gq) = w; }
    }
    __syncthreads();
}

#define XB_TMO      128
#define XB_XCNT(j)  (256  + 64 * (j))
#define XB_XSUB(j)  (1280 + 64 * (j))
#define XB_XGEN(j)  (2304 + 64 * (j))
#define XB_TOP      3328
#define XB_TOPGEN   3392
#define XCD_BAR_WORDS 3456
#define XB_SPIN_CAP (1u << 18)

__device__ __forceinline__ unsigned xb_ld(unsigned* p)              { return __hip_atomic_load(p, __ATOMIC_RELAXED, __HIP_MEMORY_SCOPE_AGENT); }
__device__ __forceinline__ unsigned xb_add(unsigned* p, unsigned v) { return __hip_atomic_fetch_add(p, v, __ATOMIC_RELAXED, __HIP_MEMORY_SCOPE_AGENT); }
__device__ __forceinline__ unsigned xb_xcc_id() { return (unsigned)__builtin_amdgcn_s_getreg((3 << 11) | 20) & 0xFu; }
#define XB_SPIN(cond, bar) do { unsigned _sp = 0; while (cond) { __builtin_amdgcn_s_sleep(1); \
    if ((++_sp & 255u) == 0u) { if (xb_ld(&(bar)[XB_TMO])) break; if (_sp > XB_SPIN_CAP) { atomicAdd(&(bar)[XB_TMO], 1u); break; } } } } while (0)

struct XcdBarrier {
    unsigned* bar; unsigned x;
    volatile LAS unsigned* st;
};

__device__ __forceinline__ XcdBarrier xcd_barrier_post(unsigned* bar, volatile LAS unsigned* st) {
    XcdBarrier b; b.bar = bar; b.x = xb_xcc_id(); b.st = st;
    if (threadIdx.x == 0) (void)xb_add(&bar[XB_XCNT(b.x)], 1u);
    return b;
}
__device__ __forceinline__ void xcd_barrier_complete(unsigned* bar, unsigned x, unsigned& nloc, unsigned& nx) {
    const unsigned G = gridDim.x * gridDim.y * gridDim.z;
    unsigned sum, cnt, mine, sp = 0u;
    for (;;) {
        sum = 0u; cnt = 0u; mine = 0u;
#pragma unroll
        for (unsigned j = 0; j < 16; ++j) { const unsigned c = xb_ld(&bar[XB_XCNT(j)]); sum += c; cnt += (c > 0u) ? 1u : 0u; mine = (j == x) ? c : mine; }
        if (sum == G) break;
        __builtin_amdgcn_s_sleep(1);
        if ((++sp & 255u) == 0u) { if (xb_ld(&bar[XB_TMO])) break; if (sp > XB_SPIN_CAP) { atomicAdd(&bar[XB_TMO], 1u); break; } }
    }
    nloc = mine > 0u ? mine : 1u; nx = cnt > 0u ? cnt : 1u;
}

__device__ __forceinline__ void xcd_barrier(const XcdBarrier& b) {
    asm volatile("s_waitcnt vmcnt(0)" ::: "memory");
    __syncthreads();
    if (threadIdx.x == 0) {
        unsigned* bar = b.bar;
        __builtin_amdgcn_s_waitcnt(0);
        unsigned nloc = b.st[0], nx = b.st[1];
        if (nloc == 0u) { xcd_barrier_complete(bar, b.x, nloc, nx); b.st[0] = nloc; b.st[1] = nx; }
        const unsigned old = xb_add(&bar[XB_XSUB(b.x)], 1u);
        const unsigned gen = old / nloc;
        if (old + 1u == (gen + 1u) * nloc) {
            __builtin_amdgcn_fence(__ATOMIC_RELEASE, "agent");
            asm volatile("s_waitcnt vmcnt(0)" ::: "memory");
            const unsigned og = xb_add(&bar[XB_TOP], 1u);
            const unsigned tg = og / nx;
            if (og + 1u == (tg + 1u) * nx) xb_add(&bar[XB_TOPGEN], 1u);
            else XB_SPIN(xb_ld(&bar[XB_TOPGEN]) == tg, bar);
            __builtin_amdgcn_fence(__ATOMIC_ACQUIRE, "agent");
            xb_add(&bar[XB_XGEN(b.x)], 1u);
            asm volatile("s_waitcnt vmcnt(0)" ::: "memory");
        } else {
            XB_SPIN(xb_ld(&bar[XB_XGEN(b.x)]) == gen, bar);
            __builtin_amdgcn_fence(__ATOMIC_ACQUIRE, "agent");
            asm volatile("s_waitcnt vmcnt(0)" ::: "memory");
        }
    }
    __syncthreads();
}


template <int NS, class Epi>
__device__ __forceinline__ void sample_fixup(const float* part, int ldn, int item, const Epi& E, unsigned* cnt) {
    int tid_ = threadIdx.x; asm volatile("" : "+v"(tid_));
    const int lane = tid_ & 63, wid = __builtin_amdgcn_readfirstlane(tid_ >> 6), wr = wid >> 2, wc = wid & 3, fr = lane & 15, fq = lane >> 4;
    const int pn = item >> 3, ah = (item >> 2) & 1, mh = item & 3;
    const size_t slice = (size_t)256 * ldn;
    const float* q = part + (size_t)(ah * 128 + wr * 64 + mh * 16 + fr) * ldn + pn * 256 + wc * 32 + 8 * fq;
    f32x4 s0 = {0.f, 0.f, 0.f, 0.f}, s1 = s0, s2 = s0, s3 = s0;
#pragma unroll
    for (int k4 = 0; k4 < NS; k4 += 4) {
        f32x4 l[4][4];
#pragma unroll
        for (int ks = 0; ks < 4; ++ks) { l[ks][0] = *(const f32x4*)(q); l[ks][1] = *(const f32x4*)(q + 4); l[ks][2] = *(const f32x4*)(q + 128); l[ks][3] = *(const f32x4*)(q + 132); q += slice; }
        s0 += (l[0][0] + l[1][0]) + (l[2][0] + l[3][0]); s1 += (l[0][1] + l[1][1]) + (l[2][1] + l[3][1]); s2 += (l[0][2] + l[1][2]) + (l[2][2] + l[3][2]); s3 += (l[0][3] + l[1][3]) + (l[2][3] + l[3][3]);
    }
    Unit u; u.pm = MP / 256; u.pn = pn; u.k0 = 0; u.nt = 0; u.split = 0;
#pragma unroll
    for (int a = 0; a < 2; ++a)
#pragma unroll
        for (int m = 0; m < 4; ++m)
            if (a == ah && m == mh) {
                f32x4 acc[2][2][4][2];
#pragma unroll
                for (int x = 0; x < 2; ++x)
#pragma unroll
                    for (int b = 0; b < 2; ++b)
#pragma unroll
                        for (int y = 0; y < 4; ++y) { acc[x][b][y][0] = (f32x4){0.f, 0.f, 0.f, 0.f}; acc[x][b][y][1] = (f32x4){0.f, 0.f, 0.f, 0.f}; }
                acc[a][0][m][0] = s0; acc[a][0][m][1] = s1; acc[a][1][m][0] = s2; acc[a][1][m][1] = s3;
                Epi Eh = E; Eh.ai0 = a; Eh.ai1 = a + 1; Eh.m0 = m; Eh.m1 = m + 1;
                Eh(acc, u, wr, wc, fr, fq);
            }
    if (cnt) {
        asm volatile("s_waitcnt vmcnt(0)" ::: "memory");
        __syncthreads();
        if (wid == 0) {
            __builtin_amdgcn_fence(__ATOMIC_RELEASE, "agent");
            asm volatile("s_waitcnt vmcnt(0)" ::: "memory");
            if (lane == 0) (void)__hip_atomic_fetch_add(cnt, 1u, __ATOMIC_RELAXED, __HIP_MEMORY_SCOPE_AGENT);
        }
    }
}

__device__ __forceinline__ void p7_rows(float* out, const bf16* H3B, const float* RSS3, const float* gfin, int row0, int row_end, int step) {
    int t7 = threadIdx.x; asm volatile("" : "+v"(t7));
    const int lane = t7 & 63, wid = __builtin_amdgcn_readfirstlane(t7 >> 6);
    const f32x4* g4 = (const f32x4*)gfin + 2 * lane;
    const f32x4 ga = g4[0], gb = g4[1], gc = g4[128], gd = g4[129];
    for (int row = row0 + wid * 2; row < row_end; row += step) {
        float part[2]; u32x4 w[2][2];
#pragma unroll
        for (int k = 0; k < 2; ++k) {
            part[k] = RSS3[(size_t)(row + k) * 16 + (lane & 15)]; if (lane >= 16) part[k] = 0.f;
            const u32x4* hp = (const u32x4*)(H3B + (size_t)(row + k) * D) + lane;
            w[k][0] = hp[0]; w[k][1] = hp[64];
        }
#pragma unroll
        for (int k = 0; k < 2; ++k) {
            const float rs = __builtin_amdgcn_rsqf(wave_sum(part[k]) * (1.0f / D) + EPS);
            f32x4* o = (f32x4*)(out + (size_t)(row + k) * D) + 2 * lane;
            const u32x4 a = w[k][0], b = w[k][1];
            o[0] = (f32x4){bflo(a.x), bfhi(a.x), bflo(a.y), bfhi(a.y)} * rs * ga; o[1] = (f32x4){bflo(a.z), bfhi(a.z), bflo(a.w), bfhi(a.w)} * rs * gb;
            o[128] = (f32x4){bflo(b.x), bfhi(b.x), bflo(b.y), bfhi(b.y)} * rs * gc; o[129] = (f32x4){bflo(b.z), bfhi(b.z), bflo(b.w), bfhi(b.w)} * rs * gd;
        }
    }
}

__global__ void __launch_bounds__(NTHREADS, 2) fwd_megakernel(Params p) {
    extern __shared__ __attribute__((aligned(16))) unsigned char lds_raw[];
    LAS unsigned char* lds = (LAS unsigned char*)lds_raw;
    cg::grid_group grid = cg::this_grid();
    const int tid = threadIdx.x, lane = tid & 63, wid = __builtin_amdgcn_readfirstlane(tid >> 6), G = gridDim.x, bx = blockIdx.x;
    unsigned char* ws = p.ws;
    bf16* A1 = (bf16*)(ws + WS_A1); bf16* HB = (bf16*)(ws + WS_HB); bf16* PB = (bf16*)(ws + WS_PB); bf16* PP = (bf16*)(ws + WS_PP); bf16* HID = (bf16*)(ws + WS_HID); bf16* MIX = (bf16*)(ws + WS_MIX); bf16* H3B = (bf16*)(ws + WS_A1);
    unsigned* ctl = (unsigned*)(ws + WS_CTL);
    float* RSS1 = (float*)(ws + WS_RSS1); float* RSS2 = (float*)(ws + WS_RSS2); float* RSS3 = (float*)(ws + WS_RSS3);

    volatile LAS unsigned* MISC = (volatile LAS unsigned*)(lds + MISC_OFF);
    if (tid < 64) MISC[tid] = 0u;
    __syncthreads();
    XcdBarrier bar = xcd_barrier_post((unsigned*)(ws + WS_CTL), MISC + 8);
    p0_prologue(p, lds, G, tid, wid, lane);
    if (p.ws == nullptr) grid.sync();
    xcd_barrier(bar);
    {
        pg8::Gemm g{A1, (const bf16*)(ws + WS_WIN), MT, NIN, D}; pg8::StaticOrder S; S.init(MT, NIN, D, G, bx);
        EpiIn E{(bf16*)(ws + WS_U), (bf16*)(ws + WS_Q), (bf16*)(ws + WS_KB), (bf16*)(ws + WS_VB), (const float*)(ws + WS_ROPE), p.out};
        pg8::gemm_phase<EpiIn, pg8::StaticOrder, true, true>(lds, g, S, E);
        pg8::Gemm g2{PB, (const bf16*)(ws + WS_WP), MT, D, DPLE}; pg8::StaticOrder S2; S2.init(MT, D, DPLE, G, G - 1 - bx);
        EpiPlain E2{PP, D};
        pg8::gemm_phase<EpiPlain, pg8::StaticOrder, true, true>(lds, g2, S2, E2);
    }
    xcd_barrier(bar);
    const int vb = (G % 8 == 0) ? (bx % 8) * (G / 8) + bx / 8 : bx;
    for (int it = vb; it < N_ATT; it += G) { if (G == 256 && vb >= G - 4 && it == vb + 3 * G) continue; attn_item(p, lds, it, tid, wid, lane); }
    if (G == 256 && vb >= 16 && vb < 20) attn_item(p, lds, (G - 4 + (vb - 16)) + 3 * G, tid, wid, lane);
    for (int it = G - 1 - vb; it < N_CONV; it += G) conv_item(p, lds, it, tid, wid, lane);
    if (G == 256 && vb >= 20 && vb < G - 4) shadow_transpose(p.in[14], D, D, nullptr, (bf16*)(ws + WS_WOUT), lds, vb - 20, G - 24);
    else if (G != 256) shadow_transpose(p.in[14], D, D, nullptr, (bf16*)(ws + WS_WOUT), lds, bx, G);
    xcd_barrier(bar);
    float* PARTA = (float*)(ws + WS_PART); float* PARTB = (float*)(ws + WS_PARTB);
    unsigned* cnt3 = ctl + CW_SPLIT; unsigned* cnt4 = ctl + CW_SPLIT + 64; unsigned* cnt5 = ctl + CW_SPLIT + 128;
    {
        pg8::Gemm g{MIX, (const bf16*)(ws + WS_WOUT), MT, D, D}; pg8::SplitOrder S; S.init(MP, D, D, 256, G, bx, nullptr, 0u);
        EpiRes<true> E{p.in[0], p.in[1], HB, RSS1};
        pg8::gemm_phase<EpiRes<true>, pg8::SplitOrder, true, true>(lds, g, S, E, pg8::SplitCtx{PARTA, D});
        if (bx >= 16) shadow_transpose(p.in[16], D, FF, p.in[15], (bf16*)(ws + WS_W1), lds, bx - 16, G - 16);
    }
    xcd_barrier(bar);
    {
        if (bx >= G - 32) { EpiRes<true> Ef{p.in[0], p.in[1], HB, RSS1}; sample_fixup<4>(PARTA, D, G - 1 - bx, Ef, cnt3); }
        pg8::Gemm g{HB, (const bf16*)(ws + WS_W1), MT, FF, D}; pg8::SplitOrder S; S.init(MP, FF, D, 256, G, bx, cnt3, 32u);
        EpiFF1 E{HID, RSS1};
        pg8::gemm_phase<EpiFF1, pg8::SplitOrder, true, true>(lds, g, S, E, pg8::SplitCtx{PARTB, FF});
        if (bx >= 64) shadow_transpose(p.in[17], FF, D, nullptr, (bf16*)(ws + WS_W2), lds, bx - 64, G - 64);
    }
    xcd_barrier(bar);
    {
        if (bx >= G - 128) { EpiFF1 Ef{HID, RSS1}; sample_fixup<4>(PARTB, FF, G - 1 - bx, Ef, cnt4); }
        pg8::Gemm g{HID, (const bf16*)(ws + WS_W2), MT, D, FF}; pg8::SplitOrder S; S.init(MP, D, FF, 512, G, bx, cnt4, 128u);
        EpiRes<false> E{nullptr, nullptr, HB, RSS2, RSS1};
        pg8::gemm_phase<EpiRes<false>, pg8::SplitOrder, true, true>(lds, g, S, E, pg8::SplitCtx{PARTA, D});
        if (bx >= 32) shadow_transpose(p.in[19], D, D, p.in[18], (bf16*)(ws + WS_WG), lds, bx - 32, G - 32);
    }
    xcd_barrier(bar);
    {
        if (bx >= G - 32) { EpiRes<false> Ef{nullptr, nullptr, HB, RSS2, RSS1}; sample_fixup<8>(PARTA, D, G - 1 - bx, Ef, cnt5); }
        pg8::Gemm g{HB, (const bf16*)(ws + WS_WG), MT, D, D}; pg8::SplitOrder S; S.init(MP, D, D, 256, G, bx, cnt5, 32u);
        EpiGate E{HB, H3B, PP, RSS2, RSS3};
        pg8::gemm_phase<EpiGate, pg8::SplitOrder, true, true>(lds, g, S, E, pg8::SplitCtx{PARTB, D});
    }
    xcd_barrier(bar);
    if (G != 256) {
        if (bx >= G - 32) { EpiGate Ef{HB, H3B, PP, RSS2, RSS3}; sample_fixup<4>(PARTB, D, G - 1 - bx, Ef, nullptr); }
        p7_rows(p.out, H3B, RSS3, p.in[21], bx * NWAVES * 2, MP, G * NWAVES * 2);
        xcd_barrier(bar);
        p7_rows(p.out, H3B, RSS3, p.in[21], MP + bx * NWAVES * 2, MT, G * NWAVES * 2);
    } else if (bx >= G - 32) {
        const int f = bx - (G - 32);
        { EpiGate Ef{HB, H3B, PP, RSS2, RSS3}; sample_fixup<4>(PARTB, D, G - 1 - bx, Ef, nullptr); }
        unsigned* cnt6 = ctl + CW_SPLIT + 192;
        asm volatile("s_waitcnt vmcnt(0)" ::: "memory");
        __syncthreads();
        if (tid < 64) {
            __builtin_amdgcn_fence(__ATOMIC_RELEASE, "agent");
            asm volatile("s_waitcnt vmcnt(0)" ::: "memory");
            if (lane == 0) (void)__hip_atomic_fetch_add(cnt6, 1u, __ATOMIC_RELAXED, __HIP_MEMORY_SCOPE_AGENT);
            unsigned polls = 0;
            while ((unsigned)__builtin_amdgcn_readfirstlane((int)__hip_atomic_load(cnt6, __ATOMIC_RELAXED, __HIP_MEMORY_SCOPE_AGENT)) < 32u) { __builtin_amdgcn_s_sleep(2); if (++polls > (1u << 22)) break; }
            __builtin_amdgcn_fence(__ATOMIC_ACQUIRE, "agent");
            asm volatile("s_waitcnt vmcnt(0)" ::: "memory");
        }
        __syncthreads();
        p7_rows(p.out, H3B, RSS3, p.in[21], MP + f * 8, MP + f * 8 + 8, 16);
        p7_rows(p.out, H3B, RSS3, p.in[21], (1792 + f) * 16, 1952 * 16, 32 * 16);
    } else {
        p7_rows(p.out, H3B, RSS3, p.in[21], bx * 16, 1792 * 16, 224 * 16);
        if (bx < 96) p7_rows(p.out, H3B, RSS3, p.in[21], (1952 + bx) * 16, (1952 + bx) * 16 + 16, 16);
    }
}

extern "C" void kernel_launch(void* const* d_in, const int* in_sizes, int n_in, void* d_out, int out_size, void* d_ws, size_t ws_size, hipStream_t stream) {
    static int grid_blocks = 0;
    if (grid_blocks == 0) {
        if (n_in != 22 || ws_size < WS_END) { fprintf(stderr, "kernel_launch: unexpected n_in %d / ws_size %zu\n", n_in, ws_size); grid_blocks = -1; return; }
        int dev = 0, cus = 0, per_cu = 0;
        (void)hipGetDevice(&dev);
        (void)hipDeviceGetAttribute(&cus, hipDeviceAttributeMultiprocessorCount, dev);
        (void)hipFuncSetAttribute((const void*)fwd_megakernel, hipFuncAttributeMaxDynamicSharedMemorySize, LDS_BYTES);
        (void)hipOccupancyMaxActiveBlocksPerMultiprocessor(&per_cu, (const void*)fwd_megakernel, NTHREADS, LDS_BYTES);
        if (per_cu < 1) { fprintf(stderr, "kernel_launch: occupancy query reports %d blocks per CU\n", per_cu); per_cu = 1; }
        if (per_cu > 1) per_cu = 1;
        grid_blocks = cus * per_cu;
    }
    if (grid_blocks < 0) return;
    Params p{};
    for (int i = 0; i < 22; ++i) p.in[i] = (const float*)d_in[i];
    p.out = (float*)d_out; p.ws = (unsigned char*)d_ws;
    (void)hipMemsetAsync((char*)d_ws + WS_CTL, 0, CTL_ZERO_BYTES, stream);
    void* args[] = {&p};
    hipError_t e = hipLaunchCooperativeKernel((const void*)fwd_megakernel, dim3(grid_blocks), dim3(NTHREADS), args, LDS_BYTES, stream);
    if (e != hipSuccess) fprintf(stderr, "cooperative launch failed: %s (grid %d)\n", hipGetErrorString(e), grid_blocks);
}
```

```cpp
#include <hip/hip_runtime.h>
#include <hip/hip_cooperative_groups.h>
#include <cstdio>
#include <cstdint>
namespace cg = cooperative_groups;

namespace pg8 {
#define PG8_LAS __attribute__((address_space(3)))
typedef unsigned short bf16_t;
typedef short bf16x8 __attribute__((ext_vector_type(8)));
typedef float f32x4 __attribute__((ext_vector_type(4)));
typedef unsigned u32x4 __attribute__((ext_vector_type(4)));
constexpr int BM = 256, BK = 64, HALF = 128, HTB = HALF * BK * 2  , STAGE_BYTES = 8 * HTB, NXCD = 8, WGM = 8;

__host__ __device__ __forceinline__ int lds_byte(int r, int c) { const int st = (r >> 4) * 2 + (c >> 5), rr = r & 15, cc = c & 31, ob = rr * 64 + cc * 2; return st * 1024 + (ob ^ (((ob >> 9) & 1) << 5)); }
__host__ __device__ __forceinline__ void stage_rc(int b, int& R, int& C) { const int st = b / 1024, sb = b % 1024, swz = sb ^ (((sb >> 9) & 1) << 5); R = (st >> 1) * 16 + swz / 64; C = (st & 1) * 32 + (swz % 64) / 2; }
__host__ __device__ __forceinline__ int perm32(int rho) { const int n = rho >> 4, i = rho & 15; return 8 * (i >> 2) + 4 * n + (i & 3); }

struct Unit { int pm, pn, k0, nt, split; };
struct Gemm { const bf16_t* A; const bf16_t* Bt; int M, N, K; };

struct StaticOrder {
    int nM, nN, nwg, G, c, ntfull;
    __host__ __device__ void init(int M, int N, int K, int G_, int c_) { nM = M / BM; nN = N / BM; nwg = nM * nN; G = G_; c = c_; ntfull = K / BK; }
    __host__ __device__ bool next(int i, Unit& u) const {
        const long L = (long)i * G + c; if (L >= nwg) return false;
        int wgid = (int)L; { const int q = nwg / NXCD, r = nwg % NXCD, xcd = wgid % NXCD, off = wgid / NXCD; wgid = (xcd < r ? xcd * (q + 1) : r * (q + 1) + (xcd - r) * q) + off; }
        const int nig = WGM * nN, gid = wgid / nig, fm = gid * WGM, gsz = (nM - fm) < WGM ? (nM - fm) : WGM;
        u.pm = fm + ((wgid % nig) % gsz); u.pn = (wgid % nig) / gsz; u.k0 = 0; u.nt = ntfull; u.split = 0; return true;
    }
    __device__ __forceinline__ void a_ready(const Unit&) const {}
    __device__ __forceinline__ void done(const Unit&) const {}
};

struct SplitOrder {
    StaticOrder so; int nmain, nsplit, ntsub, nsub; unsigned* ready; unsigned need;
    __device__ void init(int Mmain, int N, int K, int klen, int G_, int c_, unsigned* ready_, unsigned need_) { so.init(Mmain, N, K, G_, c_); nmain = so.nwg; nsplit = K / klen; ntsub = klen / BK; nsub = (N / BM) * nsplit; ready = ready_; need = need_; }
    __device__ bool next(int i, Unit& u) const {
        if (so.next(i, u)) return true;
        const int nmine = (nmain - so.c + so.G - 1) / so.G;
        const int j = (i - nmine) * so.G + so.c;
        if (j < 0 || j >= nsub) return false;
        u.pm = so.nM; u.pn = j / nsplit; u.k0 = (j % nsplit) * ntsub * BK; u.nt = ntsub; u.split = 1; return true;
    }
    __device__ __forceinline__ void a_ready(const Unit& u) const {
        if (!u.split || need == 0u) return;
        if (threadIdx.x < 64) {
            unsigned polls = 0;
            while ((unsigned)__builtin_amdgcn_readfirstlane((int)__hip_atomic_load(ready, __ATOMIC_RELAXED, __HIP_MEMORY_SCOPE_AGENT)) < need) { __builtin_amdgcn_s_sleep(2); if (++polls > (1u << 22)) break; }
            __builtin_amdgcn_fence(__ATOMIC_ACQUIRE, "agent");
            asm volatile("s_waitcnt vmcnt(0)" ::: "memory");
        }
        asm volatile("" ::: "memory"); __builtin_amdgcn_s_barrier(); asm volatile("" ::: "memory");
    }
    __device__ __forceinline__ void done(const Unit&) const {}
};
struct SplitCtx { float* sum; int ldn; };
typedef float f32x2 __attribute__((ext_vector_type(2)));
typedef __bf16 bf16x2v __attribute__((ext_vector_type(2)));
__device__ __forceinline__ unsigned pk2(float lo, float hi) { f32x2 v = {lo, hi}; return __builtin_bit_cast(unsigned, __builtin_convertvector(v, bf16x2v)); }
__device__ __forceinline__ u32x4 pk8(const f32x4& a, const f32x4& b) { u32x4 w; w.x = pk2(a[0], a[1]); w.y = pk2(a[2], a[3]); w.z = pk2(b[0], b[1]); w.w = pk2(b[2], b[3]); return w; }
__device__ __forceinline__ float bflo(unsigned w) { return __builtin_bit_cast(float, w << 16); }
__device__ __forceinline__ float bfhi(unsigned w) { return __builtin_bit_cast(float, w & 0xffff0000u); }
__device__ __forceinline__ float sigmoidf_(float x) { return __builtin_amdgcn_rcpf(1.0f + __expf(-x)); }
template <class Epi, class Sched, bool ALIGN_EPI = false, bool SP2 = false>
__device__ __forceinline__ void gemm_phase(PG8_LAS unsigned char* lds, const Gemm g, const Sched& S, const Epi& E, const SplitCtx X = SplitCtx{nullptr, 0}) {
    int tid_ = threadIdx.x; asm volatile("" : "+v"(tid_));
    const int tid = tid_, wid = __builtin_amdgcn_readfirstlane(tid >> 6), lane = tid & 63, wr = wid >> 2, wc = wid & 3, fr = lane & 15, fq = lane >> 4;
    const int K = g.K;
    unsigned voffA[2], voffB[2];
#pragma unroll
    for (int i = 0; i < 2; ++i) { int R, C; stage_rc(tid * 16 + i * 8192, R, C); const int Rb = Epi::PERM ? ((R & ~31) + perm32(R & 31)) : R;
        voffA[i] = (unsigned)(R * K + C) * 2u; voffB[i] = (unsigned)(Rb * K + C) * 2u; }
    const size_t kstep = (size_t)(BK * 2);
    const size_t hstep = (size_t)HALF * K * 2;
    const size_t tstep = 2 * hstep;
    const unsigned ldsw = (unsigned)wid * 1024u;
    const int aoff = lds_byte(wr * 64 + fr, fq * 8), boff = lds_byte(wc * 32 + fr, fq * 8);
#define PG8_SA(b, h) (((b) * 2 + (h)) * HTB)
#define PG8_SB(b, h) ((4 + (b) * 2 + (h)) * HTB)
#define PG8_STAGE(bufoff, gbase, voff) do { _Pragma("unroll") for (int _i = 0; _i < 2; ++_i) \
        __builtin_amdgcn_global_load_lds((const unsigned*)((const char*)(gbase) + (voff)[_i]), (PG8_LAS unsigned*)(lds + (bufoff) + ldsw + _i * 8192), 16, 0, 0); } while (0)
#define PG8_LDA(dst, b, h) do { _Pragma("unroll") for (int m = 0; m < 4; ++m) _Pragma("unroll") for (int k = 0; k < 2; ++k) dst[m][k] = *(const PG8_LAS bf16x8*)(lds + PG8_SA(b, h) + aoff + m * 2048 + k * 1024); } while (0)
#define PG8_LDB(dst, b, h) do { _Pragma("unroll") for (int n = 0; n < 2; ++n) _Pragma("unroll") for (int k = 0; k < 2; ++k) dst[n][k] = *(const PG8_LAS bf16x8*)(lds + PG8_SB(b, h) + boff + n * 2048 + k * 1024); } while (0)
#define PG8_MMA(ai, bj, At, Bt) do { __builtin_amdgcn_s_setprio(1); _Pragma("unroll") for (int m = 0; m < 4; ++m) _Pragma("unroll") for (int n = 0; n < 2; ++n) _Pragma("unroll") for (int k = 0; k < 2; ++k) \
        acc[ai][bj][m][n] = __builtin_amdgcn_mfma_f32_16x16x32_bf16(Bt[n][k], At[m][k], acc[ai][bj][m][n], 0, 0, 0); __builtin_amdgcn_s_setprio(0); } while (0)
#define PG8_WAIT_V(n) asm volatile("s_waitcnt vmcnt(" #n ")" ::: "memory")
#define PG8_WAIT_L(n) asm volatile("s_waitcnt lgkmcnt(" #n ")" ::: "memory")
#define PG8_BAR __builtin_amdgcn_s_barrier()
#define PG8_SCHED __builtin_amdgcn_sched_barrier(0)
    Unit cur, nxt; int ui = 0;
    if (!S.next(0, cur)) return;
    f32x4 acc[2][2][4][2];
#pragma unroll
    for (int a = 0; a < 2; ++a)
#pragma unroll
        for (int b = 0; b < 2; ++b)
#pragma unroll
            for (int m = 0; m < 4; ++m)
#pragma unroll
                for (int n = 0; n < 2; ++n) acc[a][b][m][n] = (f32x4){0.f, 0.f, 0.f, 0.f};
    bf16x8 At[4][2], B0[2][2], B1[2][2];
    const char* cA = (const char*)g.A + (size_t)cur.pm * tstep + (size_t)cur.k0 * 2; const char* cB = (const char*)g.Bt + (size_t)cur.pn * tstep + (size_t)cur.k0 * 2;
    S.a_ready(cur);
    if constexpr (SP2) {
        PG8_STAGE(PG8_SB(0, 0), cB, voffB); PG8_STAGE(PG8_SB(0, 1), cB + hstep, voffB); PG8_STAGE(PG8_SA(0, 0), cA, voffA); PG8_STAGE(PG8_SA(0, 1), cA + hstep, voffA);
        if (wr == 1) PG8_BAR;
        PG8_WAIT_V(2); PG8_BAR;
        PG8_STAGE(PG8_SB(1, 0), cB + kstep, voffB); PG8_STAGE(PG8_SA(1, 0), cA + kstep, voffA); PG8_STAGE(PG8_SB(1, 1), cB + hstep + kstep, voffB);
        PG8_WAIT_V(6); PG8_BAR;
    } else {
        PG8_STAGE(PG8_SB(0, 0), cB, voffB); PG8_STAGE(PG8_SA(0, 0), cA, voffA); PG8_STAGE(PG8_SB(0, 1), cB + hstep, voffB); PG8_STAGE(PG8_SA(0, 1), cA + hstep, voffA);
        if (wr == 1) PG8_BAR;
        PG8_WAIT_V(4); PG8_BAR;
        PG8_STAGE(PG8_SB(1, 0), cB + kstep, voffB); PG8_STAGE(PG8_SA(1, 0), cA + kstep, voffA); PG8_STAGE(PG8_SB(1, 1), cB + hstep + kstep, voffB);
        PG8_WAIT_V(6); PG8_BAR;
    }
    for (;;) {
        const bool has_next = S.next(ui + 1, nxt);
        const char* nA = has_next ? (const char*)g.A + (size_t)nxt.pm * tstep + (size_t)nxt.k0 * 2 : cA; const char* nB = has_next ? (const char*)g.Bt + (size_t)nxt.pn * tstep + (size_t)nxt.k0 * 2 : cB;
        const int nt = cur.nt;
#pragma unroll 1
        for (int t = 0; t < nt; t += 2) {
            const bool last = (t == nt - 2);
            const char* a1 = cA + (size_t)(t + 1) * kstep;
            const char* a2 = last ? nA : cA + (size_t)(t + 2) * kstep; const char* b2 = last ? nB : cB + (size_t)(t + 2) * kstep;
            const char* a3 = a2 + kstep; const char* b3 = b2 + kstep;
            if (last && has_next) S.a_ready(nxt);
            if constexpr (SP2) {
            PG8_LDB(B0, 0, 0); PG8_LDB(B1, 0, 1); PG8_SCHED; PG8_LDA(At, 0, 0); PG8_STAGE(PG8_SA(1, 1), a1 + hstep, voffA);
            PG8_WAIT_V(8); PG8_WAIT_L(0); PG8_BAR; PG8_MMA(0, 0, At, B0); PG8_MMA(0, 1, At, B1); PG8_BAR; PG8_SCHED;
            PG8_LDA(At, 0, 1); PG8_STAGE(PG8_SB(0, 0), b2, voffB); PG8_STAGE(PG8_SB(0, 1), b2 + hstep, voffB); PG8_STAGE(PG8_SA(0, 0), a2, voffA);
            PG8_WAIT_V(8); PG8_WAIT_L(0); PG8_BAR; PG8_MMA(1, 0, At, B0); PG8_MMA(1, 1, At, B1); PG8_BAR; PG8_SCHED;
            PG8_LDB(B0, 1, 0); PG8_LDB(B1, 1, 1); PG8_SCHED; PG8_LDA(At, 1, 0); PG8_STAGE(PG8_SA(0, 1), a2 + hstep, voffA);
            PG8_WAIT_V(8); PG8_WAIT_L(0); PG8_BAR; PG8_MMA(0, 0, At, B0); PG8_MMA(0, 1, At, B1); PG8_BAR; PG8_SCHED;
            PG8_LDA(At, 1, 1); PG8_STAGE(PG8_SB(1, 0), b3, voffB); PG8_STAGE(PG8_SB(1, 1), b3 + hstep, voffB); PG8_STAGE(PG8_SA(1, 0), a3, voffA);
            PG8_WAIT_V(8); PG8_WAIT_L(0); PG8_BAR; PG8_MMA(1, 0, At, B0); PG8_MMA(1, 1, At, B1); PG8_BAR; PG8_SCHED;
            } else {
            PG8_LDB(B0, 0, 0); PG8_SCHED; PG8_LDA(At, 0, 0); PG8_STAGE(PG8_SA(1, 1), a1 + hstep, voffA);
            PG8_WAIT_L(8); PG8_BAR; PG8_WAIT_L(0); PG8_MMA(0, 0, At, B0); PG8_BAR; PG8_SCHED;
            PG8_LDB(B1, 0, 1); PG8_STAGE(PG8_SB(0, 0), b2, voffB);
            PG8_BAR; PG8_WAIT_L(0); PG8_MMA(0, 1, At, B1); PG8_BAR;
            PG8_LDA(At, 0, 1); PG8_STAGE(PG8_SA(0, 0), a2, voffA);
            PG8_BAR; PG8_WAIT_L(0); PG8_MMA(1, 0, At, B0); PG8_BAR; PG8_SCHED;
            PG8_STAGE(PG8_SB(0, 1), b2 + hstep, voffB);
            PG8_WAIT_V(6); PG8_BAR; PG8_MMA(1, 1, At, B1); PG8_BAR;
            PG8_LDB(B0, 1, 0); PG8_SCHED; PG8_LDA(At, 1, 0); PG8_STAGE(PG8_SA(0, 1), a2 + hstep, voffA);
            PG8_WAIT_L(8); PG8_BAR; PG8_WAIT_L(0); PG8_MMA(0, 0, At, B0); PG8_BAR; PG8_SCHED;
            PG8_LDB(B1, 1, 1); PG8_STAGE(PG8_SB(1, 0), b3, voffB);
            PG8_BAR; PG8_WAIT_L(0); PG8_MMA(0, 1, At, B1); PG8_BAR;
            PG8_LDA(At, 1, 1); PG8_STAGE(PG8_SA(1, 0), a3, voffA);
            PG8_BAR; PG8_WAIT_L(0); PG8_MMA(1, 0, At, B0); PG8_BAR; PG8_SCHED;
            PG8_STAGE(PG8_SB(1, 1), b3 + hstep, voffB);
            PG8_WAIT_V(6); PG8_BAR; PG8_MMA(1, 1, At, B1); PG8_BAR;
            }
        }
        if constexpr (ALIGN_EPI) { if (wr == 0) PG8_BAR; }
        bool do_epi = true;
        if (cur.split) {
            const size_t slice = (size_t)BM * X.ldn, rstep = (size_t)16 * X.ldn;
            float* rp = X.sum + (size_t)(cur.k0 / (cur.nt * BK)) * slice + (size_t)(wr * 64 + fr) * X.ldn + cur.pn * BM + wc * 32 + 8 * fq;
#pragma unroll
            for (int a = 0; a < 2; ++a) {
#pragma unroll
                for (int m = 0; m < 4; ++m) {
#pragma unroll
                    for (int b = 0; b < 2; ++b) { *(f32x4*)(rp + b * HALF) = acc[a][b][m][0]; *(f32x4*)(rp + b * HALF + 4) = acc[a][b][m][1]; }
                    rp += rstep;
                }
                rp += 4 * rstep;
            }
            do_epi = false;
        }
        if (do_epi) E(acc, cur, wr, wc, fr, fq);
        if (!has_next) break;
#pragma unroll
        for (int a = 0; a < 2; ++a)
#pragma unroll
            for (int b = 0; b < 2; ++b)
#pragma unroll
                for (int m = 0; m < 4; ++m)
#pragma unroll
                    for (int n = 0; n < 2; ++n) acc[a][b][m][n] = (f32x4){0.f, 0.f, 0.f, 0.f};
        cur = nxt; cA = nA; cB = nB; ++ui;
        if constexpr (ALIGN_EPI) { if (wr == 1) PG8_BAR; }
    }
    PG8_WAIT_V(0);
    if constexpr (!ALIGN_EPI) { if (wr == 0) PG8_BAR; }
    PG8_BAR;
    if constexpr (Epi::AFTER_DRAIN) { E.fused(acc, cur, wr, wc, fr, fq, lds, wid, lane); S.done(cur); }
#undef PG8_SA
#undef PG8_SB
#undef PG8_STAGE
#undef PG8_LDA
#undef PG8_LDB
#undef PG8_MMA
#undef PG8_WAIT_V
#undef PG8_WAIT_L
#undef PG8_BAR
#undef PG8_SCHED
}
}
constexpr int D = 1024, SEQ = 16384, MP = 2 * SEQ, MS = 256, MT = MP + MS, NIN = 1792, FF = 4096, DPLE = 256, CC = 512, QC = 512, KVC = 128;
constexpr float EPS = 1e-6f;
constexpr int NTHREADS = 512, NWAVES = 8;
constexpr int LDS_BYTES = 135168 + 256;
constexpr int MISC_OFF = 135168;
constexpr size_t WS_CTL = 0, CTL_ZERO_BYTES = 32768; constexpr int CW_SPLIT = 4096;
constexpr size_t OFF_Y = 0, OFF_NKP = (size_t)MT * D, OFF_NVP = OFF_NKP + 32768, OFF_NCP = OFF_NVP + 32768, OFF_NKS = OFF_NCP + 30720, OFF_NVS = OFF_NKS + 32768, OFF_NCS = OFF_NVS + 32768;
constexpr size_t MiB = 1u << 20;
constexpr size_t WS_WIN = 1 * MiB, WS_WOUT = 5 * MiB, WS_W1 = 7 * MiB, WS_W2 = 15 * MiB, WS_WG = 23 * MiB, WS_WP = 25 * MiB, WS_ROPE = 26 * MiB;
constexpr size_t WS_RSS1 = 30 * MiB, WS_RSS2 = 33 * MiB, WS_RSS3 = 36 * MiB;
constexpr size_t WS_HB = 40 * MiB, WS_PB = 105 * MiB, WS_PP = 122 * MiB, WS_HID = 188 * MiB;
constexpr size_t WS_A1 = 188 * MiB, WS_MIX = 253 * MiB, WS_U = 318 * MiB, WS_Q = 351 * MiB, WS_KB = 384 * MiB, WS_VB = 393 * MiB;
constexpr size_t WS_PART = 446 * MiB, WS_PARTB = 462 * MiB;
constexpr size_t WS_END = 478 * MiB;
static_assert(WS_HID + (size_t)MT * FF * 2 <= WS_PART && WS_VB + (size_t)MT * KVC * 2 <= WS_END && WS_PP + (size_t)MT * D * 2 <= WS_HID && WS_HB + (size_t)MT * D * 2 <= WS_PB && WS_PB + (size_t)MT * DPLE * 2 <= WS_PP, "ws map");

#define LAS __attribute__((address_space(3)))
typedef unsigned short bf16;
using pg8::f32x4; using pg8::u32x4; using pg8::bf16x8; using pg8::Unit;
typedef float f32x16 __attribute__((ext_vector_type(16)));
typedef unsigned u32x2 __attribute__((ext_vector_type(2)));
using pg8::pk2; using pg8::pk8; using pg8::bflo; using pg8::bfhi; using pg8::sigmoidf_;

struct Params { const float* in[22]; float* out; unsigned char* ws; };

__host__ __device__ __forceinline__ int win_dest(int c) {
    if (c < 512) return 256 * (c >> 7) + (c & 127);
    if (c < 1024) { c -= 512; return 256 * (c >> 7) + 128 + (c & 127); }
    if (c < 1536) { c -= 1024; const int hq = c >> 6, r = c & 63; return 256 * (4 + (hq >> 2)) + (r >> 5) * 128 + (hq & 3) * 32 + (r & 31); }
    if (c < 1664) { c -= 1536; const int hd = c >> 6, r = c & 63; return 1536 + (r >> 5) * 128 + hd * 32 + (r & 31); }
    c -= 1664; return 1536 + (c >> 6) * 128 + 64 + (c & 63);
}
__device__ __forceinline__ float wave_sum(float v) {
#pragma unroll
    for (int o = 1; o < 64; o <<= 1) v += __shfl_xor(v, o);
    return v;
}
#define LDS_WAIT() asm volatile("s_waitcnt lgkmcnt(0)" ::: "memory")

struct EpiIn {
    static constexpr bool PERM = true, AFTER_DRAIN = false;
    bf16 *U, *Q, *KB, *VB; const float* rope; float* out;
    __device__ __forceinline__ void operator()(const f32x4 (&acc)[2][2][4][2], const Unit& u, int wr, int wc, int fr, int fq) const {
        const int rowb = u.pm * 256 + wr * 64 + fr;
        if (u.pn < 4) {
            const int ch = 128 * u.pn + 32 * wc + 8 * fq;
#pragma unroll
            for (int ai = 0; ai < 2; ++ai)
#pragma unroll
                for (int m = 0; m < 4; ++m) {
                    const int row = rowb + ai * 128 + m * 16;
                    const bool isp = row < MP; const int srow = row - MP;
                    const int t = isp ? (row & (SEQ - 1)) : (srow & 31), bb = isp ? (row >> 14) : (srow >> 5);
                    f32x4 o0, o1;
#pragma unroll
                    for (int i = 0; i < 4; ++i) { o0[i] = acc[ai][0][m][0][i] * sigmoidf_(acc[ai][1][m][0][i]); o1[i] = acc[ai][0][m][1][i] * sigmoidf_(acc[ai][1][m][1][i]); }
                    *(u32x4*)(U + (size_t)row * CC + ch) = pk8(o0, o1);
                    float* dst = nullptr;
                    if (isp) { if (t >= SEQ - 30) dst = out + OFF_NCP + ((size_t)(bb * 30 + (t - (SEQ - 30)))) * CC + ch; }
                    else { if (t >= 2) dst = out + OFF_NCS + ((size_t)(bb * 30 + (t - 2))) * CC + ch; }
                    if (dst) { *(f32x4*)dst = o0; *(f32x4*)(dst + 4) = o1; }
                }
        } else if (u.pn < 6 || wc < 2) {
            const bool isq = u.pn < 6;
#pragma unroll
            for (int ai = 0; ai < 2; ++ai)
#pragma unroll
            for (int mh = 0; mh < 4; mh += 2) {
                f32x4 rp4[4][4];
#pragma unroll
                for (int m = mh; m < mh + 2; ++m) {
                    const int row = rowb + ai * 128 + m * 16;
                    const int pos = (row < MP) ? (row & (SEQ - 1)) : 2048 + ((row - MP) & 31);
                    const f32x4* rp = (const f32x4*)(rope + ((size_t)pos * 32 + 8 * fq) * 2);
                    rp4[m][0] = rp[0]; rp4[m][1] = rp[1]; rp4[m][2] = rp[2]; rp4[m][3] = rp[3];
                }
                asm volatile("" ::: "memory");
#pragma unroll
                for (int m = mh; m < mh + 2; ++m) {
                    const int row = rowb + ai * 128 + m * 16;
                    const bool isp = row < MP; const int srow = row - MP;
                    const int t = isp ? (row & (SEQ - 1)) : (srow & 31), bb = isp ? (row >> 14) : (srow >> 5);
                    bf16* op = isq ? Q + (size_t)row * QC + (4 * (u.pn - 4) + wc) * 64 + 8 * fq : KB + (size_t)row * KVC + wc * 64 + 8 * fq;
                    float* dst = nullptr;
                    if (!isq) {
                        if (isp) { if (t >= SEQ - 128) dst = out + OFF_NKP + ((size_t)((bb * 128 + (t - (SEQ - 128))) * 2 + wc)) * 64 + 8 * fq; }
                        else dst = out + OFF_NKS + ((size_t)(srow * 2 + wc)) * 64 + 8 * fq;
                    }
                    f32x4 a[2], b[2];
#pragma unroll
                    for (int n = 0; n < 2; ++n) {
                        const f32x4 r0 = rp4[m][2 * n], r1 = rp4[m][2 * n + 1];
                        const float cs[4] = {r0[0], r0[2], r1[0], r1[2]}, sn[4] = {r0[1], r0[3], r1[1], r1[3]};
#pragma unroll
                        for (int i = 0; i < 4; ++i) { const float x1 = acc[ai][0][m][n][i], x2 = acc[ai][1][m][n][i]; a[n][i] = x1 * cs[i] - x2 * sn[i]; b[n][i] = x2 * cs[i] + x1 * sn[i]; }
                    }
                    *(u32x4*)op = pk8(a[0], a[1]); *(u32x4*)(op + 32) = pk8(b[0], b[1]);
                    if (dst) { *(f32x4*)dst = a[0]; *(f32x4*)(dst + 4) = a[1]; *(f32x4*)(dst + 32) = b[0]; *(f32x4*)(dst + 36) = b[1]; }
                }
                asm volatile("" ::: "memory");
            }
        } else {
            const int dd = 32 * (wc - 2) + 8 * fq;
#pragma unroll
            for (int ai = 0; ai < 2; ++ai)
#pragma unroll
                for (int m = 0; m < 4; ++m) {
                    const int row = rowb + ai * 128 + m * 16;
                    const bool isp = row < MP; const int srow = row - MP;
                    const int t = isp ? (row & (SEQ - 1)) : (srow & 31), bb = isp ? (row >> 14) : (srow >> 5);
#pragma unroll
                    for (int bj = 0; bj < 2; ++bj) {
                        *(u32x4*)(VB + (size_t)row * KVC + 64 * bj + dd) = pk8(acc[ai][bj][m][0], acc[ai][bj][m][1]);
                        float* dst = nullptr;
                        if (isp) { if (t >= SEQ - 128) dst = out + OFF_NVP + ((size_t)((bb * 128 + (t - (SEQ - 128))) * 2 + bj)) * 64 + dd; }
                        else dst = out + OFF_NVS + ((size_t)(srow * 2 + bj)) * 64 + dd;
                        if (dst) { *(f32x4*)dst = acc[ai][bj][m][0]; *(f32x4*)(dst + 4) = acc[ai][bj][m][1]; }
                    }
                }
        }
    }
};
struct EpiPlain {
    static constexpr bool PERM = true, AFTER_DRAIN = false;
    bf16* O; int ldc;
    __device__ __forceinline__ void operator()(const f32x4 (&acc)[2][2][4][2], const Unit& u, int wr, int wc, int fr, int fq) const {
        const int rowb = u.pm * 256 + wr * 64 + fr, colb = u.pn * 256 + wc * 32 + 8 * fq;
#pragma unroll
        for (int ai = 0; ai < 2; ++ai)
#pragma unroll
            for (int m = 0; m < 4; ++m)
#pragma unroll
                for (int bj = 0; bj < 2; ++bj)
                    *(u32x4*)(O + (size_t)(rowb + ai * 128 + m * 16) * ldc + colb + bj * 128) = pk8(acc[ai][bj][m][0], acc[ai][bj][m][1]);
    }
};
__device__ __forceinline__ void wave_row_rs(const float* RSS, int base, int lane, int fr, float (&rs)[2][4]) {
    float r2[2];
#pragma unroll
    for (int a = 0; a < 2; ++a) {
        const f32x4* q = (const f32x4*)(RSS + (size_t)(base + 128 * a + lane) * 16);
        const f32x4 x0 = q[0], x1 = q[1], x2 = q[2], x3 = q[3];
        const float sm = (((x0[0] + x0[1]) + (x0[2] + x0[3])) + ((x1[0] + x1[1]) + (x1[2] + x1[3]))) + (((x2[0] + x2[1]) + (x2[2] + x2[3])) + ((x3[0] + x3[1]) + (x3[2] + x3[3])));
        r2[a] = __builtin_amdgcn_rsqf(sm * (1.0f / D) + EPS);
    }
#pragma unroll
    for (int a = 0; a < 2; ++a)
#pragma unroll
        for (int m = 0; m < 4; ++m) rs[a][m] = __shfl(r2[a], 16 * m + fr);
}
__device__ __forceinline__ float row_rs(const float* RSS, int row) {
    const f32x4* p = (const f32x4*)(RSS + (size_t)row * 16);
    const f32x4 a = p[0], b = p[1], c = p[2], d = p[3];
    const float s = ((a[0] + a[1]) + (a[2] + a[3])) + ((b[0] + b[1]) + (b[2] + b[3])) + ((c[0] + c[1]) + (c[2] + c[3])) + ((d[0] + d[1]) + (d[2] + d[3]));
    return __builtin_amdgcn_rsqf(s * (1.0f / D) + EPS);
}
template <bool FIRST>
struct EpiRes {
    static constexpr bool PERM = true, AFTER_DRAIN = false;
    const float* bp; const float* bs; bf16* HB; float* RSS; const float* RSSs = nullptr;
    bool seam = false; int ai0 = 0, ai1 = 2, m0 = 0, m1 = 4;
    __device__ __forceinline__ void operator()(const f32x4 (&acc)[2][2][4][2], const Unit& u, int wr, int wc, int fr, int fq) const {
        const int rowb = u.pm * 256 + wr * 64 + fr, colb = u.pn * 256 + wc * 32 + 8 * fq;
        float rs[2][4];
        if (!FIRST) wave_row_rs(RSSs, u.pm * 256 + wr * 64, fr + 16 * fq, fr, rs);
#pragma unroll
        for (int ai = 0; ai < 2; ++ai) if (ai >= ai0 && ai < ai1) {
            f32x4 bf[4][2][2]; u32x4 bw[4][2];
#pragma unroll
            for (int m = 0; m < 4; ++m) if (m >= m0 && m < m1) {
                const int row = rowb + ai * 128 + m * 16;
                if (FIRST) { const float* brow = (row < MP) ? bp + (size_t)row * D : bs + (size_t)(row - MP) * D;
#pragma unroll
                    for (int bj = 0; bj < 2; ++bj) { bf[m][bj][0] = *(const f32x4*)(brow + colb + bj * 128); bf[m][bj][1] = *(const f32x4*)(brow + colb + bj * 128 + 4); } }
                else {
#pragma unroll
                    for (int bj = 0; bj < 2; ++bj) bw[m][bj] = *(const u32x4*)(HB + (size_t)row * D + colb + bj * 128); }
            }
            asm volatile("" ::: "memory");
#pragma unroll
            for (int m = 0; m < 4; ++m) if (m >= m0 && m < m1) {
                const int row = rowb + ai * 128 + m * 16;
                float sc = 1.f; if (!FIRST) sc = rs[ai][m] * rs[ai][m];
                float ss = 0.f;
#pragma unroll
                for (int bj = 0; bj < 2; ++bj) {
                    const int col = colb + bj * 128;
                    f32x4 b0, b1;
                    if (FIRST) { b0 = bf[m][bj][0]; b1 = bf[m][bj][1]; }
                    else { const u32x4 w = bw[m][bj]; b0 = (f32x4){bflo(w.x), bfhi(w.x), bflo(w.y), bfhi(w.y)}; b1 = (f32x4){bflo(w.z), bfhi(w.z), bflo(w.w), bfhi(w.w)}; }
                    const f32x4 v0 = acc[ai][bj][m][0] * sc + b0, v1 = acc[ai][bj][m][1] * sc + b1;
                    *(u32x4*)(HB + (size_t)row * D + col) = pk8(v0, v1);
                    ss += (v0[0] * v0[0] + v0[1] * v0[1]) + (v0[2] * v0[2] + v0[3] * v0[3]) + (v1[0] * v1[0] + v1[1] * v1[1]) + (v1[2] * v1[2] + v1[3] * v1[3]);
                }
                ss += __shfl_xor(ss, 16); ss += __shfl_xor(ss, 32);
                if (fq == 0) RSS[(size_t)row * 16 + u.pn * 4 + wc] = ss;
            }
            asm volatile("" ::: "memory");
        }
    }
};
struct EpiFF1 {
    static constexpr bool PERM = true, AFTER_DRAIN = false;
    bf16* O; const float* RSS; bool seam = false; int ai0 = 0, ai1 = 2, m0 = 0, m1 = 4;
    __device__ __forceinline__ void operator()(const f32x4 (&acc)[2][2][4][2], const Unit& u, int wr, int wc, int fr, int fq) const {
        const int rowb = u.pm * 256 + wr * 64 + fr, colb = u.pn * 256 + wc * 32 + 8 * fq;
#pragma unroll
        for (int ai = 0; ai < 2; ++ai) if (ai >= ai0 && ai < ai1)
#pragma unroll
            for (int m = 0; m < 4; ++m) if (m >= m0 && m < m1) {
                const int row = rowb + ai * 128 + m * 16;
#pragma unroll
                for (int bj = 0; bj < 2; ++bj) {
                    f32x4 v0 = acc[ai][bj][m][0], v1 = acc[ai][bj][m][1];
#pragma unroll
                    for (int i = 0; i < 4; ++i) { const float a = fmaxf(v0[i], 0.f), b = fmaxf(v1[i], 0.f); v0[i] = a * a; v1[i] = b * b; }
                    *(u32x4*)(O + (size_t)row * FF + colb + bj * 128) = pk8(v0, v1);
                }
                if (seam) asm volatile("" ::: "memory");
            }
    }
};
struct EpiGate {
    static constexpr bool PERM = true, AFTER_DRAIN = false;
    const bf16* HB; bf16* H3B; const bf16* PP; const float* RSSin; float* RSSout; bool seam = false; int ai0 = 0, ai1 = 2, m0 = 0, m1 = 4;
    __device__ __forceinline__ void operator()(const f32x4 (&acc)[2][2][4][2], const Unit& u, int wr, int wc, int fr, int fq) const {
        const int rowb = u.pm * 256 + wr * 64 + fr, colb = u.pn * 256 + wc * 32 + 8 * fq;
        float rs[2][4];
        wave_row_rs(RSSin, u.pm * 256 + wr * 64, fr + 16 * fq, fr, rs);
#pragma unroll
        for (int ai = 0; ai < 2; ++ai) if (ai >= ai0 && ai < ai1) {
            u32x4 pwv[4][2], hwv[4][2];
#pragma unroll
            for (int m = 0; m < 4; ++m) if (m >= m0 && m < m1) {
                const int row = rowb + ai * 128 + m * 16;
#pragma unroll
                for (int bj = 0; bj < 2; ++bj) { pwv[m][bj] = *(const u32x4*)(PP + (size_t)row * D + colb + bj * 128); hwv[m][bj] = *(const u32x4*)(HB + (size_t)row * D + colb + bj * 128); }
            }
            asm volatile("" ::: "memory");
#pragma unroll
            for (int m = 0; m < 4; ++m) if (m >= m0 && m < m1) {
                const int row = rowb + ai * 128 + m * 16; const float r1 = rs[ai][m];
                float ss = 0.f;
#pragma unroll
                for (int bj = 0; bj < 2; ++bj) {
                    const int col = colb + bj * 128;
                    const u32x4 pw = pwv[m][bj], hw = hwv[m][bj];
                    const f32x4 p0 = {bflo(pw.x), bfhi(pw.x), bflo(pw.y), bfhi(pw.y)}, p1 = {bflo(pw.z), bfhi(pw.z), bflo(pw.w), bfhi(pw.w)};
                    f32x4 v0 = {bflo(hw.x), bfhi(hw.x), bflo(hw.y), bfhi(hw.y)}, v1 = {bflo(hw.z), bfhi(hw.z), bflo(hw.w), bfhi(hw.w)};
#pragma unroll
                    for (int i = 0; i < 4; ++i) { v0[i] += sigmoidf_(acc[ai][bj][m][0][i] * r1) * p0[i]; v1[i] += sigmoidf_(acc[ai][bj][m][1][i] * r1) * p1[i]; }
                    *(u32x4*)(H3B + (size_t)row * D + col) = pk8(v0, v1);
                    ss += (v0[0] * v0[0] + v0[1] * v0[1]) + (v0[2] * v0[2] + v0[3] * v0[3]) + (v1[0] * v1[0] + v1[1] * v1[1]) + (v1[2] * v1[2] + v1[3] * v1[3]);
                }
                ss += __shfl_xor(ss, 16); ss += __shfl_xor(ss, 32);
                if (fq == 0) RSSout[(size_t)row * 16 + u.pn * 4 + wc] = ss;
            }
            asm volatile("" ::: "memory");
        }
    }
};
template <bool MAP>
__device__ __forceinline__ void p0_transpose_item(const float* W, int K, int N, const float* gk, bf16* WT, LAS float* scr, int item, int lane) {
    const int nblk = N / 32, kb = item / nblk, nb = item % nblk, k0 = 64 * kb, n0 = 32 * nb;
#pragma unroll
    for (int i = 0; i < 32; ++i) { const int kk = 2 * i + (lane >> 5); float v = W[(size_t)(k0 + kk) * N + n0 + (lane & 31)]; if (gk) v *= gk[k0 + kk]; scr[kk * 33 + (lane & 31)] = v; }
    LDS_WAIT(); asm volatile("" ::: "memory");
    const int c = lane & 7, nd0 = MAP ? win_dest(n0) : n0;
#pragma unroll
    for (int j = 0; j < 4; ++j) { const int n = (lane >> 3) + 8 * j; const LAS float* s = scr + (8 * c) * 33 + n;
        u32x4 o; o.x = pk2(s[0 * 33], s[1 * 33]); o.y = pk2(s[2 * 33], s[3 * 33]); o.z = pk2(s[4 * 33], s[5 * 33]); o.w = pk2(s[6 * 33], s[7 * 33]);
        *(u32x4*)(WT + (size_t)(nd0 + n) * K + k0 + 8 * c) = o; }
    LDS_WAIT(); asm volatile("" ::: "memory");
}
__device__ __forceinline__ void p0_prologue(const Params& p, LAS unsigned char* lds, int G, int tid, int wid, int lane) {
    unsigned char* ws = p.ws;
    LAS float* scr = (LAS float*)(lds + wid * 16384);
    const int gw = blockIdx.x * NWAVES + wid, NGW = G * NWAVES;
    constexpr int I_IN = (D / 64) * (NIN / 32), I_O = (D / 64) * (D / 32), I_P = (DPLE / 64) * (D / 32);
    constexpr int NITEMS = I_IN + I_P;
    for (int it = gw; it < NITEMS; it += NGW) {
        int r = it;
        if (r < I_IN) { p0_transpose_item<true>(p.in[8], D, NIN, nullptr, (bf16*)(ws + WS_WIN), scr, r, lane); continue; } r -= I_IN;
        p0_transpose_item<false>(p.in[20], DPLE, D, nullptr, (bf16*)(ws + WS_WP), scr, r, lane);
    }
    const f32x4* g4 = (const f32x4*)p.in[7] + lane;
    bf16* A1 = (bf16*)(ws + WS_A1); bf16* PB = (bf16*)(ws + WS_PB);
    for (int row = gw * 4; row < MT; row += NGW * 4) {
        f32x4 v[4][4]; f32x4 pv[4]; float s[4];
#pragma unroll
        for (int k = 0; k < 4; ++k) {
            const int rr = row + k;
            const float* xr = (rr < MP) ? p.in[0] + (size_t)rr * D : p.in[1] + (size_t)(rr - MP) * D;
            const f32x4* x4 = (const f32x4*)xr + lane;
#pragma unroll
            for (int j = 0; j < 4; ++j) v[k][j] = x4[64 * j];
            const float* pr = (rr < MP) ? p.in[2] + (size_t)rr * DPLE : p.in[3] + (size_t)(rr - MP) * DPLE;
            pv[k] = ((const f32x4*)pr)[lane];
        }
#pragma unroll
        for (int k = 0; k < 4; ++k) {
            s[k] = 0.f;
#pragma unroll
            for (int j = 0; j < 4; ++j) s[k] += (v[k][j][0] * v[k][j][0] + v[k][j][1] * v[k][j][1]) + (v[k][j][2] * v[k][j][2] + v[k][j][3] * v[k][j][3]);
            const float rs = __builtin_amdgcn_rsqf(wave_sum(s[k]) * (1.0f / D) + EPS);
            u32x2* o = (u32x2*)(A1 + (size_t)(row + k) * D) + lane;
#pragma unroll
            for (int j = 0; j < 4; ++j) { const f32x4 g = g4[64 * j]; u32x2 w; w.x = pk2(v[k][j][0] * rs * g[0], v[k][j][1] * rs * g[1]); w.y = pk2(v[k][j][2] * rs * g[2], v[k][j][3] * rs * g[3]); o[64 * j] = w; }
            u32x2 w; w.x = pk2(pv[k][0], pv[k][1]); w.y = pk2(pv[k][2], pv[k][3]); ((u32x2*)(PB + (size_t)(row + k) * DPLE))[lane] = w;
        }
    }
    float* rope = (float*)(ws + WS_ROPE);
    for (int idx = blockIdx.x * NTHREADS + tid; idx < SEQ * 32; idx += G * NTHREADS) {
        const int pos = idx >> 5, d = idx & 31;
        const float inv = (float)(1.0 / exp2((double)d * (13.287712379549449 / 32.0)));
        const float ang = (float)pos * inv;
        const double a = (double)ang, k = rint(a * 0.15915494309189535);
        const double r = fma(-k, 1.2246467991473532e-16 * 2.0, fma(-k, 6.283185307179586, a));
        const float rf = (float)r;
        ((pg8::f32x2*)rope)[idx] = (pg8::f32x2){cosf(rf), sinf(rf)};
    }
}

__device__ __forceinline__ void shadow_transpose(const float* W, int K, int N, const float* gk, bf16* WT, LAS unsigned char* lds, int cu, int ncu) {
    int t = threadIdx.x; asm volatile("" : "+v"(t));
    const int lane = t & 63, wid = __builtin_amdgcn_readfirstlane(t >> 6);
    LAS float* scr = (LAS float*)(lds + wid * 16384);
    const int nitems = (K / 64) * (N / 32);
    for (int it = cu * NWAVES + wid; it < nitems; it += ncu * NWAVES) p0_transpose_item<false>(W, K, N, gk, WT, scr, it, lane);
}

constexpr int N_ATT_P = 2 * 256 * 2, N_ATT = N_ATT_P + 16, N_CONV_P = MP / 64, N_CONV = N_CONV_P + 4;
constexpr int DCP = 516;
static_assert(64 * DCP * 4 <= MISC_OFF, "conv tile fits under the barrier words");
__device__ __forceinline__ void conv_item(const Params& p, LAS unsigned char* lds, int item, int tid, int wid, int lane) {
    typedef pg8::f32x2 f2;
    const bf16* U = (const bf16*)(p.ws + WS_U); bf16* MIX = (bf16*)(p.ws + WS_MIX);
    LAS float* DC = (LAS float*)lds;
    const int half = wid >> 2, c2 = 2 * (tid & 255);
    const bool sample = item >= N_CONV_P;
    const int row0 = item * 64, rowh = row0 + 32 * half;
    f2 win[62];
    if (!sample) {
        const int t0 = rowh & (SEQ - 1);
#pragma unroll
        for (int k = 0; k < 62; ++k) {
            const int tk = t0 - 30 + k;
            unsigned w = *(const unsigned*)(U + (size_t)(rowh - 30 + k - (tk < 0 ? tk : 0)) * CC + c2);
            if (tk < 0) w = 0u;
            win[k] = (f2){bflo(w), bfhi(w)};
        }
    } else {
        const float* sc = p.in[6] + (size_t)((item - N_CONV_P) * 2 + half) * 30 * CC + c2;
#pragma unroll
        for (int k = 0; k < 30; ++k) win[k] = *(const f2*)(sc + (size_t)k * CC);
#pragma unroll
        for (int k = 30; k < 62; ++k) { const unsigned w = *(const unsigned*)(U + (size_t)(rowh - 30 + k) * CC + c2); win[k] = (f2){bflo(w), bfhi(w)}; }
    }
    f2 w[31];
#pragma unroll
    for (int j = 0; j < 31; ++j) w[j] = *(const f2*)(p.in[9] + j * CC + c2);
    const f2 bias = *(const f2*)(p.in[10] + c2);
#pragma unroll
    for (int r = 0; r < 32; ++r) {
        f2 a = bias;
#pragma unroll
        for (int j = 0; j < 31; ++j) a = w[j] * win[r + j] + a;
        *(LAS f2*)(DC + (32 * half + r) * DCP + c2) = a;
    }
    __syncthreads();
    const int c8 = lane * 8;
    const f32x4 g0 = *(const f32x4*)(p.in[11] + c8), g1 = *(const f32x4*)(p.in[11] + c8 + 4), b0 = *(const f32x4*)(p.in[12] + c8), b1 = *(const f32x4*)(p.in[12] + c8 + 4);
#pragma unroll
    for (int rr = 0; rr < 8; ++rr) {
        const int r = 8 * wid + rr;
        f32x4 x0 = *(const LAS f32x4*)(DC + r * DCP + c8), x1 = *(const LAS f32x4*)(DC + r * DCP + c8 + 4);
        const float mean = wave_sum((x0[0] + x0[1]) + (x0[2] + x0[3]) + (x1[0] + x1[1]) + (x1[2] + x1[3])) * (1.0f / CC);
        x0 = x0 - mean; x1 = x1 - mean;
        const float var = wave_sum((x0[0] * x0[0] + x0[1] * x0[1]) + (x0[2] * x0[2] + x0[3] * x0[3]) + (x1[0] * x1[0] + x1[1] * x1[1]) + (x1[2] * x1[2] + x1[3] * x1[3])) * (1.0f / CC);
        const float rstd = __builtin_amdgcn_rsqf(var + EPS);
        f32x4 y0 = x0 * rstd * g0 + b0, y1 = x1 * rstd * g1 + b1;
#pragma unroll
        for (int i = 0; i < 4; ++i) { y0[i] *= sigmoidf_(y0[i]); y1[i] *= sigmoidf_(y1[i]); }
        *(u32x4*)(MIX + (size_t)(row0 + r) * D + c8) = pk8(y0, y1);
    }
    __syncthreads();
}

constexpr int KSP = 144, VTP = 408, VT_OFF = 192 * KSP;
#define MFMA32(a, b, c) __builtin_amdgcn_mfma_f32_32x32x16_bf16((a), (b), (c), 0, 0, 0)
__device__ __forceinline__ void attn_item(const Params& p, LAS unsigned char* lds, int item, int tid, int wid, int lane) {
    const bf16* Q = (const bf16*)(p.ws + WS_Q); const bf16* KB = (const bf16*)(p.ws + WS_KB); const bf16* VB = (const bf16*)(p.ws + WS_VB); bf16* MIX = (bf16*)(p.ws + WS_MIX);
    const bool sample = item >= N_ATT_P;
    int b, n, kvh, kt0, kt1;
    if (!sample) { b = item >> 9; n = (item >> 1) & 255; kvh = item & 1; kt0 = (n >= 2) ? 0 : (n == 1 ? 2 : 4); kt1 = 6; }
    else { const int s = item - N_ATT_P; b = s >> 1; n = 0; kvh = s & 1; kt0 = 0; kt1 = 5; }
    const int keyrow0 = b * SEQ + (n - 2) * 64;
    if (!sample) {
        u32x4 kv[3], vv[3];
#pragma unroll
        for (int i = 0; i < 3; ++i) {
            const int id = tid + NTHREADS * i, j = id >> 3, c = id & 7, jc = j < 32 * kt0 ? 32 * kt0 : j;
            const size_t grow = (size_t)(keyrow0 + jc);
            kv[i] = *(const u32x4*)(KB + grow * KVC + kvh * 64 + c * 8); vv[i] = *(const u32x4*)(VB + grow * KVC + kvh * 64 + c * 8);
        }
#pragma unroll
        for (int i = 0; i < 3; ++i) {
            const int id = tid + NTHREADS * i, j = id >> 3, c = id & 7;
            if (j >= 32 * kt0) {
                *(LAS u32x4*)(lds + j * KSP + c * 16) = kv[i];
                LAS unsigned short* vt = (LAS unsigned short*)(lds + VT_OFF + (8 * c) * VTP) + j;
                vt[0 * (VTP / 2)] = (unsigned short)(vv[i].x & 0xffffu); vt[1 * (VTP / 2)] = (unsigned short)(vv[i].x >> 16);
                vt[2 * (VTP / 2)] = (unsigned short)(vv[i].y & 0xffffu); vt[3 * (VTP / 2)] = (unsigned short)(vv[i].y >> 16);
                vt[4 * (VTP / 2)] = (unsigned short)(vv[i].z & 0xffffu); vt[5 * (VTP / 2)] = (unsigned short)(vv[i].z >> 16);
                vt[6 * (VTP / 2)] = (unsigned short)(vv[i].w & 0xffffu); vt[7 * (VTP / 2)] = (unsigned short)(vv[i].w >> 16);
            }
        }
    } else {
#pragma unroll
    for (int i = 0; i < 3; ++i) {
        const int id = tid + NTHREADS * i, j = id >> 3, c = id & 7;
        if (j >= 32 * kt0 && j < 32 * kt1) {
            u32x4 kv, vv;
            if (!sample || j >= 128) {
                const size_t grow = sample ? (size_t)(MP + b * 32 + (j - 128)) : (size_t)(keyrow0 + j);
                kv = *(const u32x4*)(KB + grow * KVC + kvh * 64 + c * 8); vv = *(const u32x4*)(VB + grow * KVC + kvh * 64 + c * 8);
            } else {
                const size_t off = ((size_t)(b * 128 + j) * 2 + kvh) * 64 + c * 8;
                const f32x4 k0 = *(const f32x4*)(p.in[4] + off), k1 = *(const f32x4*)(p.in[4] + off + 4), v0 = *(const f32x4*)(p.in[5] + off), v1 = *(const f32x4*)(p.in[5] + off + 4);
                kv = pk8(k0, k1); vv = pk8(v0, v1);
            }
            *(LAS u32x4*)(lds + j * KSP + c * 16) = kv;
            LAS unsigned short* vt = (LAS unsigned short*)(lds + VT_OFF + (8 * c) * VTP) + j;
            vt[0 * (VTP / 2)] = (unsigned short)(vv.x & 0xffffu); vt[1 * (VTP / 2)] = (unsigned short)(vv.x >> 16);
            vt[2 * (VTP / 2)] = (unsigned short)(vv.y & 0xffffu); vt[3 * (VTP / 2)] = (unsigned short)(vv.y >> 16);
            vt[4 * (VTP / 2)] = (unsigned short)(vv.z & 0xffffu); vt[5 * (VTP / 2)] = (unsigned short)(vv.z >> 16);
            vt[6 * (VTP / 2)] = (unsigned short)(vv.w & 0xffffu); vt[7 * (VTP / 2)] = (unsigned short)(vv.w >> 16);
        }
    }
    }
    __syncthreads();
    const int g = wid >> 1, qh = wid & 1, head = kvh * 4 + g, q = lane & 31, h = lane >> 5;
    if (!sample || qh == 0) {
        const size_t qrow = sample ? (size_t)(MP + b * 32 + q) : (size_t)(b * SEQ + n * 64 + qh * 32 + q);
        bf16x8 bq[4];
#pragma unroll
        for (int ks = 0; ks < 4; ++ks) bq[ks] = *(const bf16x8*)(Q + qrow * QC + head * 64 + ks * 16 + 8 * h);
        f32x16 st[6];
#pragma unroll
        for (int kt = 0; kt < 6; ++kt) {
#pragma unroll
            for (int r = 0; r < 16; ++r) st[kt][r] = 0.f;
            if (kt >= kt0 && kt < kt1) {
#pragma unroll
                for (int ks = 0; ks < 4; ++ks) { const bf16x8 a = *(const LAS bf16x8*)(lds + (32 * kt + q) * KSP + (16 * ks + 8 * h) * 2); st[kt] = MFMA32(a, bq[ks], st[kt]); }
            }
        }
        const float sk = p.in[13][head];
        float mx = sk;
#pragma unroll
        for (int kt = 0; kt < 6; ++kt) if (kt >= kt0 && kt < kt1) {
#pragma unroll
            for (int r = 0; r < 16; ++r) mx = fmaxf(mx, st[kt][r] * 0.125f);
        }
        mx = fmaxf(mx, __shfl_xor(mx, 32));
        float sum = 0.f;
#pragma unroll
        for (int kt = 0; kt < 6; ++kt) if (kt >= kt0 && kt < kt1) {
#pragma unroll
            for (int r = 0; r < 16; ++r) { const float e = __expf(st[kt][r] * 0.125f - mx); st[kt][r] = e; sum += e; }
        }
        sum += __shfl_xor(sum, 32); sum += __expf(sk - mx);
        f32x16 o[2];
#pragma unroll
        for (int r = 0; r < 16; ++r) { o[0][r] = 0.f; o[1][r] = 0.f; }
#pragma unroll
        for (int kt = 0; kt < 6; ++kt) if (kt >= kt0 && kt < kt1) {
#pragma unroll
            for (int s = 0; s < 2; ++s) {
                u32x4 pw; pw.x = pk2(st[kt][8 * s + 0], st[kt][8 * s + 1]); pw.y = pk2(st[kt][8 * s + 2], st[kt][8 * s + 3]); pw.z = pk2(st[kt][8 * s + 4], st[kt][8 * s + 5]); pw.w = pk2(st[kt][8 * s + 6], st[kt][8 * s + 7]);
                const bf16x8 pb = __builtin_bit_cast(bf16x8, pw);
#pragma unroll
                for (int dt = 0; dt < 2; ++dt) {
                    const LAS unsigned char* vp = lds + VT_OFF + (32 * dt + q) * VTP + (32 * kt + 16 * s + 4 * h) * 2;
                    const u32x2 lo = *(const LAS u32x2*)vp, hi = *(const LAS u32x2*)(vp + 16);
                    const u32x4 aw = {lo.x, lo.y, hi.x, hi.y};
                    o[dt] = MFMA32(__builtin_bit_cast(bf16x8, aw), pb, o[dt]);
                }
            }
        }
        const float inv = 1.0f / sum;
        bf16* op = MIX + qrow * D + CC + head * 64 + 4 * h;
#pragma unroll
        for (int dt = 0; dt < 2; ++dt)
#pragma unroll
            for (int gq = 0; gq < 4; ++gq) { u32x2 w; w.x = pk2(o[dt][4 * gq + 0] * inv, o[dt][4 * gq + 1] * inv); w.y = pk2(o[dt][4 * gq + 2] * inv, o[dt][4 * gq + 3] * inv); *(u32x2*)(op + 32 * dt + 8 * gq) = w; }
    }
    __syncthreads();
}

#define XB_TMO      128
#define XB_XCNT(j)  (256  + 64 * (j))
#define XB_XSUB(j)  (1280 + 64 * (j))
#define XB_XGEN(j)  (2304 + 64 * (j))
#define XB_TOP      3328
#define XB_TOPGEN   3392
#define XCD_BAR_WORDS 3456
#define XB_SPIN_CAP (1u << 18)

__device__ __forceinline__ unsigned xb_ld(unsigned* p)              { return __hip_atomic_load(p, __ATOMIC_RELAXED, __HIP_MEMORY_SCOPE_AGENT); }
__device__ __forceinline__ unsigned xb_add(unsigned* p, unsigned v) { return __hip_atomic_fetch_add(p, v, __ATOMIC_RELAXED, __HIP_MEMORY_SCOPE_AGENT); }
__device__ __forceinline__ unsigned xb_xcc_id() { return (unsigned)__builtin_amdgcn_s_getreg((3 << 11) | 20) & 0xFu; }
#define XB_SPIN(cond, bar) do { unsigned _sp = 0; while (cond) { __builtin_amdgcn_s_sleep(1); \
    if ((++_sp & 255u) == 0u) { if (xb_ld(&(bar)[XB_TMO])) break; if (_sp > XB_SPIN_CAP) { atomicAdd(&(bar)[XB_TMO], 1u); break; } } } } while (0)

struct XcdBarrier {
    unsigned* bar; unsigned x;
    volatile LAS unsigned* st;
};

__device__ __forceinline__ XcdBarrier xcd_barrier_post(unsigned* bar, volatile LAS unsigned* st) {
    XcdBarrier b; b.bar = bar; b.x = xb_xcc_id(); b.st = st;
    if (threadIdx.x == 0) (void)xb_add(&bar[XB_XCNT(b.x)], 1u);
    return b;
}
__device__ __forceinline__ void xcd_barrier_complete(unsigned* bar, unsigned x, unsigned& nloc, unsigned& nx) {
    const unsigned G = gridDim.x * gridDim.y * gridDim.z;
    unsigned sum, cnt, mine, sp = 0u;
    for (;;) {
        sum = 0u; cnt = 0u; mine = 0u;
#pragma unroll
        for (unsigned j = 0; j < 16; ++j) { const unsigned c = xb_ld(&bar[XB_XCNT(j)]); sum += c; cnt += (c > 0u) ? 1u : 0u; mine = (j == x) ? c : mine; }
        if (sum == G) break;
        __builtin_amdgcn_s_sleep(1);
        if ((++sp & 255u) == 0u) { if (xb_ld(&bar[XB_TMO])) break; if (sp > XB_SPIN_CAP) { atomicAdd(&bar[XB_TMO], 1u); break; } }
    }
    nloc = mine > 0u ? mine : 1u; nx = cnt > 0u ? cnt : 1u;
}

__device__ __forceinline__ void xcd_barrier(const XcdBarrier& b) {
    asm volatile("s_waitcnt vmcnt(0)" ::: "memory");
    __syncthreads();
    if (threadIdx.x == 0) {
        unsigned* bar = b.bar;
        __builtin_amdgcn_s_waitcnt(0);
        unsigned nloc = b.st[0], nx = b.st[1];
        if (nloc == 0u) { xcd_barrier_complete(bar, b.x, nloc, nx); b.st[0] = nloc; b.st[1] = nx; }
        const unsigned old = xb_add(&bar[XB_XSUB(b.x)], 1u);
        const unsigned gen = old / nloc;
        if (old + 1u == (gen + 1u) * nloc) {
            __builtin_amdgcn_fence(__ATOMIC_RELEASE, "agent");
            asm volatile("s_waitcnt vmcnt(0)" ::: "memory");
            const unsigned og = xb_add(&bar[XB_TOP], 1u);
            const unsigned tg = og / nx;
            if (og + 1u == (tg + 1u) * nx) xb_add(&bar[XB_TOPGEN], 1u);
            else XB_SPIN(xb_ld(&bar[XB_TOPGEN]) == tg, bar);
            __builtin_amdgcn_fence(__ATOMIC_ACQUIRE, "agent");
            xb_add(&bar[XB_XGEN(b.x)], 1u);
            asm volatile("s_waitcnt vmcnt(0)" ::: "memory");
        } else {
            XB_SPIN(xb_ld(&bar[XB_XGEN(b.x)]) == gen, bar);
            __builtin_amdgcn_fence(__ATOMIC_ACQUIRE, "agent");
            asm volatile("s_waitcnt vmcnt(0)" ::: "memory");
        }
    }
    __syncthreads();
}


template <int NS, class Epi>
__device__ __forceinline__ void sample_fixup(const float* part, int ldn, int item, const Epi& E, unsigned* cnt) {
    int tid_ = threadIdx.x; asm volatile("" : "+v"(tid_));
    const int lane = tid_ & 63, wid = __builtin_amdgcn_readfirstlane(tid_ >> 6), wr = wid >> 2, wc = wid & 3, fr = lane & 15, fq = lane >> 4;
    const int pn = item >> 3, ah = (item >> 2) & 1, mh = item & 3;
    const size_t slice = (size_t)256 * ldn;
    const float* q = part + (size_t)(ah * 128 + wr * 64 + mh * 16 + fr) * ldn + pn * 256 + wc * 32 + 8 * fq;
    f32x4 s0 = {0.f, 0.f, 0.f, 0.f}, s1 = s0, s2 = s0, s3 = s0;
#pragma unroll
    for (int k4 = 0; k4 < NS; k4 += 4) {
        f32x4 l[4][4];
#pragma unroll
        for (int ks = 0; ks < 4; ++ks) { l[ks][0] = *(const f32x4*)(q); l[ks][1] = *(const f32x4*)(q + 4); l[ks][2] = *(const f32x4*)(q + 128); l[ks][3] = *(const f32x4*)(q + 132); q += slice; }
        s0 += (l[0][0] + l[1][0]) + (l[2][0] + l[3][0]); s1 += (l[0][1] + l[1][1]) + (l[2][1] + l[3][1]); s2 += (l[0][2] + l[1][2]) + (l[2][2] + l[3][2]); s3 += (l[0][3] + l[1][3]) + (l[2][3] + l[3][3]);
    }
    Unit u; u.pm = MP / 256; u.pn = pn; u.k0 = 0; u.nt = 0; u.split = 0;
#pragma unroll
    for (int a = 0; a < 2; ++a)
#pragma unroll
        for (int m = 0; m < 4; ++m)
            if (a == ah && m == mh) {
                f32x4 acc[2][2][4][2];
#pragma unroll
                for (int x = 0; x < 2; ++x)
#pragma unroll
                    for (int b = 0; b < 2; ++b)
#pragma unroll
                        for (int y = 0; y < 4; ++y) { acc[x][b][y][0] = (f32x4){0.f, 0.f, 0.f, 0.f}; acc[x][b][y][1] = (f32x4){0.f, 0.f, 0.f, 0.f}; }
                acc[a][0][m][0] = s0; acc[a][0][m][1] = s1; acc[a][1][m][0] = s2; acc[a][1][m][1] = s3;
                Epi Eh = E; Eh.ai0 = a; Eh.ai1 = a + 1; Eh.m0 = m; Eh.m1 = m + 1;
                Eh(acc, u, wr, wc, fr, fq);
            }
    if (cnt) {
        asm volatile("s_waitcnt vmcnt(0)" ::: "memory");
        __syncthreads();
        if (wid == 0) {
            __builtin_amdgcn_fence(__ATOMIC_RELEASE, "agent");
            asm volatile("s_waitcnt vmcnt(0)" ::: "memory");
            if (lane == 0) (void)__hip_atomic_fetch_add(cnt, 1u, __ATOMIC_RELAXED, __HIP_MEMORY_SCOPE_AGENT);
        }
    }
}

__device__ __forceinline__ void p7_rows(float* out, const bf16* H3B, const float* RSS3, const float* gfin, int row0, int row_end, int step) {
    int t7 = threadIdx.x; asm volatile("" : "+v"(t7));
    const int lane = t7 & 63, wid = __builtin_amdgcn_readfirstlane(t7 >> 6);
    const f32x4* g4 = (const f32x4*)gfin + 2 * lane;
    const f32x4 ga = g4[0], gb = g4[1], gc = g4[128], gd = g4[129];
    for (int row = row0 + wid * 2; row < row_end; row += step) {
        float part[2]; u32x4 w[2][2];
#pragma unroll
        for (int k = 0; k < 2; ++k) {
            part[k] = RSS3[(size_t)(row + k) * 16 + (lane & 15)]; if (lane >= 16) part[k] = 0.f;
            const u32x4* hp = (const u32x4*)(H3B + (size_t)(row + k) * D) + lane;
            w[k][0] = hp[0]; w[k][1] = hp[64];
        }
#pragma unroll
        for (int k = 0; k < 2; ++k) {
            const float rs = __builtin_amdgcn_rsqf(wave_sum(part[k]) * (1.0f / D) + EPS);
            f32x4* o = (f32x4*)(out + (size_t)(row + k) * D) + 2 * lane;
            const u32x4 a = w[k][0], b = w[k][1];
            o[0] = (f32x4){bflo(a.x), bfhi(a.x), bflo(a.y), bfhi(a.y)} * rs * ga; o[1] = (f32x4){bflo(a.z), bfhi(a.z), bflo(a.w), bfhi(a.w)} * rs * gb;
            o[128] = (f32x4){bflo(b.x), bfhi(b.x), bflo(b.y), bfhi(b.y)} * rs * gc; o[129] = (f32x4){bflo(b.z), bfhi(b.z), bflo(b.w), bfhi(b.w)} * rs * gd;
        }
    }
}

__global__ void __launch_bounds__(NTHREADS, 2) fwd_megakernel(Params p) {
    extern __shared__ __attribute__((aligned(16))) unsigned char lds_raw[];
    LAS unsigned char* lds = (LAS unsigned char*)lds_raw;
    cg::grid_group grid = cg::this_grid();
    const int tid = threadIdx.x, lane = tid & 63, wid = __builtin_amdgcn_readfirstlane(tid >> 6), G = gridDim.x, bx = blockIdx.x;
    unsigned char* ws = p.ws;
    bf16* A1 = (bf16*)(ws + WS_A1); bf16* HB = (bf16*)(ws + WS_HB); bf16* PB = (bf16*)(ws + WS_PB); bf16* PP = (bf16*)(ws + WS_PP); bf16* HID = (bf16*)(ws + WS_HID); bf16* MIX = (bf16*)(ws + WS_MIX); bf16* H3B = (bf16*)(ws + WS_A1);
    unsigned* ctl = (unsigned*)(ws + WS_CTL);
    float* RSS1 = (float*)(ws + WS_RSS1); float* RSS2 = (float*)(ws + WS_RSS2); float* RSS3 = (float*)(ws + WS_RSS3);

    volatile LAS unsigned* MISC = (volatile LAS unsigned*)(lds + MISC_OFF);
    if (tid < 64) MISC[tid] = 0u;
    __syncthreads();
    XcdBarrier bar = xcd_barrier_post((unsigned*)(ws + WS_CTL), MISC + 8);
    p0_prologue(p, lds, G, tid, wid, lane);
    if (p.ws == nullptr) grid.sync();
    xcd_barrier(bar);
    {
        pg8::Gemm g{A1, (const bf16*)(ws + WS_WIN), MT, NIN, D}; pg8::StaticOrder S; S.init(MT, NIN, D, G, bx);
        EpiIn E{(bf16*)(ws + WS_U), (bf16*)(ws + WS_Q), (bf16*)(ws + WS_KB), (bf16*)(ws + WS_VB), (const float*)(ws + WS_ROPE), p.out};
        pg8::gemm_phase<EpiIn, pg8::StaticOrder, true, true>(lds, g, S, E);
        pg8::Gemm g2{PB, (const bf16*)(ws + WS_WP), MT, D, DPLE}; pg8::StaticOrder S2; S2.init(MT, D, DPLE, G, G - 1 - bx);
        EpiPlain E2{PP, D};
        pg8::gemm_phase<EpiPlain, pg8::StaticOrder, true, true>(lds, g2, S2, E2);
    }
    xcd_barrier(bar);
    const int vb = (G % 8 == 0) ? (bx % 8) * (G / 8) + bx / 8 : bx;
    for (int it = vb; it < N_ATT; it += G) { if (G == 256 && vb >= G - 4 && it == vb + 3 * G) continue; attn_item(p, lds, it, tid, wid, lane); }
    if (G == 256 && vb >= 16 && vb < 20) attn_item(p, lds, (G - 4 + (vb - 16)) + 3 * G, tid, wid, lane);
    for (int it = G - 1 - vb; it < N_CONV; it += G) conv_item(p, lds, it, tid, wid, lane);
    if (G == 256 && vb >= 20 && vb < G - 4) shadow_transpose(p.in[14], D, D, nullptr, (bf16*)(ws + WS_WOUT), lds, vb - 20, G - 24);
    else if (G != 256) shadow_transpose(p.in[14], D, D, nullptr, (bf16*)(ws + WS_WOUT), lds, bx, G);
    xcd_barrier(bar);
    float* PARTA = (float*)(ws + WS_PART); float* PARTB = (float*)(ws + WS_PARTB);
    unsigned* cnt3 = ctl + CW_SPLIT; unsigned* cnt4 = ctl + CW_SPLIT + 64; unsigned* cnt5 = ctl + CW_SPLIT + 128;
    {
        pg8::Gemm g{MIX, (const bf16*)(ws + WS_WOUT), MT, D, D}; pg8::SplitOrder S; S.init(MP, D, D, 256, G, bx, nullptr, 0u);
        EpiRes<true> E{p.in[0], p.in[1], HB, RSS1};
        pg8::gemm_phase<EpiRes<true>, pg8::SplitOrder, true, true>(lds, g, S, E, pg8::SplitCtx{PARTA, D});
        if (bx >= 16) shadow_transpose(p.in[16], D, FF, p.in[15], (bf16*)(ws + WS_W1), lds, bx - 16, G - 16);
    }
    xcd_barrier(bar);
    {
        if (bx >= G - 32) { EpiRes<true> Ef{p.in[0], p.in[1], HB, RSS1}; sample_fixup<4>(PARTA, D, G - 1 - bx, Ef, cnt3); }
        pg8::Gemm g{HB, (const bf16*)(ws + WS_W1), MT, FF, D}; pg8::SplitOrder S; S.init(MP, FF, D, 256, G, bx, cnt3, 32u);
        EpiFF1 E{HID, RSS1};
        pg8::gemm_phase<EpiFF1, pg8::SplitOrder, true, true>(lds, g, S, E, pg8::SplitCtx{PARTB, FF});
        if (bx >= 64) shadow_transpose(p.in[17], FF, D, nullptr, (bf16*)(ws + WS_W2), lds, bx - 64, G - 64);
    }
    xcd_barrier(bar);
    {
        if (bx >= G - 128) { EpiFF1 Ef{HID, RSS1}; sample_fixup<4>(PARTB, FF, G - 1 - bx, Ef, cnt4); }
        pg8::Gemm g{HID, (const bf16*)(ws + WS_W2), MT, D, FF}; pg8::SplitOrder S; S.init(MP, D, FF, 512, G, bx, cnt4, 128u);
        EpiRes<false> E{nullptr, nullptr, HB, RSS2, RSS1};
        pg8::gemm_phase<EpiRes<false>, pg8::SplitOrder, true, true>(lds, g, S, E, pg8::SplitCtx{PARTA, D});
        if (bx >= 32) shadow_transpose(p.in[19], D, D, p.in[18], (bf16*)(ws + WS_WG), lds, bx - 32, G - 32);
    }
    xcd_barrier(bar);
    {
        if (bx >= G - 32) { EpiRes<false> Ef{nullptr, nullptr, HB, RSS2, RSS1}; sample_fixup<8>(PARTA, D, G - 1 - bx, Ef, cnt5); }
        pg8::Gemm g{HB, (const bf16*)(ws + WS_WG), MT, D, D}; pg8::SplitOrder S; S.init(MP, D, D, 256, G, bx, cnt5, 32u);
        EpiGate E{HB, H3B, PP, RSS2, RSS3};
        pg8::gemm_phase<EpiGate, pg8::SplitOrder, true, true>(lds, g, S, E, pg8::SplitCtx{PARTB, D});
    }
    xcd_barrier(bar);
    if (G != 256) {
        if (bx >= G - 32) { EpiGate Ef{HB, H3B, PP, RSS2, RSS3}; sample_fixup<4>(PARTB, D, G - 1 - bx, Ef, nullptr); }
        p7_rows(p.out, H3B, RSS3, p.in[21], bx * NWAVES * 2, MP, G * NWAVES * 2);
        xcd_barrier(bar);
        p7_rows(p.out, H3B, RSS3, p.in[21], MP + bx * NWAVES * 2, MT, G * NWAVES * 2);
    } else if (bx >= G - 32) {
        const int f = bx - (G - 32);
        { EpiGate Ef{HB, H3B, PP, RSS2, RSS3}; sample_fixup<4>(PARTB, D, G - 1 - bx, Ef, nullptr); }
        unsigned* cnt6 = ctl + CW_SPLIT + 192;
        asm volatile("s_waitcnt vmcnt(0)" ::: "memory");
        __syncthreads();
        if (tid < 64) {
            __builtin_amdgcn_fence(__ATOMIC_RELEASE, "agent");
            asm volatile("s_waitcnt vmcnt(0)" ::: "memory");
            if (lane == 0) (void)__hip_atomic_fetch_add(cnt6, 1u, __ATOMIC_RELAXED, __HIP_MEMORY_SCOPE_AGENT);
            unsigned polls = 0;
            while ((unsigned)__builtin_amdgcn_readfirstlane((int)__hip_atomic_load(cnt6, __ATOMIC_RELAXED, __HIP_MEMORY_SCOPE_AGENT)) < 32u) { __builtin_amdgcn_s_sleep(2); if (++polls > (1u << 22)) break; }
            __builtin_amdgcn_fence(__ATOMIC_ACQUIRE, "agent");
            asm volatile("s_waitcnt vmcnt(0)" ::: "memory");
        }
        __syncthreads();
        p7_rows(p.out, H3B, RSS3, p.in[21], MP + f * 8, MP + f * 8 + 8, 16);
        p7_rows(p.out, H3B, RSS3, p.in[21], (1792 + f) * 16, 1952 * 16, 32 * 16);
    } else {
        p7_rows(p.out, H3B, RSS3, p.in[21], bx * 16, 1792 * 16, 224 * 16);
        if (bx < 96) p7_rows(p.out, H3B, RSS3, p.in[21], (1952 + bx) * 16, (1952 + bx) * 16 + 16, 16);
    }
}

extern "C" void kernel_launch(void* const* d_in, const int* in_sizes, int n_in, void* d_out, int out_size, void* d_ws, size_t ws_size, hipStream_t stream) {
    static int grid_blocks = 0;
    if (grid_blocks == 0) {
        if (n_in != 22 || ws_size < WS_END) { fprintf(stderr, "kernel_launch: unexpected n_in %d / ws_size %zu\n", n_in, ws_size); grid_blocks = -1; return; }
        int dev = 0, cus = 0, per_cu = 0;
        (void)hipGetDevice(&dev);
        (void)hipDeviceGetAttribute(&cus, hipDeviceAttributeMultiprocessorCount, dev);
        (void)hipFuncSetAttribute((const void*)fwd_megakernel, hipFuncAttributeMaxDynamicSharedMemorySize, LDS_BYTES);
        (void)hipOccupancyMaxActiveBlocksPerMultiprocessor(&per_cu, (const void*)fwd_megakernel, NTHREADS, LDS_BYTES);
        if (per_cu < 1) { fprintf(stderr, "kernel_launch: occupancy query reports %d blocks per CU\n", per_cu); per_cu = 1; }
        if (per_cu > 1) per_cu = 1;
        grid_blocks = cus * per_cu;
    }
    if (grid_blocks < 0) return;
    Params p{};
    for (int i = 0; i < 22; ++i) p.in[i] = (const float*)d_in[i];
    p.out = (float*)d_out; p.ws = (unsigned char*)d_ws;
    (void)hipMemsetAsync((char*)d_ws + WS_CTL, 0, CTL_ZERO_BYTES, stream);
    void* args[] = {&p};
    hipError_t e = hipLaunchCooperativeKernel((const void*)fwd_megakernel, dim3(grid_blocks), dim3(NTHREADS), args, LDS_BYTES, stream);
    if (e != hipSuccess) fprintf(stderr, "cooperative launch failed: %s (grid %d)\n", hipGetErrorString(e), grid_blocks);
}
```

```cpp
#include <hip/hip_runtime.h>
#include <hip/hip_cooperative_groups.h>
#include <cstdio>
#include <cstdint>
namespace cg = cooperative_groups;

namespace pg8 {
#define PG8_LAS __attribute__((address_space(3)))
typedef unsigned short bf16_t;
typedef short bf16x8 __attribute__((ext_vector_type(8)));
typedef float f32x4 __attribute__((ext_vector_type(4)));
typedef unsigned u32x4 __attribute__((ext_vector_type(4)));
constexpr int BM = 256, BK = 64, HALF = 128, HTB = HALF * BK * 2  , STAGE_BYTES = 8 * HTB, NXCD = 8, WGM = 8;

__host__ __device__ __forceinline__ int lds_byte(int r, int c) { const int st = (r >> 4) * 2 + (c >> 5), rr = r & 15, cc = c & 31, ob = rr * 64 + cc * 2; return st * 1024 + (ob ^ (((ob >> 9) & 1) << 5)); }
__host__ __device__ __forceinline__ void stage_rc(int b, int& R, int& C) { const int st = b / 1024, sb = b % 1024, swz = sb ^ (((sb >> 9) & 1) << 5); R = (st >> 1) * 16 + swz / 64; C = (st & 1) * 32 + (swz % 64) / 2; }
__host__ __device__ __forceinline__ int perm32(int rho) { const int n = rho >> 4, i = rho & 15; return 8 * (i >> 2) + 4 * n + (i & 3); }

struct Unit { int pm, pn, k0, nt, split; };
struct Gemm { const bf16_t* A; const bf16_t* Bt; int M, N, K; };

struct StaticOrder {
    int nM, nN, nwg, G, c, ntfull;
    __host__ __device__ void init(int M, int N, int K, int G_, int c_) { nM = M / BM; nN = N / BM; nwg = nM * nN; G = G_; c = c_; ntfull = K / BK; }
    __host__ __device__ bool next(int i, Unit& u) const {
        const long L = (long)i * G + c; if (L >= nwg) return false;
        int wgid = (int)L; { const int q = nwg / NXCD, r = nwg % NXCD, xcd = wgid % NXCD, off = wgid / NXCD; wgid = (xcd < r ? xcd * (q + 1) : r * (q + 1) + (xcd - r) * q) + off; }
        const int nig = WGM * nN, gid = wgid / nig, fm = gid * WGM, gsz = (nM - fm) < WGM ? (nM - fm) : WGM;
        u.pm = fm + ((wgid % nig) % gsz); u.pn = (wgid % nig) / gsz; u.k0 = 0; u.nt = ntfull; u.split = 0; return true;
    }
    __device__ __forceinline__ void a_ready(const Unit&) const {}
    __device__ __forceinline__ void done(const Unit&) const {}
};

struct SplitOrder {
    StaticOrder so; int nmain, nsplit, ntsub, nsub; unsigned* ready; unsigned need;
    __device__ void init(int Mmain, int N, int K, int klen, int G_, int c_, unsigned* ready_, unsigned need_) { so.init(Mmain, N, K, G_, c_); nmain = so.nwg; nsplit = K / klen; ntsub = klen / BK; nsub = (N / BM) * nsplit; ready = ready_; need = need_; }
    __device__ bool next(int i, Unit& u) const {
        if (so.next(i, u)) return true;
        const int nmine = (nmain - so.c + so.G - 1) / so.G;
        const int j = (i - nmine) * so.G + so.c;
        if (j < 0 || j >= nsub) return false;
        u.pm = so.nM; u.pn = j / nsplit; u.k0 = (j % nsplit) * ntsub * BK; u.nt = ntsub; u.split = 1; return true;
    }
    __device__ __forceinline__ void a_ready(const Unit& u) const {
        if (!u.split || need == 0u) return;
        if (threadIdx.x < 64) {
            unsigned polls = 0;
            while ((unsigned)__builtin_amdgcn_readfirstlane((int)__hip_atomic_load(ready, __ATOMIC_RELAXED, __HIP_MEMORY_SCOPE_AGENT)) < need) { __builtin_amdgcn_s_sleep(2); if (++polls > (1u << 22)) break; }
            __builtin_amdgcn_fence(__ATOMIC_ACQUIRE, "agent");
            asm volatile("s_waitcnt vmcnt(0)" ::: "memory");
        }
        asm volatile("" ::: "memory"); __builtin_amdgcn_s_barrier(); asm volatile("" ::: "memory");
    }
    __device__ __forceinline__ void done(const Unit&) const {}
};
struct SplitCtx { float* sum; int ldn; };
typedef float f32x2 __attribute__((ext_vector_type(2)));
typedef __bf16 bf16x2v __attribute__((ext_vector_type(2)));
__device__ __forceinline__ unsigned pk2(float lo, float hi) { f32x2 v = {lo, hi}; return __builtin_bit_cast(unsigned, __builtin_convertvector(v, bf16x2v)); }
__device__ __forceinline__ u32x4 pk8(const f32x4& a, const f32x4& b) { u32x4 w; w.x = pk2(a[0], a[1]); w.y = pk2(a[2], a[3]); w.z = pk2(b[0], b[1]); w.w = pk2(b[2], b[3]); return w; }
__device__ __forceinline__ float bflo(unsigned w) { return __builtin_bit_cast(float, w << 16); }
__device__ __forceinline__ float bfhi(unsigned w) { return __builtin_bit_cast(float, w & 0xffff0000u); }
__device__ __forceinline__ float sigmoidf_(float x) { return __builtin_amdgcn_rcpf(1.0f + __expf(-x)); }
template <class Epi, class Sched, bool ALIGN_EPI = false, bool SP2 = false>
__device__ __forceinline__ void gemm_phase(PG8_LAS unsigned char* lds, const Gemm g, const Sched& S, const Epi& E, const SplitCtx X = SplitCtx{nullptr, 0}) {
    int tid_ = threadIdx.x; asm volatile("" : "+v"(tid_));
    const int tid = tid_, wid = __builtin_amdgcn_readfirstlane(tid >> 6), lane = tid & 63, wr = wid >> 2, wc = wid & 3, fr = lane & 15, fq = lane >> 4;
    const int K = g.K;
    unsigned voffA[2], voffB[2];
#pragma unroll
    for (int i = 0; i < 2; ++i) { int R, C; stage_rc(tid * 16 + i * 8192, R, C); const int Rb = Epi::PERM ? ((R & ~31) + perm32(R & 31)) : R;
        voffA[i] = (unsigned)(R * K + C) * 2u; voffB[i] = (unsigned)(Rb * K + C) * 2u; }
    const size_t kstep = (size_t)(BK * 2);
    const size_t hstep = (size_t)HALF * K * 2;
    const size_t tstep = 2 * hstep;
    const unsigned ldsw = (unsigned)wid * 1024u;
    const int aoff = lds_byte(wr * 64 + fr, fq * 8), boff = lds_byte(wc * 32 + fr, fq * 8);
#define PG8_SA(b, h) (((b) * 2 + (h)) * HTB)
#define PG8_SB(b, h) ((4 + (b) * 2 + (h)) * HTB)
#define PG8_STAGE(bufoff, gbase, voff) do { _Pragma("unroll") for (int _i = 0; _i < 2; ++_i) \
        __builtin_amdgcn_global_load_lds((const unsigned*)((const char*)(gbase) + (voff)[_i]), (PG8_LAS unsigned*)(lds + (bufoff) + ldsw + _i * 8192), 16, 0, 0); } while (0)
#define PG8_LDA(dst, b, h) do { _Pragma("unroll") for (int m = 0; m < 4; ++m) _Pragma("unroll") for (int k = 0; k < 2; ++k) dst[m][k] = *(const PG8_LAS bf16x8*)(lds + PG8_SA(b, h) + aoff + m * 2048 + k * 1024); } while (0)
#define PG8_LDB(dst, b, h) do { _Pragma("unroll") for (int n = 0; n < 2; ++n) _Pragma("unroll") for (int k = 0; k < 2; ++k) dst[n][k] = *(const PG8_LAS bf16x8*)(lds + PG8_SB(b, h) + boff + n * 2048 + k * 1024); } while (0)
#define PG8_MMA(ai, bj, At, Bt) do { __builtin_amdgcn_s_setprio(1); _Pragma("unroll") for (int m = 0; m < 4; ++m) _Pragma("unroll") for (int n = 0; n < 2; ++n) _Pragma("unroll") for (int k = 0; k < 2; ++k) \
        acc[ai][bj][m][n] = __builtin_amdgcn_mfma_f32_16x16x32_bf16(Bt[n][k], At[m][k], acc[ai][bj][m][n], 0, 0, 0); __builtin_amdgcn_s_setprio(0); } while (0)
#define PG8_WAIT_V(n) asm volatile("s_waitcnt vmcnt(" #n ")" ::: "memory")
#define PG8_WAIT_L(n) asm volatile("s_waitcnt lgkmcnt(" #n ")" ::: "memory")
#define PG8_BAR __builtin_amdgcn_s_barrier()
#define PG8_SCHED __builtin_amdgcn_sched_barrier(0)
    Unit cur, nxt; int ui = 0;
    if (!S.next(0, cur)) return;
    f32x4 acc[2][2][4][2];
#pragma unroll
    for (int a = 0; a < 2; ++a)
#pragma unroll
        for (int b = 0; b < 2; ++b)
#pragma unroll
            for (int m = 0; m < 4; ++m)
#pragma unroll
                for (int n = 0; n < 2; ++n) acc[a][b][m][n] = (f32x4){0.f, 0.f, 0.f, 0.f};
    bf16x8 At[4][2], B0[2][2], B1[2][2];
    const char* cA = (const char*)g.A + (size_t)cur.pm * tstep + (size_t)cur.k0 * 2; const char* cB = (const char*)g.Bt + (size_t)cur.pn * tstep + (size_t)cur.k0 * 2;
    S.a_ready(cur);
    if constexpr (SP2) {
        PG8_STAGE(PG8_SB(0, 0), cB, voffB); PG8_STAGE(PG8_SB(0, 1), cB + hstep, voffB); PG8_STAGE(PG8_SA(0, 0), cA, voffA); PG8_STAGE(PG8_SA(0, 1), cA + hstep, voffA);
        if (wr == 1) PG8_BAR;
        PG8_WAIT_V(2); PG8_BAR;
        PG8_STAGE(PG8_SB(1, 0), cB + kstep, voffB); PG8_STAGE(PG8_SA(1, 0), cA + kstep, voffA); PG8_STAGE(PG8_SB(1, 1), cB + hstep + kstep, voffB);
        PG8_WAIT_V(6); PG8_BAR;
    } else {
        PG8_STAGE(PG8_SB(0, 0), cB, voffB); PG8_STAGE(PG8_SA(0, 0), cA, voffA); PG8_STAGE(PG8_SB(0, 1), cB + hstep, voffB); PG8_STAGE(PG8_SA(0, 1), cA + hstep, voffA);
        if (wr == 1) PG8_BAR;
        PG8_WAIT_V(4); PG8_BAR;
        PG8_STAGE(PG8_SB(1, 0), cB + kstep, voffB); PG8_STAGE(PG8_SA(1, 0), cA + kstep, voffA); PG8_STAGE(PG8_SB(1, 1), cB + hstep + kstep, voffB);
        PG8_WAIT_V(6); PG8_BAR;
    }
    for (;;) {
        const bool has_next = S.next(ui + 1, nxt);
        const char* nA = has_next ? (const char*)g.A + (size_t)nxt.pm * tstep + (size_t)nxt.k0 * 2 : cA; const char* nB = has_next ? (const char*)g.Bt + (size_t)nxt.pn * tstep + (size_t)nxt.k0 * 2 : cB;
        const int nt = cur.nt;
#pragma unroll 1
        for (int t = 0; t < nt; t += 2) {
            const bool last = (t == nt - 2);
            const char* a1 = cA + (size_t)(t + 1) * kstep;
            const char* a2 = last ? nA : cA + (size_t)(t + 2) * kstep; const char* b2 = last ? nB : cB + (size_t)(t + 2) * kstep;
            const char* a3 = a2 + kstep; const char* b3 = b2 + kstep;
            if (last && has_next) S.a_ready(nxt);
            if constexpr (SP2) {
            PG8_LDB(B0, 0, 0); PG8_LDB(B1, 0, 1); PG8_SCHED; PG8_LDA(At, 0, 0); PG8_STAGE(PG8_SA(1, 1), a1 + hstep, voffA);
            PG8_WAIT_V(8); PG8_WAIT_L(0); PG8_BAR; PG8_MMA(0, 0, At, B0); PG8_MMA(0, 1, At, B1); PG8_BAR; PG8_SCHED;
            PG8_LDA(At, 0, 1); PG8_STAGE(PG8_SB(0, 0), b2, voffB); PG8_STAGE(PG8_SB(0, 1), b2 + hstep, voffB); PG8_STAGE(PG8_SA(0, 0), a2, voffA);
            PG8_WAIT_V(8); PG8_WAIT_L(0); PG8_BAR; PG8_MMA(1, 0, At, B0); PG8_MMA(1, 1, At, B1); PG8_BAR; PG8_SCHED;
            PG8_LDB(B0, 1, 0); PG8_LDB(B1, 1, 1); PG8_SCHED; PG8_LDA(At, 1, 0); PG8_STAGE(PG8_SA(0, 1), a2 + hstep, voffA);
            PG8_WAIT_V(8); PG8_WAIT_L(0); PG8_BAR; PG8_MMA(0, 0, At, B0); PG8_MMA(0, 1, At, B1); PG8_BAR; PG8_SCHED;
            PG8_LDA(At, 1, 1); PG8_STAGE(PG8_SB(1, 0), b3, voffB); PG8_STAGE(PG8_SB(1, 1), b3 + hstep, voffB); PG8_STAGE(PG8_SA(1, 0), a3, voffA);
            PG8_WAIT_V(8); PG8_WAIT_L(0); PG8_BAR; PG8_MMA(1, 0, At, B0); PG8_MMA(1, 1, At, B1); PG8_BAR; PG8_SCHED;
            } else {
            PG8_LDB(B0, 0, 0); PG8_SCHED; PG8_LDA(At, 0, 0); PG8_STAGE(PG8_SA(1, 1), a1 + hstep, voffA);
            PG8_WAIT_L(8); PG8_BAR; PG8_WAIT_L(0); PG8_MMA(0, 0, At, B0); PG8_BAR; PG8_SCHED;
            PG8_LDB(B1, 0, 1); PG8_STAGE(PG8_SB(0, 0), b2, voffB);
            PG8_BAR; PG8_WAIT_L(0); PG8_MMA(0, 1, At, B1); PG8_BAR;
            PG8_LDA(At, 0, 1); PG8_STAGE(PG8_SA(0, 0), a2, voffA);
            PG8_BAR; PG8_WAIT_L(0); PG8_MMA(1, 0, At, B0); PG8_BAR; PG8_SCHED;
            PG8_STAGE(PG8_SB(0, 1), b2 + hstep, voffB);
            PG8_WAIT_V(6); PG8_BAR; PG8_MMA(1, 1, At, B1); PG8_BAR;
            PG8_LDB(B0, 1, 0); PG8_SCHED; PG8_LDA(At, 1, 0); PG8_STAGE(PG8_SA(0, 1), a2 + hstep, voffA);
            PG8_WAIT_L(8); PG8_BAR; PG8_WAIT_L(0); PG8_MMA(0, 0, At, B0); PG8_BAR; PG8_SCHED;
            PG8_LDB(B1, 1, 1); PG8_STAGE(PG8_SB(1, 0), b3, voffB);
            PG8_BAR; PG8_WAIT_L(0); PG8_MMA(0, 1, At, B1); PG8_BAR;
            PG8_LDA(At, 1, 1); PG8_STAGE(PG8_SA(1, 0), a3, voffA);
            PG8_BAR; PG8_WAIT_L(0); PG8_MMA(1, 0, At, B0); PG8_BAR; PG8_SCHED;
            PG8_STAGE(PG8_SB(1, 1), b3 + hstep, voffB);
            PG8_WAIT_V(6); PG8_BAR; PG8_MMA(1, 1, At, B1); PG8_BAR;
            }
        }
        if constexpr (ALIGN_EPI) { if (wr == 0) PG8_BAR; }
        bool do_epi = true;
        if (cur.split) {
            const size_t slice = (size_t)BM * X.ldn, rstep = (size_t)16 * X.ldn;
            float* rp = X.sum + (size_t)(cur.k0 / (cur.nt * BK)) * slice + (size_t)(wr * 64 + fr) * X.ldn + cur.pn * BM + wc * 32 + 8 * fq;
#pragma unroll
            for (int a = 0; a < 2; ++a) {
#pragma unroll
                for (int m = 0; m < 4; ++m) {
#pragma unroll
                    for (int b = 0; b < 2; ++b) { *(f32x4*)(rp + b * HALF) = acc[a][b][m][0]; *(f32x4*)(rp + b * HALF + 4) = acc[a][b][m][1]; }
                    rp += rstep;
                }
                rp += 4 * rstep;
            }
            do_epi = false;
        }
        if (do_epi) E(acc, cur, wr, wc, fr, fq);
        if (!has_next) break;
#pragma unroll
        for (int a = 0; a < 2; ++a)
#pragma unroll
            for (int b = 0; b < 2; ++b)
#pragma unroll
                for (int m = 0; m < 4; ++m)
#pragma unroll
                    for (int n = 0; n < 2; ++n) acc[a][b][m][n] = (f32x4){0.f, 0.f, 0.f, 0.f};
        cur = nxt; cA = nA; cB = nB; ++ui;
        if constexpr (ALIGN_EPI) { if (wr == 1) PG8_BAR; }
    }
    PG8_WAIT_V(0);
    if constexpr (!ALIGN_EPI) { if (wr == 0) PG8_BAR; }
    PG8_BAR;
    if constexpr (Epi::AFTER_DRAIN) { E.fused(acc, cur, wr, wc, fr, fq, lds, wid, lane); S.done(cur); }
#undef PG8_SA
#undef PG8_SB
#undef PG8_STAGE
#undef PG8_LDA
#undef PG8_LDB
#undef PG8_MMA
#undef PG8_WAIT_V
#undef PG8_WAIT_L
#undef PG8_BAR
#undef PG8_SCHED
}
}
constexpr int D = 1024, SEQ = 16384, MP = 2 * SEQ, MS = 256, MT = MP + MS, NIN = 1792, FF = 4096, DPLE = 256, CC = 512, QC = 512, KVC = 128;
constexpr float EPS = 1e-6f;
constexpr int NTHREADS = 512, NWAVES = 8;
constexpr int LDS_BYTES = 135168 + 256;
constexpr int MISC_OFF = 135168;
constexpr size_t WS_CTL = 0, CTL_ZERO_BYTES = 32768; constexpr int CW_SPLIT = 4096;
constexpr size_t OFF_Y = 0, OFF_NKP = (size_t)MT * D, OFF_NVP = OFF_NKP + 32768, OFF_NCP = OFF_NVP + 32768, OFF_NKS = OFF_NCP + 30720, OFF_NVS = OFF_NKS + 32768, OFF_NCS = OFF_NVS + 32768;
constexpr size_t MiB = 1u << 20;
constexpr size_t WS_WIN = 1 * MiB, WS_WOUT = 5 * MiB, WS_W1 = 7 * MiB, WS_W2 = 15 * MiB, WS_WG = 23 * MiB, WS_WP = 25 * MiB, WS_ROPE = 26 * MiB;
constexpr size_t WS_RSS1 = 30 * MiB, WS_RSS2 = 33 * MiB, WS_RSS3 = 36 * MiB;
constexpr size_t WS_HB = 40 * MiB, WS_PB = 105 * MiB, WS_PP = 122 * MiB, WS_HID = 188 * MiB;
constexpr size_t WS_A1 = 188 * MiB, WS_MIX = 253 * MiB, WS_U = 318 * MiB, WS_Q = 351 * MiB, WS_KB = 384 * MiB, WS_VB = 393 * MiB;
constexpr size_t WS_PART = 446 * MiB, WS_PARTB = 462 * MiB;
constexpr size_t WS_END = 478 * MiB;
static_assert(WS_HID + (size_t)MT * FF * 2 <= WS_PART && WS_VB + (size_t)MT * KVC * 2 <= WS_END && WS_PP + (size_t)MT * D * 2 <= WS_HID && WS_HB + (size_t)MT * D * 2 <= WS_PB && WS_PB + (size_t)MT * DPLE * 2 <= WS_PP, "ws map");

#define LAS __attribute__((address_space(3)))
typedef unsigned short bf16;
using pg8::f32x4; using pg8::u32x4; using pg8::bf16x8; using pg8::Unit;
typedef float f32x16 __attribute__((ext_vector_type(16)));
typedef unsigned u32x2 __attribute__((ext_vector_type(2)));
using pg8::pk2; using pg8::pk8; using pg8::bflo; using pg8::bfhi; using pg8::sigmoidf_;

struct Params { const float* in[22]; float* out; unsigned char* ws; };

__host__ __device__ __forceinline__ int win_dest(int c) {
    if (c < 512) return 256 * (c >> 7) + (c & 127);
    if (c < 1024) { c -= 512; return 256 * (c >> 7) + 128 + (c & 127); }
    if (c < 1536) { c -= 1024; const int hq = c >> 6, r = c & 63; return 256 * (4 + (hq >> 2)) + (r >> 5) * 128 + (hq & 3) * 32 + (r & 31); }
    if (c < 1664) { c -= 1536; const int hd = c >> 6, r = c & 63; return 1536 + (r >> 5) * 128 + hd * 32 + (r & 31); }
    c -= 1664; return 1536 + (c >> 6) * 128 + 64 + (c & 63);
}
__device__ __forceinline__ float wave_sum(float v) {
#pragma unroll
    for (int o = 1; o < 64; o <<= 1) v += __shfl_xor(v, o);
    return v;
}
#define LDS_WAIT() asm volatile("s_waitcnt lgkmcnt(0)" ::: "memory")

struct EpiIn {
    static constexpr bool PERM = true, AFTER_DRAIN = false;
    bf16 *U, *Q, *KB, *VB; const float* rope; float* out;
    __device__ __forceinline__ void operator()(const f32x4 (&acc)[2][2][4][2], const Unit& u, int wr, int wc, int fr, int fq) const {
        const int rowb = u.pm * 256 + wr * 64 + fr;
        if (u.pn < 4) {
            const int ch = 128 * u.pn + 32 * wc + 8 * fq;
#pragma unroll
            for (int ai = 0; ai < 2; ++ai)
#pragma unroll
                for (int m = 0; m < 4; ++m) {
                    const int row = rowb + ai * 128 + m * 16;
                    const bool isp = row < MP; const int srow = row - MP;
                    const int t = isp ? (row & (SEQ - 1)) : (srow & 31), bb = isp ? (row >> 14) : (srow >> 5);
                    f32x4 o0, o1;
#pragma unroll
                    for (int i = 0; i < 4; ++i) { o0[i] = acc[ai][0][m][0][i] * sigmoidf_(acc[ai][1][m][0][i]); o1[i] = acc[ai][0][m][1][i] * sigmoidf_(acc[ai][1][m][1][i]); }
                    *(u32x4*)(U + (size_t)row * CC + ch) = pk8(o0, o1);
                    float* dst = nullptr;
                    if (isp) { if (t >= SEQ - 30) dst = out + OFF_NCP + ((size_t)(bb * 30 + (t - (SEQ - 30)))) * CC + ch; }
                    else { if (t >= 2) dst = out + OFF_NCS + ((size_t)(bb * 30 + (t - 2))) * CC + ch; }
                    if (dst) { *(f32x4*)dst = o0; *(f32x4*)(dst + 4) = o1; }
                }
        } else if (u.pn < 6 || wc < 2) {
            const bool isq = u.pn < 6;
#pragma unroll
            for (int ai = 0; ai < 2; ++ai)
#pragma unroll
            for (int mh = 0; mh < 4; mh += 2) {
                f32x4 rp4[4][4];
#pragma unroll
                for (int m = mh; m < mh + 2; ++m) {
                    const int row = rowb + ai * 128 + m * 16;
                    const int pos = (row < MP) ? (row & (SEQ - 1)) : 2048 + ((row - MP) & 31);
                    const f32x4* rp = (const f32x4*)(rope + ((size_t)pos * 32 + 8 * fq) * 2);
                    rp4[m][0] = rp[0]; rp4[m][1] = rp[1]; rp4[m][2] = rp[2]; rp4[m][3] = rp[3];
                }
                asm volatile("" ::: "memory");
#pragma unroll
                for (int m = mh; m < mh + 2; ++m) {
                    const int row = rowb + ai * 128 + m * 16;
                    const bool isp = row < MP; const int srow = row - MP;
                    const int t = isp ? (row & (SEQ - 1)) : (srow & 31), bb = isp ? (row >> 14) : (srow >> 5);
                    bf16* op = isq ? Q + (size_t)row * QC + (4 * (u.pn - 4) + wc) * 64 + 8 * fq : KB + (size_t)row * KVC + wc * 64 + 8 * fq;
                    float* dst = nullptr;
                    if (!isq) {
                        if (isp) { if (t >= SEQ - 128) dst = out + OFF_NKP + ((size_t)((bb * 128 + (t - (SEQ - 128))) * 2 + wc)) * 64 + 8 * fq; }
                        else dst = out + OFF_NKS + ((size_t)(srow * 2 + wc)) * 64 + 8 * fq;
                    }
                    f32x4 a[2], b[2];
#pragma unroll
                    for (int n = 0; n < 2; ++n) {
                        const f32x4 r0 = rp4[m][2 * n], r1 = rp4[m][2 * n + 1];
                        const float cs[4] = {r0[0], r0[2], r1[0], r1[2]}, sn[4] = {r0[1], r0[3], r1[1], r1[3]};
#pragma unroll
                        for (int i = 0; i < 4; ++i) { const float x1 = acc[ai][0][m][n][i], x2 = acc[ai][1][m][n][i]; a[n][i] = x1 * cs[i] - x2 * sn[i]; b[n][i] = x2 * cs[i] + x1 * sn[i]; }
                    }
                    *(u32x4*)op = pk8(a[0], a[1]); *(u32x4*)(op + 32) = pk8(b[0], b[1]);
                    if (dst) { *(f32x4*)dst = a[0]; *(f32x4*)(dst + 4) = a[1]; *(f32x4*)(dst + 32) = b[0]; *(f32x4*)(dst + 36) = b[1]; }
                }
                asm volatile("" ::: "memory");
            }
        } else {
            const int dd = 32 * (wc - 2) + 8 * fq;
#pragma unroll
            for (int ai = 0; ai < 2; ++ai)
#pragma unroll
                for (int m = 0; m < 4; ++m) {
                    const int row = rowb + ai * 128 + m * 16;
                    const bool isp = row < MP; const int srow = row - MP;
                    const int t = isp ? (row & (SEQ - 1)) : (srow & 31), bb = isp ? (row >> 14) : (srow >> 5);
#pragma unroll
                    for (int bj = 0; bj < 2; ++bj) {
                        *(u32x4*)(VB + (size_t)row * KVC + 64 * bj + dd) = pk8(acc[ai][bj][m][0], acc[ai][bj][m][1]);
                        float* dst = nullptr;
                        if (isp) { if (t >= SEQ - 128) dst = out + OFF_NVP + ((size_t)((bb * 128 + (t - (SEQ - 128))) * 2 + bj)) * 64 + dd; }
                        else dst = out + OFF_NVS + ((size_t)(srow * 2 + bj)) * 64 + dd;
                        if (dst) { *(f32x4*)dst = acc[ai][bj][m][0]; *(f32x4*)(dst + 4) = acc[ai][bj][m][1]; }
                    }
                }
        }
    }
};
struct EpiPlain {
    static constexpr bool PERM = true, AFTER_DRAIN = false;
    bf16* O; int ldc;
    __device__ __forceinline__ void operator()(const f32x4 (&acc)[2][2][4][2], const Unit& u, int wr, int wc, int fr, int fq) const {
        const int rowb = u.pm * 256 + wr * 64 + fr, colb = u.pn * 256 + wc * 32 + 8 * fq;
#pragma unroll
        for (int ai = 0; ai < 2; ++ai)
#pragma unroll
            for (int m = 0; m < 4; ++m)
#pragma unroll
                for (int bj = 0; bj < 2; ++bj)
                    *(u32x4*)(O + (size_t)(rowb + ai * 128 + m * 16) * ldc + colb + bj * 128) = pk8(acc[ai][bj][m][0], acc[ai][bj][m][1]);
    }
};
__device__ __forceinline__ void wave_row_rs(const float* RSS, int base, int lane, int fr, float (&rs)[2][4]) {
    float r2[2];
#pragma unroll
    for (int a = 0; a < 2; ++a) {
        const f32x4* q = (const f32x4*)(RSS + (size_t)(base + 128 * a + lane) * 16);
        const f32x4 x0 = q[0], x1 = q[1], x2 = q[2], x3 = q[3];
        const float sm = (((x0[0] + x0[1]) + (x0[2] + x0[3])) + ((x1[0] + x1[1]) + (x1[2] + x1[3]))) + (((x2[0] + x2[1]) + (x2[2] + x2[3])) + ((x3[0] + x3[1]) + (x3[2] + x3[3])));
        r2[a] = __builtin_amdgcn_rsqf(sm * (1.0f / D) + EPS);
    }
#pragma unroll
    for (int a = 0; a < 2; ++a)
#pragma unroll
        for (int m = 0; m < 4; ++m) rs[a][m] = __shfl(r2[a], 16 * m + fr);
}
__device__ __forceinline__ float row_rs(const float* RSS, int row) {
    const f32x4* p = (const f32x4*)(RSS + (size_t)row * 16);
    const f32x4 a = p[0], b = p[1], c = p[2], d = p[3];
    const float s = ((a[0] + a[1]) + (a[2] + a[3])) + ((b[0] + b[1]) + (b[2] + b[3])) + ((c[0] + c[1]) + (c[2] + c[3])) + ((d[0] + d[1]) + (d[2] + d[3]));
    return __builtin_amdgcn_rsqf(s * (1.0f / D) + EPS);
}
template <bool FIRST>
struct EpiRes {
    static constexpr bool PERM = true, AFTER_DRAIN = false;
    const float* bp; const float* bs; bf16* HB; float* RSS; const float* RSSs = nullptr;
    bool seam = false; int ai0 = 0, ai1 = 2, m0 = 0, m1 = 4;
    __device__ __forceinline__ void operator()(const f32x4 (&acc)[2][2][4][2], const Unit& u, int wr, int wc, int fr, int fq) const {
        const int rowb = u.pm * 256 + wr * 64 + fr, colb = u.pn * 256 + wc * 32 + 8 * fq;
        float rs[2][4];
        if (!FIRST) wave_row_rs(RSSs, u.pm * 256 + wr * 64, fr + 16 * fq, fr, rs);
#pragma unroll
        for (int ai = 0; ai < 2; ++ai) if (ai >= ai0 && ai < ai1) {
            f32x4 bf[4][2][2]; u32x4 bw[4][2];
#pragma unroll
            for (int m = 0; m < 4; ++m) if (m >= m0 && m < m1) {
                const int row = rowb + ai * 128 + m * 16;
                if (FIRST) { const float* brow = (row < MP) ? bp + (size_t)row * D : bs + (size_t)(row - MP) * D;
#pragma unroll
                    for (int bj = 0; bj < 2; ++bj) { bf[m][bj][0] = *(const f32x4*)(brow + colb + bj * 128); bf[m][bj][1] = *(const f32x4*)(brow + colb + bj * 128 + 4); } }
                else {
#pragma unroll
                    for (int bj = 0; bj < 2; ++bj) bw[m][bj] = *(const u32x4*)(HB + (size_t)row * D + colb + bj * 128); }
            }
            asm volatile("" ::: "memory");
#pragma unroll
            for (int m = 0; m < 4; ++m) if (m >= m0 && m < m1) {
                const int row = rowb + ai * 128 + m * 16;
                float sc = 1.f; if (!FIRST) sc = rs[ai][m] * rs[ai][m];
                float ss = 0.f;
#pragma unroll
                for (int bj = 0; bj < 2; ++bj) {
                    const int col = colb + bj * 128;
                    f32x4 b0, b1;
                    if (FIRST) { b0 = bf[m][bj][0]; b1 = bf[m][bj][1]; }
                    else { const u32x4 w = bw[m][bj]; b0 = (f32x4){bflo(w.x), bfhi(w.x), bflo(w.y), bfhi(w.y)}; b1 = (f32x4){bflo(w.z), bfhi(w.z), bflo(w.w), bfhi(w.w)}; }
                    const f32x4 v0 = acc[ai][bj][m][0] * sc + b0, v1 = acc[ai][bj][m][1] * sc + b1;
                    *(u32x4*)(HB + (size_t)row * D + col) = pk8(v0, v1);
                    ss += (v0[0] * v0[0] + v0[1] * v0[1]) + (v0[2] * v0[2] + v0[3] * v0[3]) + (v1[0] * v1[0] + v1[1] * v1[1]) + (v1[2] * v1[2] + v1[3] * v1[3]);
                }
                ss += __shfl_xor(ss, 16); ss += __shfl_xor(ss, 32);
                if (fq == 0) RSS[(size_t)row * 16 + u.pn * 4 + wc] = ss;
            }
            asm volatile("" ::: "memory");
        }
    }
};
struct EpiFF1 {
    static constexpr bool PERM = true, AFTER_DRAIN = false;
    bf16* O; const float* RSS; bool seam = false; int ai0 = 0, ai1 = 2, m0 = 0, m1 = 4;
    __device__ __forceinline__ void operator()(const f32x4 (&acc)[2][2][4][2], const Unit& u, int wr, int wc, int fr, int fq) const {
        const int rowb = u.pm * 256 + wr * 64 + fr, colb = u.pn * 256 + wc * 32 + 8 * fq;
#pragma unroll
        for (int ai = 0; ai < 2; ++ai) if (ai >= ai0 && ai < ai1)
#pragma unroll
            for (int m = 0; m < 4; ++m) if (m >= m0 && m < m1) {
                const int row = rowb + ai * 128 + m * 16;
#pragma unroll
                for (int bj = 0; bj < 2; ++bj) {
                    f32x4 v0 = acc[ai][bj][m][0], v1 = acc[ai][bj][m][1];
#pragma unroll
                    for (int i = 0; i < 4; ++i) { const float a = fmaxf(v0[i], 0.f), b = fmaxf(v1[i], 0.f); v0[i] = a * a; v1[i] = b * b; }
                    *(u32x4*)(O + (size_t)row * FF + colb + bj * 128) = pk8(v0, v1);
                }
                if (seam) asm volatile("" ::: "memory");
            }
    }
};
struct EpiGate {
    static constexpr bool PERM = true, AFTER_DRAIN = false;
    const bf16* HB; bf16* H3B; const bf16* PP; const float* RSSin; float* RSSout; bool seam = false; int ai0 = 0, ai1 = 2, m0 = 0, m1 = 4;
    __device__ __forceinline__ void operator()(const f32x4 (&acc)[2][2][4][2], const Unit& u, int wr, int wc, int fr, int fq) const {
        const int rowb = u.pm * 256 + wr * 64 + fr, colb = u.pn * 256 + wc * 32 + 8 * fq;
        float rs[2][4];
        wave_row_rs(RSSin, u.pm * 256 + wr * 64, fr + 16 * fq, fr, rs);
#pragma unroll
        for (int ai = 0; ai < 2; ++ai) if (ai >= ai0 && ai < ai1) {
            u32x4 pwv[4][2], hwv[4][2];
#pragma unroll
            for (int m = 0; m < 4; ++m) if (m >= m0 && m < m1) {
                const int row = rowb + ai * 128 + m * 16;
#pragma unroll
                for (int bj = 0; bj < 2; ++bj) { pwv[m][bj] = *(const u32x4*)(PP + (size_t)row * D + colb + bj * 128); hwv[m][bj] = *(const u32x4*)(HB + (size_t)row * D + colb + bj * 128); }
            }
            asm volatile("" ::: "memory");
#pragma unroll
            for (int m = 0; m < 4; ++m) if (m >= m0 && m < m1) {
                const int row = rowb + ai * 128 + m * 16; const float r1 = rs[ai][m];
                float ss = 0.f;
#pragma unroll
                for (int bj = 0; bj < 2; ++bj) {
                    const int col = colb + bj * 128;
                    const u32x4 pw = pwv[m][bj], hw = hwv[m][bj];
                    const f32x4 p0 = {bflo(pw.x), bfhi(pw.x), bflo(pw.y), bfhi(pw.y)}, p1 = {bflo(pw.z), bfhi(pw.z), bflo(pw.w), bfhi(pw.w)};
                    f32x4 v0 = {bflo(hw.x), bfhi(hw.x), bflo(hw.y), bfhi(hw.y)}, v1 = {bflo(hw.z), bfhi(hw.z), bflo(hw.w), bfhi(hw.w)};
#pragma unroll
                    for (int i = 0; i < 4; ++i) { v0[i] += sigmoidf_(acc[ai][bj][m][0][i] * r1) * p0[i]; v1[i] += sigmoidf_(acc[ai][bj][m][1][i] * r1) * p1[i]; }
                    *(u32x4*)(H3B + (size_t)row * D + col) = pk8(v0, v1);
                    ss += (v0[0] * v0[0] + v0[1] * v0[1]) + (v0[2] * v0[2] + v0[3] * v0[3]) + (v1[0] * v1[0] + v1[1] * v1[1]) + (v1[2] * v1[2] + v1[3] * v1[3]);
                }
                ss += __shfl_xor(ss, 16); ss += __shfl_xor(ss, 32);
                if (fq == 0) RSSout[(size_t)row * 16 + u.pn * 4 + wc] = ss;
            }
            asm volatile("" ::: "memory");
        }
    }
};
template <bool MAP>
__device__ __forceinline__ void p0_transpose_item(const float* W, int K, int N, const float* gk, bf16* WT, LAS float* scr, int item, int lane) {
    const int nblk = N / 32, kb = item / nblk, nb = item % nblk, k0 = 64 * kb, n0 = 32 * nb;
#pragma unroll
    for (int i = 0; i < 32; ++i) { const int kk = 2 * i + (lane >> 5); float v = W[(size_t)(k0 + kk) * N + n0 + (lane & 31)]; if (gk) v *= gk[k0 + kk]; scr[kk * 33 + (lane & 31)] = v; }
    LDS_WAIT(); asm volatile("" ::: "memory");
    const int c = lane & 7, nd0 = MAP ? win_dest(n0) : n0;
#pragma unroll
    for (int j = 0; j < 4; ++j) { const int n = (lane >> 3) + 8 * j; const LAS float* s = scr + (8 * c) * 33 + n;
        u32x4 o; o.x = pk2(s[0 * 33], s[1 * 33]); o.y = pk2(s[2 * 33], s[3 * 33]); o.z = pk2(s[4 * 33], s[5 * 33]); o.w = pk2(s[6 * 33], s[7 * 33]);
        *(u32x4*)(WT + (size_t)(nd0 + n) * K + k0 + 8 * c) = o; }
    LDS_WAIT(); asm volatile("" ::: "memory");
}
__device__ __forceinline__ void p0_prologue(const Params& p, LAS unsigned char* lds, int G, int tid, int wid, int lane) {
    unsigned char* ws = p.ws;
    LAS float* scr = (LAS float*)(lds + wid * 16384);
    const int gw = blockIdx.x * NWAVES + wid, NGW = G * NWAVES;
    constexpr int I_IN = (D / 64) * (NIN / 32), I_O = (D / 64) * (D / 32), I_P = (DPLE / 64) * (D / 32);
    constexpr int NITEMS = I_IN + I_P;
    for (int it = gw; it < NITEMS; it += NGW) {
        int r = it;
        if (r < I_IN) { p0_transpose_item<true>(p.in[8], D, NIN, nullptr, (bf16*)(ws + WS_WIN), scr, r, lane); continue; } r -= I_IN;
        p0_transpose_item<false>(p.in[20], DPLE, D, nullptr, (bf16*)(ws + WS_WP), scr, r, lane);
    }
    const f32x4* g4 = (const f32x4*)p.in[7] + lane;
    bf16* A1 = (bf16*)(ws + WS_A1); bf16* PB = (bf16*)(ws + WS_PB);
    for (int row = gw * 4; row < MT; row += NGW * 4) {
        f32x4 v[4][4]; float s[4];
#pragma unroll
        for (int k = 0; k < 4; ++k) {
            const int rr = row + k;
            const float* xr = (rr < MP) ? p.in[0] + (size_t)rr * D : p.in[1] + (size_t)(rr - MP) * D;
            const f32x4* x4 = (const f32x4*)xr + lane;
#pragma unroll
            for (int j = 0; j < 4; ++j) v[k][j] = x4[64 * j];
        }
#pragma unroll
        for (int k = 0; k < 4; ++k) {
            s[k] = 0.f;
#pragma unroll
            for (int j = 0; j < 4; ++j) s[k] += (v[k][j][0] * v[k][j][0] + v[k][j][1] * v[k][j][1]) + (v[k][j][2] * v[k][j][2] + v[k][j][3] * v[k][j][3]);
            const float rs = __builtin_amdgcn_rsqf(wave_sum(s[k]) * (1.0f / D) + EPS);
            u32x2* o = (u32x2*)(A1 + (size_t)(row + k) * D) + lane;
#pragma unroll
            for (int j = 0; j < 4; ++j) { const f32x4 g = g4[64 * j]; u32x2 w; w.x = pk2(v[k][j][0] * rs * g[0], v[k][j][1] * rs * g[1]); w.y = pk2(v[k][j][2] * rs * g[2], v[k][j][3] * rs * g[3]); o[64 * j] = w; }
        }
    }
    float* rope = (float*)(ws + WS_ROPE);
    for (int idx = blockIdx.x * NTHREADS + tid; idx < SEQ * 32; idx += G * NTHREADS) {
        const int pos = idx >> 5, d = idx & 31;
        const float inv = (float)(1.0 / exp2((double)d * (13.287712379549449 / 32.0)));
        const float ang = (float)pos * inv;
        const double a = (double)ang, k = rint(a * 0.15915494309189535);
        const double r = fma(-k, 1.2246467991473532e-16 * 2.0, fma(-k, 6.283185307179586, a));
        const float rf = (float)r;
        ((pg8::f32x2*)rope)[idx] = (pg8::f32x2){cosf(rf), sinf(rf)};
    }
}

__device__ __forceinline__ void shadow_transpose(const float* W, int K, int N, const float* gk, bf16* WT, LAS unsigned char* lds, int cu, int ncu) {
    int t = threadIdx.x; asm volatile("" : "+v"(t));
    const int lane = t & 63, wid = __builtin_amdgcn_readfirstlane(t >> 6);
    LAS float* scr = (LAS float*)(lds + wid * 16384);
    const int nitems = (K / 64) * (N / 32);
    for (int it = cu * NWAVES + wid; it < nitems; it += ncu * NWAVES) p0_transpose_item<false>(W, K, N, gk, WT, scr, it, lane);
}

__device__ __forceinline__ void shadow_pb(const Params& p, int cu, int ncu) {
    int t = threadIdx.x; asm volatile("" : "+v"(t));
    const int lane = t & 63, wid = __builtin_amdgcn_readfirstlane(t >> 6);
    bf16* PB = (bf16*)(p.ws + WS_PB);
    for (int row = (cu * NWAVES + wid) * 8; row < MT; row += ncu * NWAVES * 8) {
        f32x4 pv[8];
#pragma unroll
        for (int k = 0; k < 8; ++k) { const int rr = row + k; const float* pr = (rr < MP) ? p.in[2] + (size_t)rr * DPLE : p.in[3] + (size_t)(rr - MP) * DPLE; pv[k] = ((const f32x4*)pr)[lane]; }
#pragma unroll
        for (int k = 0; k < 8; ++k) { u32x2 w; w.x = pk2(pv[k][0], pv[k][1]); w.y = pk2(pv[k][2], pv[k][3]); ((u32x2*)(PB + (size_t)(row + k) * DPLE))[lane] = w; }
    }
}

constexpr int N_ATT_P = 2 * 256 * 2, N_ATT = N_ATT_P + 16, N_CONV_P = MP / 64, N_CONV = N_CONV_P + 4;
constexpr int DCP = 516;
static_assert(64 * DCP * 4 <= MISC_OFF, "conv tile fits under the barrier words");
__device__ __forceinline__ void conv_item(const Params& p, LAS unsigned char* lds, int item, int tid, int wid, int lane) {
    typedef pg8::f32x2 f2;
    const bf16* U = (const bf16*)(p.ws + WS_U); bf16* MIX = (bf16*)(p.ws + WS_MIX);
    LAS float* DC = (LAS float*)lds;
    const int half = wid >> 2, c2 = 2 * (tid & 255);
    const bool sample = item >= N_CONV_P;
    const int row0 = item * 64, rowh = row0 + 32 * half;
    f2 win[62];
    if (!sample) {
        const int t0 = rowh & (SEQ - 1);
#pragma unroll
        for (int k = 0; k < 62; ++k) {
            const int tk = t0 - 30 + k;
            unsigned w = *(const unsigned*)(U + (size_t)(rowh - 30 + k - (tk < 0 ? tk : 0)) * CC + c2);
            if (tk < 0) w = 0u;
            win[k] = (f2){bflo(w), bfhi(w)};
        }
    } else {
        const float* sc = p.in[6] + (size_t)((item - N_CONV_P) * 2 + half) * 30 * CC + c2;
#pragma unroll
        for (int k = 0; k < 30; ++k) win[k] = *(const f2*)(sc + (size_t)k * CC);
#pragma unroll
        for (int k = 30; k < 62; ++k) { const unsigned w = *(const unsigned*)(U + (size_t)(rowh - 30 + k) * CC + c2); win[k] = (f2){bflo(w), bfhi(w)}; }
    }
    f2 w[31];
#pragma unroll
    for (int j = 0; j < 31; ++j) w[j] = *(const f2*)(p.in[9] + j * CC + c2);
    const f2 bias = *(const f2*)(p.in[10] + c2);
#pragma unroll
    for (int r = 0; r < 32; ++r) {
        f2 a = bias;
#pragma unroll
        for (int j = 0; j < 31; ++j) a = w[j] * win[r + j] + a;
        *(LAS f2*)(DC + (32 * half + r) * DCP + c2) = a;
    }
    __syncthreads();
    const int c8 = lane * 8;
    const f32x4 g0 = *(const f32x4*)(p.in[11] + c8), g1 = *(const f32x4*)(p.in[11] + c8 + 4), b0 = *(const f32x4*)(p.in[12] + c8), b1 = *(const f32x4*)(p.in[12] + c8 + 4);
#pragma unroll
    for (int rr = 0; rr < 8; ++rr) {
        const int r = 8 * wid + rr;
        f32x4 x0 = *(const LAS f32x4*)(DC + r * DCP + c8), x1 = *(const LAS f32x4*)(DC + r * DCP + c8 + 4);
        const float mean = wave_sum((x0[0] + x0[1]) + (x0[2] + x0[3]) + (x1[0] + x1[1]) + (x1[2] + x1[3])) * (1.0f / CC);
        x0 = x0 - mean; x1 = x1 - mean;
        const float var = wave_sum((x0[0] * x0[0] + x0[1] * x0[1]) + (x0[2] * x0[2] + x0[3] * x0[3]) + (x1[0] * x1[0] + x1[1] * x1[1]) + (x1[2] * x1[2] + x1[3] * x1[3])) * (1.0f / CC);
        const float rstd = __builtin_amdgcn_rsqf(var + EPS);
        f32x4 y0 = x0 * rstd * g0 + b0, y1 = x1 * rstd * g1 + b1;
#pragma unroll
        for (int i = 0; i < 4; ++i) { y0[i] *= sigmoidf_(y0[i]); y1[i] *= sigmoidf_(y1[i]); }
        *(u32x4*)(MIX + (size_t)(row0 + r) * D + c8) = pk8(y0, y1);
    }
    __syncthreads();
}

constexpr int KSP = 144, VTP = 408, VT_OFF = 192 * KSP;
#define MFMA32(a, b, c) __builtin_amdgcn_mfma_f32_32x32x16_bf16((a), (b), (c), 0, 0, 0)
__device__ __forceinline__ void attn_item(const Params& p, LAS unsigned char* lds, int item, int tid, int wid, int lane) {
    const bf16* Q = (const bf16*)(p.ws + WS_Q); const bf16* KB = (const bf16*)(p.ws + WS_KB); const bf16* VB = (const bf16*)(p.ws + WS_VB); bf16* MIX = (bf16*)(p.ws + WS_MIX);
    const bool sample = item >= N_ATT_P;
    int b, n, kvh, kt0, kt1;
    if (!sample) { b = item >> 9; n = (item >> 1) & 255; kvh = item & 1; kt0 = (n >= 2) ? 0 : (n == 1 ? 2 : 4); kt1 = 6; }
    else { const int s = item - N_ATT_P; b = s >> 1; n = 0; kvh = s & 1; kt0 = 0; kt1 = 5; }
    const int keyrow0 = b * SEQ + (n - 2) * 64;
    if (!sample) {
        u32x4 kv[3], vv[3];
#pragma unroll
        for (int i = 0; i < 3; ++i) {
            const int id = tid + NTHREADS * i, j = id >> 3, c = id & 7, jc = j < 32 * kt0 ? 32 * kt0 : j;
            const size_t grow = (size_t)(keyrow0 + jc);
            kv[i] = *(const u32x4*)(KB + grow * KVC + kvh * 64 + c * 8); vv[i] = *(const u32x4*)(VB + grow * KVC + kvh * 64 + c * 8);
        }
#pragma unroll
        for (int i = 0; i < 3; ++i) {
            const int id = tid + NTHREADS * i, j = id >> 3, c = id & 7;
            if (j >= 32 * kt0) {
                *(LAS u32x4*)(lds + j * KSP + c * 16) = kv[i];
                LAS unsigned short* vt = (LAS unsigned short*)(lds + VT_OFF + (8 * c) * VTP) + j;
                vt[0 * (VTP / 2)] = (unsigned short)(vv[i].x & 0xffffu); vt[1 * (VTP / 2)] = (unsigned short)(vv[i].x >> 16);
                vt[2 * (VTP / 2)] = (unsigned short)(vv[i].y & 0xffffu); vt[3 * (VTP / 2)] = (unsigned short)(vv[i].y >> 16);
                vt[4 * (VTP / 2)] = (unsigned short)(vv[i].z & 0xffffu); vt[5 * (VTP / 2)] = (unsigned short)(vv[i].z >> 16);
                vt[6 * (VTP / 2)] = (unsigned short)(vv[i].w & 0xffffu); vt[7 * (VTP / 2)] = (unsigned short)(vv[i].w >> 16);
            }
        }
    } else {
#pragma unroll
    for (int i = 0; i < 3; ++i) {
        const int id = tid + NTHREADS * i, j = id >> 3, c = id & 7;
        if (j >= 32 * kt0 && j < 32 * kt1) {
            u32x4 kv, vv;
            if (!sample || j >= 128) {
                const size_t grow = sample ? (size_t)(MP + b * 32 + (j - 128)) : (size_t)(keyrow0 + j);
                kv = *(const u32x4*)(KB + grow * KVC + kvh * 64 + c * 8); vv = *(const u32x4*)(VB + grow * KVC + kvh * 64 + c * 8);
            } else {
                const size_t off = ((size_t)(b * 128 + j) * 2 + kvh) * 64 + c * 8;
                const f32x4 k0 = *(const f32x4*)(p.in[4] + off), k1 = *(const f32x4*)(p.in[4] + off + 4), v0 = *(const f32x4*)(p.in[5] + off), v1 = *(const f32x4*)(p.in[5] + off + 4);
                kv = pk8(k0, k1); vv = pk8(v0, v1);
            }
            *(LAS u32x4*)(lds + j * KSP + c * 16) = kv;
            LAS unsigned short* vt = (LAS unsigned short*)(lds + VT_OFF + (8 * c) * VTP) + j;
            vt[0 * (VTP / 2)] = (unsigned short)(vv.x & 0xffffu); vt[1 * (VTP / 2)] = (unsigned short)(vv.x >> 16);
            vt[2 * (VTP / 2)] = (unsigned short)(vv.y & 0xffffu); vt[3 * (VTP / 2)] = (unsigned short)(vv.y >> 16);
            vt[4 * (VTP / 2)] = (unsigned short)(vv.z & 0xffffu); vt[5 * (VTP / 2)] = (unsigned short)(vv.z >> 16);
            vt[6 * (VTP / 2)] = (unsigned short)(vv.w & 0xffffu); vt[7 * (VTP / 2)] = (unsigned short)(vv.w >> 16);
        }
    }
    }
    __syncthreads();
    const int g = wid >> 1, qh = wid & 1, head = kvh * 4 + g, q = lane & 31, h = lane >> 5;
    if (!sample || qh == 0) {
        const size_t qrow = sample ? (size_t)(MP + b * 32 + q) : (size_t)(b * SEQ + n * 64 + qh * 32 + q);
        bf16x8 bq[4];
#pragma unroll
        for (int ks = 0; ks < 4; ++ks) bq[ks] = *(const bf16x8*)(Q + qrow * QC + head * 64 + ks * 16 + 8 * h);
        f32x16 st[6];
#pragma unroll
        for (int kt = 0; kt < 6; ++kt) {
#pragma unroll
            for (int r = 0; r < 16; ++r) st[kt][r] = 0.f;
            if (kt >= kt0 && kt < kt1) {
#pragma unroll
                for (int ks = 0; ks < 4; ++ks) { const bf16x8 a = *(const LAS bf16x8*)(lds + (32 * kt + q) * KSP + (16 * ks + 8 * h) * 2); st[kt] = MFMA32(a, bq[ks], st[kt]); }
            }
        }
        const float sk = p.in[13][head];
        float mx = sk;
#pragma unroll
        for (int kt = 0; kt < 6; ++kt) if (kt >= kt0 && kt < kt1) {
#pragma unroll
            for (int r = 0; r < 16; ++r) mx = fmaxf(mx, st[kt][r] * 0.125f);
        }
        mx = fmaxf(mx, __shfl_xor(mx, 32));
        float sum = 0.f;
#pragma unroll
        for (int kt = 0; kt < 6; ++kt) if (kt >= kt0 && kt < kt1) {
#pragma unroll
            for (int r = 0; r < 16; ++r) { const float e = __expf(st[kt][r] * 0.125f - mx); st[kt][r] = e; sum += e; }
        }
        sum += __shfl_xor(sum, 32); sum += __expf(sk - mx);
        f32x16 o[2];
#pragma unroll
        for (int r = 0; r < 16; ++r) { o[0][r] = 0.f; o[1][r] = 0.f; }
#pragma unroll
        for (int kt = 0; kt < 6; ++kt) if (kt >= kt0 && kt < kt1) {
#pragma unroll
            for (int s = 0; s < 2; ++s) {
                u32x4 pw; pw.x = pk2(st[kt][8 * s + 0], st[kt][8 * s + 1]); pw.y = pk2(st[kt][8 * s + 2], st[kt][8 * s + 3]); pw.z = pk2(st[kt][8 * s + 4], st[kt][8 * s + 5]); pw.w = pk2(st[kt][8 * s + 6], st[kt][8 * s + 7]);
                const bf16x8 pb = __builtin_bit_cast(bf16x8, pw);
#pragma unroll
                for (int dt = 0; dt < 2; ++dt) {
                    const LAS unsigned char* vp = lds + VT_OFF + (32 * dt + q) * VTP + (32 * kt + 16 * s + 4 * h) * 2;
                    const u32x2 lo = *(const LAS u32x2*)vp, hi = *(const LAS u32x2*)(vp + 16);
                    const u32x4 aw = {lo.x, lo.y, hi.x, hi.y};
                    o[dt] = MFMA32(__builtin_bit_cast(bf16x8, aw), pb, o[dt]);
                }
            }
        }
        const float inv = 1.0f / sum;
        bf16* op = MIX + qrow * D + CC + head * 64 + 4 * h;
#pragma unroll
        for (int dt = 0; dt < 2; ++dt)
#pragma unroll
            for (int gq = 0; gq < 4; ++gq) { u32x2 w; w.x = pk2(o[dt][4 * gq + 0] * inv, o[dt][4 * gq + 1] * inv); w.y = pk2(o[dt][4 * gq + 2] * inv, o[dt][4 * gq + 3] * inv); *(u32x2*)(op + 32 * dt + 8 * gq) = w; }
    }
    __syncthreads();
}

#define XB_TMO      128
#define XB_XCNT(j)  (256  + 64 * (j))
#define XB_XSUB(j)  (1280 + 64 * (j))
#define XB_XGEN(j)  (2304 + 64 * (j))
#define XB_TOP      3328
#define XB_TOPGEN   3392
#define XCD_BAR_WORDS 3456
#define XB_SPIN_CAP (1u << 18)

__device__ __forceinline__ unsigned xb_ld(unsigned* p)              { return __hip_atomic_load(p, __ATOMIC_RELAXED, __HIP_MEMORY_SCOPE_AGENT); }
__device__ __forceinline__ unsigned xb_add(unsigned* p, unsigned v) { return __hip_atomic_fetch_add(p, v, __ATOMIC_RELAXED, __HIP_MEMORY_SCOPE_AGENT); }
__device__ __forceinline__ unsigned xb_xcc_id() { return (unsigned)__builtin_amdgcn_s_getreg((3 << 11) | 20) & 0xFu; }
#define XB_SPIN(cond, bar) do { unsigned _sp = 0; while (cond) { __builtin_amdgcn_s_sleep(1); \
    if ((++_sp & 255u) == 0u) { if (xb_ld(&(bar)[XB_TMO])) break; if (_sp > XB_SPIN_CAP) { atomicAdd(&(bar)[XB_TMO], 1u); break; } } } } while (0)

struct XcdBarrier {
    unsigned* bar; unsigned x;
    volatile LAS unsigned* st;
};

__device__ __forceinline__ XcdBarrier xcd_barrier_post(unsigned* bar, volatile LAS unsigned* st) {
    XcdBarrier b; b.bar = bar; b.x = xb_xcc_id(); b.st = st;
    if (threadIdx.x == 0) (void)xb_add(&bar[XB_XCNT(b.x)], 1u);
    return b;
}
__device__ __forceinline__ void xcd_barrier_complete(unsigned* bar, unsigned x, unsigned& nloc, unsigned& nx) {
    const unsigned G = gridDim.x * gridDim.y * gridDim.z;
    unsigned sum, cnt, mine, sp = 0u;
    for (;;) {
        sum = 0u; cnt = 0u; mine = 0u;
#pragma unroll
        for (unsigned j = 0; j < 16; ++j) { const unsigned c = xb_ld(&bar[XB_XCNT(j)]); sum += c; cnt += (c > 0u) ? 1u : 0u; mine = (j == x) ? c : mine; }
        if (sum == G) break;
        __builtin_amdgcn_s_sleep(1);
        if ((++sp & 255u) == 0u) { if (xb_ld(&bar[XB_TMO])) break; if (sp > XB_SPIN_CAP) { atomicAdd(&bar[XB_TMO], 1u); break; } }
    }
    nloc = mine > 0u ? mine : 1u; nx = cnt > 0u ? cnt : 1u;
}

__device__ __forceinline__ void xcd_barrier(const XcdBarrier& b) {
    asm volatile("s_waitcnt vmcnt(0)" ::: "memory");
    __syncthreads();
    if (threadIdx.x == 0) {
        unsigned* bar = b.bar;
        __builtin_amdgcn_s_waitcnt(0);
        unsigned nloc = b.st[0], nx = b.st[1];
        if (nloc == 0u) { xcd_barrier_complete(bar, b.x, nloc, nx); b.st[0] = nloc; b.st[1] = nx; }
        const unsigned old = xb_add(&bar[XB_XSUB(b.x)], 1u);
        const unsigned gen = old / nloc;
        if (old + 1u == (gen + 1u) * nloc) {
            __builtin_amdgcn_fence(__ATOMIC_RELEASE, "agent");
            asm volatile("s_waitcnt vmcnt(0)" ::: "memory");
            const unsigned og = xb_add(&bar[XB_TOP], 1u);
            const unsigned tg = og / nx;
            if (og + 1u == (tg + 1u) * nx) xb_add(&bar[XB_TOPGEN], 1u);
            else XB_SPIN(xb_ld(&bar[XB_TOPGEN]) == tg, bar);
            __builtin_amdgcn_fence(__ATOMIC_ACQUIRE, "agent");
            xb_add(&bar[XB_XGEN(b.x)], 1u);
            asm volatile("s_waitcnt vmcnt(0)" ::: "memory");
        } else {
            XB_SPIN(xb_ld(&bar[XB_XGEN(b.x)]) == gen, bar);
            __builtin_amdgcn_fence(__ATOMIC_ACQUIRE, "agent");
            asm volatile("s_waitcnt vmcnt(0)" ::: "memory");
        }
    }
    __syncthreads();
}


template <int NS, class Epi>
__device__ __forceinline__ void sample_fixup(const float* part, int ldn, int item, const Epi& E, unsigned* cnt) {
    int tid_ = threadIdx.x; asm volatile("" : "+v"(tid_));
    const int lane = tid_ & 63, wid = __builtin_amdgcn_readfirstlane(tid_ >> 6), wr = wid >> 2, wc = wid & 3, fr = lane & 15, fq = lane >> 4;
    const int pn = item >> 3, ah = (item >> 2) & 1, mh = item & 3;
    const size_t slice = (size_t)256 * ldn;
    const float* q = part + (size_t)(ah * 128 + wr * 64 + mh * 16 + fr) * ldn + pn * 256 + wc * 32 + 8 * fq;
    f32x4 s0 = {0.f, 0.f, 0.f, 0.f}, s1 = s0, s2 = s0, s3 = s0;
#pragma unroll
    for (int k4 = 0; k4 < NS; k4 += 4) {
        f32x4 l[4][4];
#pragma unroll
        for (int ks = 0; ks < 4; ++ks) { l[ks][0] = *(const f32x4*)(q); l[ks][1] = *(const f32x4*)(q + 4); l[ks][2] = *(const f32x4*)(q + 128); l[ks][3] = *(const f32x4*)(q + 132); q += slice; }
        s0 += (l[0][0] + l[1][0]) + (l[2][0] + l[3][0]); s1 += (l[0][1] + l[1][1]) + (l[2][1] + l[3][1]); s2 += (l[0][2] + l[1][2]) + (l[2][2] + l[3][2]); s3 += (l[0][3] + l[1][3]) + (l[2][3] + l[3][3]);
    }
    Unit u; u.pm = MP / 256; u.pn = pn; u.k0 = 0; u.nt = 0; u.split = 0;
#pragma unroll
    for (int a = 0; a < 2; ++a)
#pragma unroll
        for (int m = 0; m < 4; ++m)
            if (a == ah && m == mh) {
                f32x4 acc[2][2][4][2];
#pragma unroll
                for (int x = 0; x < 2; ++x)
#pragma unroll
                    for (int b = 0; b < 2; ++b)
#pragma unroll
                        for (int y = 0; y < 4; ++y) { acc[x][b][y][0] = (f32x4){0.f, 0.f, 0.f, 0.f}; acc[x][b][y][1] = (f32x4){0.f, 0.f, 0.f, 0.f}; }
                acc[a][0][m][0] = s0; acc[a][0][m][1] = s1; acc[a][1][m][0] = s2; acc[a][1][m][1] = s3;
                Epi Eh = E; Eh.ai0 = a; Eh.ai1 = a + 1; Eh.m0 = m; Eh.m1 = m + 1;
                Eh(acc, u, wr, wc, fr, fq);
            }
    if (cnt) {
        asm volatile("s_waitcnt vmcnt(0)" ::: "memory");
        __syncthreads();
        if (wid == 0) {
            __builtin_amdgcn_fence(__ATOMIC_RELEASE, "agent");
            asm volatile("s_waitcnt vmcnt(0)" ::: "memory");
            if (lane == 0) (void)__hip_atomic_fetch_add(cnt, 1u, __ATOMIC_RELAXED, __HIP_MEMORY_SCOPE_AGENT);
        }
    }
}

__device__ __forceinline__ void p7_rows(float* out, const bf16* H3B, const float* RSS3, const float* gfin, int row0, int row_end, int step) {
    int t7 = threadIdx.x; asm volatile("" : "+v"(t7));
    const int lane = t7 & 63, wid = __builtin_amdgcn_readfirstlane(t7 >> 6);
    const f32x4* g4 = (const f32x4*)gfin + 2 * lane;
    const f32x4 ga = g4[0], gb = g4[1], gc = g4[128], gd = g4[129];
    for (int row = row0 + wid * 2; row < row_end; row += step) {
        float part[2]; u32x4 w[2][2];
#pragma unroll
        for (int k = 0; k < 2; ++k) {
            part[k] = RSS3[(size_t)(row + k) * 16 + (lane & 15)]; if (lane >= 16) part[k] = 0.f;
            const u32x4* hp = (const u32x4*)(H3B + (size_t)(row + k) * D) + lane;
            w[k][0] = hp[0]; w[k][1] = hp[64];
        }
#pragma unroll
        for (int k = 0; k < 2; ++k) {
            const float rs = __builtin_amdgcn_rsqf(wave_sum(part[k]) * (1.0f / D) + EPS);
            f32x4* o = (f32x4*)(out + (size_t)(row + k) * D) + 2 * lane;
            const u32x4 a = w[k][0], b = w[k][1];
            o[0] = (f32x4){bflo(a.x), bfhi(a.x), bflo(a.y), bfhi(a.y)} * rs * ga; o[1] = (f32x4){bflo(a.z), bfhi(a.z), bflo(a.w), bfhi(a.w)} * rs * gb;
            o[128] = (f32x4){bflo(b.x), bfhi(b.x), bflo(b.y), bfhi(b.y)} * rs * gc; o[129] = (f32x4){bflo(b.z), bfhi(b.z), bflo(b.w), bfhi(b.w)} * rs * gd;
        }
    }
}

__global__ void __launch_bounds__(NTHREADS, 2) fwd_megakernel(Params p) {
    extern __shared__ __attribute__((aligned(16))) unsigned char lds_raw[];
    LAS unsigned char* lds = (LAS unsigned char*)lds_raw;
    cg::grid_group grid = cg::this_grid();
    const int tid = threadIdx.x, lane = tid & 63, wid = __builtin_amdgcn_readfirstlane(tid >> 6), G = gridDim.x, bx = blockIdx.x;
    unsigned char* ws = p.ws;
    bf16* A1 = (bf16*)(ws + WS_A1); bf16* HB = (bf16*)(ws + WS_HB); bf16* PB = (bf16*)(ws + WS_PB); bf16* PP = (bf16*)(ws + WS_PP); bf16* HID = (bf16*)(ws + WS_HID); bf16* MIX = (bf16*)(ws + WS_MIX); bf16* H3B = (bf16*)(ws + WS_A1);
    unsigned* ctl = (unsigned*)(ws + WS_CTL);
    float* RSS1 = (float*)(ws + WS_RSS1); float* RSS2 = (float*)(ws + WS_RSS2); float* RSS3 = (float*)(ws + WS_RSS3);

    volatile LAS unsigned* MISC = (volatile LAS unsigned*)(lds + MISC_OFF);
    if (tid < 64) MISC[tid] = 0u;
    __syncthreads();
    XcdBarrier bar = xcd_barrier_post((unsigned*)(ws + WS_CTL), MISC + 8);
    p0_prologue(p, lds, G, tid, wid, lane);
    if (p.ws == nullptr) grid.sync();
    xcd_barrier(bar);
    {
        pg8::Gemm g{A1, (const bf16*)(ws + WS_WIN), MT, NIN, D}; pg8::StaticOrder S; S.init(MT, NIN, D, G, bx);
        EpiIn E{(bf16*)(ws + WS_U), (bf16*)(ws + WS_Q), (bf16*)(ws + WS_KB), (bf16*)(ws + WS_VB), (const float*)(ws + WS_ROPE), p.out};
        pg8::gemm_phase<EpiIn, pg8::StaticOrder, true, true>(lds, g, S, E);
        if (bx >= 136) shadow_pb(p, bx - 136, G - 136);
    }
    xcd_barrier(bar);
    const int vb = (G % 8 == 0) ? (bx % 8) * (G / 8) + bx / 8 : bx;
    for (int it = vb; it < N_ATT; it += G) { if (G == 256 && vb >= G - 4 && it == vb + 3 * G) continue; attn_item(p, lds, it, tid, wid, lane); }
    if (G == 256 && vb >= 16 && vb < 20) attn_item(p, lds, (G - 4 + (vb - 16)) + 3 * G, tid, wid, lane);
    for (int it = G - 1 - vb; it < N_CONV; it += G) conv_item(p, lds, it, tid, wid, lane);
    if (G == 256 && vb >= 20 && vb < G - 4) shadow_transpose(p.in[14], D, D, nullptr, (bf16*)(ws + WS_WOUT), lds, vb - 20, G - 24);
    else if (G != 256) shadow_transpose(p.in[14], D, D, nullptr, (bf16*)(ws + WS_WOUT), lds, bx, G);
    xcd_barrier(bar);
    float* PARTA = (float*)(ws + WS_PART); float* PARTB = (float*)(ws + WS_PARTB);
    unsigned* cnt3 = ctl + CW_SPLIT; unsigned* cnt4 = ctl + CW_SPLIT + 64; unsigned* cnt5 = ctl + CW_SPLIT + 128;
    {
        pg8::Gemm g{MIX, (const bf16*)(ws + WS_WOUT), MT, D, D}; pg8::SplitOrder S; S.init(MP, D, D, 256, G, bx, nullptr, 0u);
        EpiRes<true> E{p.in[0], p.in[1], HB, RSS1};
        pg8::gemm_phase<EpiRes<true>, pg8::SplitOrder, true, true>(lds, g, S, E, pg8::SplitCtx{PARTA, D});
        if (bx >= 16) shadow_transpose(p.in[16], D, FF, p.in[15], (bf16*)(ws + WS_W1), lds, bx - 16, G - 16);
    }
    xcd_barrier(bar);
    {
        if (bx >= G - 32) { EpiRes<true> Ef{p.in[0], p.in[1], HB, RSS1}; sample_fixup<4>(PARTA, D, G - 1 - bx, Ef, cnt3); }
        pg8::Gemm g{HB, (const bf16*)(ws + WS_W1), MT, FF, D}; pg8::SplitOrder S; S.init(MP, FF, D, 256, G, bx, cnt3, 32u);
        EpiFF1 E{HID, RSS1};
        pg8::gemm_phase<EpiFF1, pg8::SplitOrder, true, true>(lds, g, S, E, pg8::SplitCtx{PARTB, FF});
        if (bx >= 64) shadow_transpose(p.in[17], FF, D, nullptr, (bf16*)(ws + WS_W2), lds, bx - 64, G - 64);
        if (bx >= 64) shadow_transpose(p.in[19], D, D, p.in[18], (bf16*)(ws + WS_WG), lds, bx - 64, G - 64);
    }
    xcd_barrier(bar);
    {
        if (bx >= G - 128) { EpiFF1 Ef{HID, RSS1}; sample_fixup<4>(PARTB, FF, G - 1 - bx, Ef, cnt4); }
        pg8::Gemm g{HID, (const bf16*)(ws + WS_W2), MT, D, FF}; pg8::SplitOrder S; S.init(MP, D, FF, 512, G, bx, cnt4, 128u);
        EpiRes<false> E{nullptr, nullptr, HB, RSS2, RSS1};
        pg8::gemm_phase<EpiRes<false>, pg8::SplitOrder, true, true>(lds, g, S, E, pg8::SplitCtx{PARTA, D});
        if (bx >= 32) {
            pg8::Gemm g2{PB, (const bf16*)(ws + WS_WP), MT, D, DPLE}; pg8::StaticOrder S2; S2.init(MT, D, DPLE, G - 32, bx - 32);
            EpiPlain E2{PP, D};
            pg8::gemm_phase<EpiPlain, pg8::StaticOrder, true, true>(lds, g2, S2, E2);
        }
    }
    xcd_barrier(bar);
    {
        if (bx >= G - 32) { EpiRes<false> Ef{nullptr, nullptr, HB, RSS2, RSS1}; sample_fixup<8>(PARTA, D, G - 1 - bx, Ef, cnt5); }
        pg8::Gemm g{HB, (const bf16*)(ws + WS_WG), MT, D, D}; pg8::SplitOrder S; S.init(MP, D, D, 256, G, bx, cnt5, 32u);
        EpiGate E{HB, H3B, PP, RSS2, RSS3};
        pg8::gemm_phase<EpiGate, pg8::SplitOrder, true, true>(lds, g, S, E, pg8::SplitCtx{PARTB, D});
    }
    xcd_barrier(bar);
    if (G != 256) {
        if (bx >= G - 32) { EpiGate Ef{HB, H3B, PP, RSS2, RSS3}; sample_fixup<4>(PARTB, D, G - 1 - bx, Ef, nullptr); }
        p7_rows(p.out, H3B, RSS3, p.in[21], bx * NWAVES * 2, MP, G * NWAVES * 2);
        xcd_barrier(bar);
        p7_rows(p.out, H3B, RSS3, p.in[21], MP + bx * NWAVES * 2, MT, G * NWAVES * 2);
    } else if (bx >= G - 32) {
        const int f = bx - (G - 32);
        { EpiGate Ef{HB, H3B, PP, RSS2, RSS3}; sample_fixup<4>(PARTB, D, G - 1 - bx, Ef, nullptr); }
        unsigned* cnt6 = ctl + CW_SPLIT + 192;
        asm volatile("s_waitcnt vmcnt(0)" ::: "memory");
        __syncthreads();
        if (tid < 64) {
            __builtin_amdgcn_fence(__ATOMIC_RELEASE, "agent");
            asm volatile("s_waitcnt vmcnt(0)" ::: "memory");
            if (lane == 0) (void)__hip_atomic_fetch_add(cnt6, 1u, __ATOMIC_RELAXED, __HIP_MEMORY_SCOPE_AGENT);
            unsigned polls = 0;
            while ((unsigned)__builtin_amdgcn_readfirstlane((int)__hip_atomic_load(cnt6, __ATOMIC_RELAXED, __HIP_MEMORY_SCOPE_AGENT)) < 32u) { __builtin_amdgcn_s_sleep(2); if (++polls > (1u << 22)) break; }
            __builtin_amdgcn_fence(__ATOMIC_ACQUIRE, "agent");
            asm volatile("s_waitcnt vmcnt(0)" ::: "memory");
        }
        __syncthreads();
        p7_rows(p.out, H3B, RSS3, p.in[21], MP + f * 8, MP + f * 8 + 8, 16);
        p7_rows(p.out, H3B, RSS3, p.in[21], (1792 + f) * 16, 1952 * 16, 32 * 16);
    } else {
        p7_rows(p.out, H3B, RSS3, p.in[21], bx * 16, 1792 * 16, 224 * 16);
        if (bx < 96) p7_rows(p.out, H3B, RSS3, p.in[21], (1952 + bx) * 16, (1952 + bx) * 16 + 16, 16);
    }
}

extern "C" void kernel_launch(void* const* d_in, const int* in_sizes, int n_in, void* d_out, int out_size, void* d_ws, size_t ws_size, hipStream_t stream) {
    static int grid_blocks = 0;
    if (grid_blocks == 0) {
        if (n_in != 22 || ws_size < WS_END) { fprintf(stderr, "kernel_launch: unexpected n_in %d / ws_size %zu\n", n_in, ws_size); grid_blocks = -1; return; }
        int dev = 0, cus = 0, per_cu = 0;
        (void)hipGetDevice(&dev);
        (void)hipDeviceGetAttribute(&cus, hipDeviceAttributeMultiprocessorCount, dev);
        (void)hipFuncSetAttribute((const void*)fwd_megakernel, hipFuncAttributeMaxDynamicSharedMemorySize, LDS_BYTES);
        (void)hipOccupancyMaxActiveBlocksPerMultiprocessor(&per_cu, (const void*)fwd_megakernel, NTHREADS, LDS_BYTES);
        if (per_cu < 1) { fprintf(stderr, "kernel_launch: occupancy query reports %d blocks per CU\n", per_cu); per_cu = 1; }
        if (per_cu > 1) per_cu = 1;
        grid_blocks = cus * per_cu;
    }
    if (grid_blocks < 0) return;
    Params p{};
    for (int i = 0; i < 22; ++i) p.in[i] = (const float*)d_in[i];
    p.out = (float*)d_out; p.ws = (unsigned char*)d_ws;
    (void)hipMemsetAsync((char*)d_ws + WS_CTL, 0, CTL_ZERO_BYTES, stream);
    void* args[] = {&p};
    hipError_t e = hipLaunchCooperativeKernel((const void*)fwd_megakernel, dim3(grid_blocks), dim3(NTHREADS), args, LDS_BYTES, stream);
    if (e != hipSuccess) fprintf(stderr, "cooperative launch failed: %s (grid %d)\n", hipGetErrorString(e), grid_blocks);
}
```
